# Optimizing an MI355X kernel written in HIP

```python
import math
import jax, jax.numpy as jnp
from jax import lax
import numpy as np

D_MODEL = 1024
BATCH = 4
SEQ = 4096
DEPTH = 1
DEC_BATCH = 32
DEC_SEQ = 8
PAST_LEN = 8192
PAGE_SIZE = 128

ATT_HEAD_DIM = 64
N_ATT_HEADS = (D_MODEL // 2) // ATT_HEAD_DIM
ATT_WIDTH = N_ATT_HEADS * ATT_HEAD_DIM
N_ML_HEADS = 4
ML_HEAD_DIM = (D_MODEL // 2) // N_ML_HEADS
ML_WIDTH = N_ML_HEADS * ML_HEAD_DIM
MIX_WIDTH = ATT_WIDTH + ML_WIDTH
PROJ_COLS = 3 * ATT_WIDTH + 4 * ML_WIDTH + 2 * N_ML_HEADS
MOBA_BLOCK = 256
MOBA_TOPK = 3
QUERY_BLOCK = 128
ML_CHUNK = 64
NUM_BUCKETS = 32
MAX_DISTANCE = 128
D_FF = 4 * D_MODEL
RMS_EPS = 1e-6

kernel_name = "hymba_moba_mlstm_decoder_step"


def rmsnorm(x, g):
    xf = x.astype(jnp.float32)
    y = xf * lax.rsqrt(jnp.mean(xf * xf, axis=-1, keepdims=True) + RMS_EPS) * g.astype(jnp.float32)
    return y.astype(x.dtype)


def t5_bucket(dist):
    n = jnp.maximum(dist, 0)
    max_exact = NUM_BUCKETS // 2
    nf = jnp.maximum(n, 1).astype(jnp.float32)
    large = max_exact + (jnp.log(nf / max_exact) / math.log(MAX_DISTANCE / max_exact)
                         * (NUM_BUCKETS - max_exact)).astype(jnp.int32)
    large = jnp.minimum(large, NUM_BUCKETS - 1)
    return jnp.where(n < max_exact, n, large)


def split_projection(xn, w_in, b_ig, b_fg):
    lead = xn.shape[:-1]
    p = xn @ w_in
    sizes = [ATT_WIDTH] * 3 + [ML_WIDTH] * 4 + [N_ML_HEADS] * 2
    cuts = np.cumsum(sizes)[:-1].tolist()
    aq, ak, av, mq, mk, mv, mo, ig, fg = jnp.split(p, cuts, axis=-1)
    att = lambda a: a.reshape(lead + (N_ATT_HEADS, ATT_HEAD_DIM))
    mh = lambda a: a.reshape(lead + (N_ML_HEADS, ML_HEAD_DIM))
    ig = ig.astype(jnp.float32) + b_ig.astype(jnp.float32)
    logf = jax.nn.log_sigmoid(fg.astype(jnp.float32) + b_fg.astype(jnp.float32))
    return (att(aq), att(ak), att(av), mh(mq), mh(mk) * (ML_HEAD_DIM ** -0.5), mh(mv), mo, ig, logf)


def key_blocks(k):
    B, T, H, dh = k.shape
    nb = -(-T // MOBA_BLOCK)
    k = jnp.pad(k, ((0, 0), (0, nb * MOBA_BLOCK - T), (0, 0), (0, 0)))
    return k.reshape(B, nb, MOBA_BLOCK, H, dh).transpose(0, 3, 1, 2, 4)


def moba_attend(q, k_blocks, v_blocks, k_means, q_pos, rel_bias):
    T, H = q.shape[0], q.shape[1]
    NB = k_blocks.shape[1]
    n_sel = min(MOBA_TOPK, NB)
    own = q_pos // MOBA_BLOCK
    scores = jnp.einsum('thd,hnd->thn', q.astype(jnp.float32), k_means)
    fully_past = jnp.arange(NB)[None, None, :] < own[:, None, None]
    scores = jnp.where(fully_past, scores, -jnp.inf)
    _, sel = lax.top_k(scores, n_sel)
    sel_ok = jnp.broadcast_to(jnp.arange(n_sel)[None, None, :] < own[:, None, None], (T, H, n_sel))
    idx = jnp.concatenate([sel, jnp.broadcast_to(own[:, None, None], (T, H, 1))], axis=-1)
    ok = jnp.concatenate([sel_ok, jnp.ones((T, H, 1), dtype=bool)], axis=-1)
    head = jnp.arange(H)[None, :, None]
    kg = k_blocks[head, idx]
    vg = v_blocks[head, idx]
    k_pos = idx[..., None] * MOBA_BLOCK + jnp.arange(MOBA_BLOCK)
    dist = q_pos[:, None, None, None] - k_pos
    bias = rel_bias[t5_bucket(dist), head[..., None]].astype(jnp.float32)
    logits = jnp.einsum('thd,thjpd->thjp', q, kg, preferred_element_type=jnp.float32) * (ATT_HEAD_DIM ** -0.5) + bias
    logits = jnp.where(ok[..., None] & (dist >= 0), logits, -jnp.inf)
    J = logits.shape[2]
    probs = jax.nn.softmax(logits.reshape(T, H, J * MOBA_BLOCK), axis=-1).reshape(T, H, J, MOBA_BLOCK)
    return jnp.einsum('thjp,thjpd->thd', probs.astype(vg.dtype), vg)


def moba_prompt(q, k, v, rel_bias):
    B, S, H, dh = q.shape
    kb, vb = key_blocks(k), key_blocks(v)
    km = jnp.mean(kb.astype(jnp.float32), axis=3)
    nq = S // QUERY_BLOCK
    qc = q.reshape(B * nq, QUERY_BLOCK, H, dh)
    bidx = jnp.repeat(jnp.arange(B), nq)
    p0 = jnp.tile(jnp.arange(nq) * QUERY_BLOCK, B)

    def step(args):
        qq, b, s0 = args
        return moba_attend(qq, kb[b], vb[b], km[b], s0 + jnp.arange(QUERY_BLOCK), rel_bias)

    return lax.map(step, (qc, bidx, p0)).reshape(B, S, H, dh)


def moba_sample(q, k, v, pool_k, pool_v, page_table, rel_bias):
    DB, T = q.shape[0], q.shape[1]
    past_k = pool_k[page_table].reshape(DB, -1, N_ATT_HEADS, ATT_HEAD_DIM)
    past_v = pool_v[page_table].reshape(DB, -1, N_ATT_HEADS, ATT_HEAD_DIM)
    past = past_k.shape[1]
    kb = key_blocks(jnp.concatenate([past_k.astype(k.dtype), k], axis=1))
    vb = key_blocks(jnp.concatenate([past_v.astype(v.dtype), v], axis=1))
    km = jnp.mean(kb.astype(jnp.float32), axis=3)
    q_pos = past + jnp.arange(T)
    return lax.map(lambda a: moba_attend(a[0], a[1], a[2], a[3], q_pos, rel_bias), (q, kb, vb, km))


def mlstm_chunk(carry, inp):
    C, n, m = carry
    q, k, v, ig, lf = (a.astype(jnp.float32) for a in inp)
    L = q.shape[1]
    b = jnp.cumsum(lf, axis=1)
    a = b + m[:, None, :]
    logD = b[:, :, None, :] - b[:, None, :, :] + ig[:, None, :, :]
    causal = jnp.tril(jnp.ones((L, L), dtype=bool))[None, :, :, None]
    logD = jnp.where(causal, logD, -jnp.inf)
    m_t = jnp.maximum(a, jnp.max(logD, axis=2))
    D = jnp.exp(logD - m_t[:, :, None, :])
    w_state = jnp.exp(a - m_t)
    s = jnp.einsum('bthd,bjhd->btjh', q, k) * D
    num = w_state[..., None] * jnp.einsum('bthd,bhde->bthe', q, C) + jnp.einsum('btjh,bjhe->bthe', s, v)
    den = w_state * jnp.einsum('bthd,bhd->bth', q, n) + jnp.sum(s, axis=2)
    h = num / jnp.maximum(jnp.abs(den), jnp.exp(-m_t))[..., None]
    bL = b[:, -1, :]
    m_new = m_t[:, -1, :]
    g_state = jnp.exp(bL + m - m_new)
    g_tok = jnp.exp(bL[:, None, :] - b + ig - m_new[:, None, :])
    C_new = g_state[..., None, None] * C + jnp.einsum('bjh,bjhd,bjhe->bhde', g_tok, k, v)
    n_new = g_state[..., None] * n + jnp.einsum('bjh,bjhd->bhd', g_tok, k)
    return (C_new, n_new, m_new), h


def mlstm_prompt(q, k, v, ig, lf):
    B, S, H, d = q.shape
    L = min(ML_CHUNK, S)
    nc = S // L
    chunks = lambda a: jnp.moveaxis(a.reshape((B, nc, L) + a.shape[2:]), 1, 0)
    init = (jnp.zeros((B, H, d, d), jnp.float32), jnp.zeros((B, H, d), jnp.float32), jnp.zeros((B, H), jnp.float32))
    state, hs = lax.scan(mlstm_chunk, init, (chunks(q), chunks(k), chunks(v), chunks(ig), chunks(lf)))
    return jnp.moveaxis(hs, 0, 1).reshape(B, S, H, d), state


def mlstm_sample(q, k, v, ig, lf, C, n, m):
    state, h = mlstm_chunk((C.astype(jnp.float32), n.astype(jnp.float32), m.astype(jnp.float32)), (q, k, v, ig, lf))
    return h, state


def trunk_layer(x, attend, recur, norm_mix, w_in, b_ig, b_fg, ml_norm, w_out, norm_ffn, w_up, w_down):
    lead = x.shape[:-1]
    xn = rmsnorm(x, norm_mix)
    aq, ak, av, mq, mk, mv, mo, ig, lf = split_projection(xn, w_in, b_ig, b_fg)
    att = attend(aq, ak, av).reshape(lead + (ATT_WIDTH,))
    h, ml_state = recur(mq, mk, mv, ig, lf)
    hn = rmsnorm(h, ml_norm.reshape(N_ML_HEADS, ML_HEAD_DIM)).reshape(lead + (ML_WIDTH,))
    ml = hn * jax.nn.sigmoid(mo.astype(jnp.float32))
    mix = jnp.concatenate([att.astype(x.dtype), ml.astype(x.dtype)], axis=-1)
    x = x + mix @ w_out
    u = jax.nn.relu(rmsnorm(x, norm_ffn) @ w_up)
    x = x + (u * u) @ w_down
    return x, (ak, av) + tuple(ml_state)


def setup_inputs(seed: int = 0) -> dict:
    key = jax.random.key(seed)
    ks = jax.random.split(key, 24)
    n_pages = PAST_LEN // PAGE_SIZE
    n_used = DEC_BATCH * n_pages
    n_phys = n_used + max(1, n_used // 4)
    f32 = jnp.float32
    nrm = lambda k, shape, s: jax.random.normal(k, shape, f32) * s
    page_table = jax.random.permutation(ks[0], n_phys)[:n_used].reshape(DEC_BATCH, n_pages).astype(jnp.int32)
    b_fg = jnp.linspace(3.0, 6.0, N_ML_HEADS, dtype=f32)[None, :] + nrm(ks[13], (DEPTH, N_ML_HEADS), 0.1)
    return {
        "x_prompt": nrm(ks[1], (BATCH, SEQ, D_MODEL), 1.0),
        "x_sample": nrm(ks[2], (DEC_BATCH, DEC_SEQ, D_MODEL), 1.0),
        "cache_k": nrm(ks[3], (DEPTH, n_phys, PAGE_SIZE, N_ATT_HEADS, ATT_HEAD_DIM), 1.0),
        "cache_v": nrm(ks[4], (DEPTH, n_phys, PAGE_SIZE, N_ATT_HEADS, ATT_HEAD_DIM), 1.0),
        "state_C": nrm(ks[5], (DEPTH, DEC_BATCH, N_ML_HEADS, ML_HEAD_DIM, ML_HEAD_DIM), 0.1),
        "state_n": nrm(ks[6], (DEPTH, DEC_BATCH, N_ML_HEADS, ML_HEAD_DIM), 0.1),
        "state_m": nrm(ks[7], (DEPTH, DEC_BATCH, N_ML_HEADS), 1.0),
        "page_table": page_table,
        "rel_bias": nrm(ks[8], (NUM_BUCKETS, N_ATT_HEADS), 0.5),
        "norm_mix": 1.0 + nrm(ks[9], (DEPTH, D_MODEL), 0.1),
        "w_in": nrm(ks[10], (DEPTH, D_MODEL, PROJ_COLS), D_MODEL ** -0.5),
        "b_ig": nrm(ks[11], (DEPTH, N_ML_HEADS), 0.1),
        "b_fg": b_fg,
        "ml_norm": 1.0 + nrm(ks[12], (DEPTH, ML_WIDTH), 0.1),
        "w_out": nrm(ks[14], (DEPTH, MIX_WIDTH, D_MODEL), MIX_WIDTH ** -0.5),
        "norm_ffn": 1.0 + nrm(ks[15], (DEPTH, D_MODEL), 0.1),
        "w_up": nrm(ks[16], (DEPTH, D_MODEL, D_FF), D_MODEL ** -0.5),
        "w_down": nrm(ks[17], (DEPTH, D_FF, D_MODEL), D_FF ** -0.5),
        "norm_final": 1.0 + nrm(ks[18], (D_MODEL,), 0.1),
    }


def reference(x_prompt, x_sample, cache_k, cache_v, state_C, state_n, state_m, page_table, rel_bias,
              norm_mix, w_in, b_ig, b_fg, ml_norm, w_out, norm_ffn, w_up, w_down, norm_final):
    yp, ys = x_prompt, x_sample
    sp, ss = [], []
    for l in range(DEPTH):
        wl = (norm_mix[l], w_in[l], b_ig[l], b_fg[l], ml_norm[l], w_out[l], norm_ffn[l], w_up[l], w_down[l])
        yp, st_p = trunk_layer(
            yp,
            lambda q, k, v: moba_prompt(q, k, v, rel_bias),
            mlstm_prompt,
            *wl)
        ys, st_s = trunk_layer(
            ys,
            lambda q, k, v: moba_sample(q, k, v, cache_k[l], cache_v[l], page_table, rel_bias),
            lambda q, k, v, ig, lf: mlstm_sample(q, k, v, ig, lf, state_C[l], state_n[l], state_m[l]),
            *wl)
        sp.append(st_p)
        ss.append(st_s)
    y_prompt = rmsnorm(yp, norm_final)
    y_sample = rmsnorm(ys, norm_final)
    new_k_prompt = jnp.stack([s[0] for s in sp])
    new_v_prompt = jnp.stack([s[1] for s in sp])
    new_C_prompt = jnp.stack([s[2] for s in sp])
    new_n_prompt = jnp.stack([s[3] for s in sp])
    new_m_prompt = jnp.stack([s[4] for s in sp])
    new_k_sample = jnp.stack([s[0] for s in ss])
    new_v_sample = jnp.stack([s[1] for s in ss])
    new_C_sample = jnp.stack([s[2] for s in ss])
    new_n_sample = jnp.stack([s[3] for s in ss])
    new_m_sample = jnp.stack([s[4] for s in ss])
    return (y_prompt, y_sample, new_k_prompt, new_v_prompt, new_C_prompt, new_n_prompt, new_m_prompt,
            new_k_sample, new_v_sample, new_C_sample, new_n_sample, new_m_sample)
```

```cpp
#include <hip/hip_runtime.h>
#include <cstdio>
#include <cstdint>
#include <cmath>
constexpr int D = 1024, SEQ = 4096, NBATCH = 4, MP = NBATCH * SEQ  , DB = 32, DS = 8, MS = DB * DS  , M = MP + MS  ;
constexpr int FF = 4096, NPROJ = 3592, NPG = 3584  ;
constexpr int AH = 8, AD = 64, AW = 512, MH = 4, MD = 128, MW = 512;
constexpr int PAST = 8192, PAGE = 128, NPAGES = PAST / PAGE  , MBLK = 256, NBLK_P = SEQ / MBLK  , NBLK_S = PAST / MBLK  ;
constexpr float RMS_EPS = 1e-6f;
constexpr size_t O_YP = 0, O_YS = 16777216, O_KP = 17039360, O_VP = 25427968, O_CP = 33816576, O_NP = 34078720, O_MP = 34080768,
                 O_KS = 34080784, O_VS = 34211856, O_CS = 34342928, O_NS = 36440080, O_MS = 36456464, O_END = 36456592;
namespace pg8 {
#define PG8_LAS __attribute__((address_space(3)))
typedef unsigned short bf16_t;
typedef short bf16x8 __attribute__((ext_vector_type(8)));
typedef float f32x4 __attribute__((ext_vector_type(4)));
typedef unsigned u32x4 __attribute__((ext_vector_type(4)));
constexpr int BM = 256, BK = 64, HALF = 128, HTB = HALF * BK * 2  , STAGE_BYTES = 8 * HTB, NXCD = 8, WGM = 8;

__host__ __device__ __forceinline__ int lds_byte(int r, int c) { const int st = (r >> 4) * 2 + (c >> 5), rr = r & 15, cc = c & 31, ob = rr * 64 + cc * 2; return st * 1024 + (ob ^ (((ob >> 9) & 1) << 5)); }
__host__ __device__ __forceinline__ void stage_rc(int b, int& R, int& C) { const int st = b / 1024, sb = b % 1024, swz = sb ^ (((sb >> 9) & 1) << 5); R = (st >> 1) * 16 + swz / 64; C = (st & 1) * 32 + (swz % 64) / 2; }
__host__ __device__ __forceinline__ int perm32(int rho) { const int n = rho >> 4, i = rho & 15; return 8 * (i >> 2) + 4 * n + (i & 3); }

struct Unit { int pm, pn; };
struct Gemm { const bf16_t* A; const bf16_t* Bt; int M, N, K; };

struct StaticOrder {
    int nM, nN, nwg, G, c;
    __host__ __device__ void init(int M, int N, int G_, int c_) { nM = M / BM; nN = N / BM; nwg = nM * nN; G = G_; c = c_; }
    __host__ __device__ bool next(int i, Unit& u) const {
        const long L = (long)i * G + c; if (L >= nwg) return false;
        int wgid = (int)L; { const int q = nwg / NXCD, r = nwg % NXCD, xcd = wgid % NXCD, off = wgid / NXCD; wgid = (xcd < r ? xcd * (q + 1) : r * (q + 1) + (xcd - r) * q) + off; }
        const int nig = WGM * nN, gid = wgid / nig, fm = gid * WGM, gsz = (nM - fm) < WGM ? (nM - fm) : WGM;
        u.pm = fm + ((wgid % nig) % gsz); u.pn = (wgid % nig) / gsz; return true;
    }
    __device__ __forceinline__ void a_ready(const Unit&) const {}
    __device__ __forceinline__ void done(const Unit&) const {}
};

__device__ __forceinline__ unsigned cvt_pk_bf16(float lo, float hi) { unsigned r; asm volatile("v_cvt_pk_bf16_f32 %0, %1, %2" : "=v"(r) : "v"(lo), "v"(hi)); return r; }
typedef float f32x2 __attribute__((ext_vector_type(2)));
typedef unsigned u32x4_t __attribute__((ext_vector_type(4)));
__device__ __forceinline__ u32x4_t pack8(f32x4 v0, f32x4 v1) { u32x4_t w; w.x = cvt_pk_bf16(v0[0], v0[1]); w.y = cvt_pk_bf16(v0[2], v0[3]); w.z = cvt_pk_bf16(v1[0], v1[1]); w.w = cvt_pk_bf16(v1[2], v1[3]); return w; }
struct EpiInProj {
    static constexpr bool PERM = true, AFTER_DRAIN = false;
    bf16_t* seg0; size_t seg_stride; float* out; float* ksum;
    __device__ __forceinline__ void operator()(const f32x4 (&acc)[2][2][4][2], const Unit& u, int wr, int wc, int fr, int fq) const {
        const int seg = u.pn >> 1;
        const float sc = (seg == 0) ? 0.125f : ((seg == 4) ? 0.08838834764831845f : 1.0f);
        bf16_t* base = seg0 + (size_t)seg * seg_stride;
        const int cs0 = (u.pn & 1) * 256 + wc * 32 + 8 * fq;
        const int row0 = u.pm * BM + wr * 64 + fr;
        const bool kv = (seg == 1) || (seg == 2);
        const bool prompt = u.pm < (MP / BM);
        float* fo = out + (prompt ? (seg == 1 ? O_KP : O_VP) : (seg == 1 ? O_KS : O_VS));
        const int frow0 = prompt ? row0 : row0 - MP;
        f32x4 cs[2][2];
#pragma unroll
        for (int bj = 0; bj < 2; ++bj)
#pragma unroll
            for (int n = 0; n < 2; ++n) cs[bj][n] = (f32x4){0.f, 0.f, 0.f, 0.f};
#pragma unroll
        for (int ai = 0; ai < 2; ++ai)
#pragma unroll
            for (int m = 0; m < 4; ++m) {
                bf16_t* rowp = base + (size_t)(row0 + ai * HALF + m * 16) * 512 + cs0;
#pragma unroll
                for (int bj = 0; bj < 2; ++bj) {
                    f32x4 v0 = acc[ai][bj][m][0], v1 = acc[ai][bj][m][1];
                    if (kv) { float* fp = fo + (size_t)(frow0 + ai * HALF + m * 16) * 512 + cs0 + bj * HALF; *(f32x4*)fp = v0; *(f32x4*)(fp + 4) = v1; }
                    if (seg == 1) { cs[bj][0] += v0; cs[bj][1] += v1; }
                    v0 = v0 * sc; v1 = v1 * sc;
                    *(u32x4_t*)(rowp + bj * HALF) = pack8(v0, v1);
                }
            }
        if (seg == 1 && prompt) {
#pragma unroll
            for (int bj = 0; bj < 2; ++bj)
#pragma unroll
                for (int n = 0; n < 2; ++n)
#pragma unroll
                    for (int j = 0; j < 4; ++j) {
                        float v = cs[bj][n][j];
                        v += __shfl_xor(v, 1); v += __shfl_xor(v, 2); v += __shfl_xor(v, 4); v += __shfl_xor(v, 8);
                        if (fr == 0) __hip_atomic_fetch_add(ksum + (size_t)u.pm * 512 + cs0 + bj * HALF + n * 4 + j, v, __ATOMIC_RELAXED, __HIP_MEMORY_SCOPE_AGENT);
                    }
        }
    }
};
struct EpiResid {
    static constexpr bool PERM = false, AFTER_DRAIN = false;
    const float* xp; const float* xs; float* x1;
    __device__ __forceinline__ void operator()(const f32x4 (&acc)[2][2][4][2], const Unit& u, int wr, int wc, int fr, int fq) const {
        const int row0 = u.pm * BM + wr * 64 + fr, col0 = u.pn * BM + wc * 32 + 4 * fq;
        const float* src = (u.pm < (MP / BM)) ? xp + (size_t)row0 * D : xs + (size_t)(row0 - MP) * D;
        float* dst = x1 + (size_t)row0 * D;
#pragma unroll
        for (int ai = 0; ai < 2; ++ai)
#pragma unroll
            for (int m = 0; m < 4; ++m) {
                const size_t off = (size_t)(ai * HALF + m * 16) * D + col0;
#pragma unroll
                for (int bj = 0; bj < 2; ++bj)
#pragma unroll
                    for (int n = 0; n < 2; ++n) { const f32x4 xv = *(const f32x4*)(src + off + bj * HALF + n * 16); *(f32x4*)(dst + off + bj * HALF + n * 16) = xv + acc[ai][bj][m][n]; }
            }
    }
};
struct EpiAccum {
    static constexpr bool PERM = false, AFTER_DRAIN = false;
    float* x1;
    __device__ __forceinline__ void operator()(const f32x4 (&acc)[2][2][4][2], const Unit& u, int wr, int wc, int fr, int fq) const {
        const int row0 = u.pm * BM + wr * 64 + fr, col0 = u.pn * BM + wc * 32 + 4 * fq;
        float* dst = x1 + (size_t)row0 * D;
#pragma unroll
        for (int ai = 0; ai < 2; ++ai)
#pragma unroll
            for (int m = 0; m < 4; ++m) {
                const size_t off = (size_t)(ai * HALF + m * 16) * D + col0;
#pragma unroll
                for (int bj = 0; bj < 2; ++bj)
#pragma unroll
                    for (int n = 0; n < 2; ++n) { float* p = dst + off + bj * HALF + n * 16; const f32x4 xv = *(const f32x4*)p; *(f32x4*)p = xv + acc[ai][bj][m][n]; }
            }
    }
};
struct EpiRelu2 {
    static constexpr bool PERM = true, AFTER_DRAIN = false;
    bf16_t* U;
    __device__ __forceinline__ void operator()(const f32x4 (&acc)[2][2][4][2], const Unit& u, int wr, int wc, int fr, int fq) const {
        const int row0 = u.pm * BM + wr * 64 + fr, col0 = u.pn * BM + wc * 32 + 8 * fq;
#pragma unroll
        for (int ai = 0; ai < 2; ++ai)
#pragma unroll
            for (int m = 0; m < 4; ++m) {
                bf16_t* rowp = U + (size_t)(row0 + ai * HALF + m * 16) * FF + col0;
#pragma unroll
                for (int bj = 0; bj < 2; ++bj) {
                    f32x4 v0 = acc[ai][bj][m][0], v1 = acc[ai][bj][m][1];
#pragma unroll
                    for (int j = 0; j < 4; ++j) { const float a = fmaxf(v0[j], 0.f), b = fmaxf(v1[j], 0.f); v0[j] = a * a; v1[j] = b * b; }
                    *(u32x4_t*)(rowp + bj * HALF) = pack8(v0, v1);
                }
            }
    }
};

template <class Epi, class Sched, bool ALIGN_EPI = false, bool SP2 = false>
__device__ __forceinline__ void gemm_phase(PG8_LAS unsigned char* lds, const Gemm g, const Sched& S, const Epi& E) {
    const int tid = threadIdx.x, wid = __builtin_amdgcn_readfirstlane(tid >> 6), lane = tid & 63, wr = wid >> 2, wc = wid & 3, fr = lane & 15, fq = lane >> 4;
    const int K = g.K, nt = K / BK;
    unsigned voffA[2], voffB[2];
#pragma unroll
    for (int i = 0; i < 2; ++i) { int R, C; stage_rc(tid * 16 + i * 8192, R, C); const int Rb = Epi::PERM ? ((R & ~31) + perm32(R & 31)) : R;
        voffA[i] = (unsigned)(R * K + C) * 2u; voffB[i] = (unsigned)(Rb * K + C) * 2u; }
    const size_t kstep = (size_t)(BK * 2);
    const size_t hstep = (size_t)HALF * K * 2;
    const size_t tstep = 2 * hstep;
    const unsigned ldsw = (unsigned)wid * 1024u;
    const int aoff = lds_byte(wr * 64 + fr, fq * 8), boff = lds_byte(wc * 32 + fr, fq * 8);
#define PG8_SA(b, h) (((b) * 2 + (h)) * HTB)
#define PG8_SB(b, h) ((4 + (b) * 2 + (h)) * HTB)
#define PG8_STAGE(bufoff, gbase, voff) do { _Pragma("unroll") for (int _i = 0; _i < 2; ++_i) \
        __builtin_amdgcn_global_load_lds((const unsigned*)((const char*)(gbase) + (voff)[_i]), (PG8_LAS unsigned*)(lds + (bufoff) + ldsw + _i * 8192), 16, 0, 0); } while (0)
#define PG8_LDA(dst, b, h) do { _Pragma("unroll") for (int m = 0; m < 4; ++m) _Pragma("unroll") for (int k = 0; k < 2; ++k) dst[m][k] = *(const PG8_LAS bf16x8*)(lds + PG8_SA(b, h) + aoff + m * 2048 + k * 1024); } while (0)
#define PG8_LDB(dst, b, h) do { _Pragma("unroll") for (int n = 0; n < 2; ++n) _Pragma("unroll") for (int k = 0; k < 2; ++k) dst[n][k] = *(const PG8_LAS bf16x8*)(lds + PG8_SB(b, h) + boff + n * 2048 + k * 1024); } while (0)
#define PG8_MMA(ai, bj, At, Bt) do { __builtin_amdgcn_s_setprio(1); _Pragma("unroll") for (int m = 0; m < 4; ++m) _Pragma("unroll") for (int n = 0; n < 2; ++n) _Pragma("unroll") for (int k = 0; k < 2; ++k) \
        acc[ai][bj][m][n] = __builtin_amdgcn_mfma_f32_16x16x32_bf16(Bt[n][k], At[m][k], acc[ai][bj][m][n], 0, 0, 0); __builtin_amdgcn_s_setprio(0); } while (0)
#define PG8_WAIT_V(n) asm volatile("s_waitcnt vmcnt(" #n ")" ::: "memory")
#define PG8_WAIT_L(n) asm volatile("s_waitcnt lgkmcnt(" #n ")" ::: "memory")
#define PG8_BAR __builtin_amdgcn_s_barrier()
#define PG8_SCHED __builtin_amdgcn_sched_barrier(0)
    Unit cur, nxt; int ui = 0;
    if (!S.next(0, cur)) return;
    f32x4 acc[2][2][4][2];
#pragma unroll
    for (int a = 0; a < 2; ++a)
#pragma unroll
        for (int b = 0; b < 2; ++b)
#pragma unroll
            for (int m = 0; m < 4; ++m)
#pragma unroll
                for (int n = 0; n < 2; ++n) acc[a][b][m][n] = (f32x4){0.f, 0.f, 0.f, 0.f};
    bf16x8 At[4][2], B0[2][2], B1[2][2];
    const char* cA = (const char*)g.A + (size_t)cur.pm * tstep; const char* cB = (const char*)g.Bt + (size_t)cur.pn * tstep;
    S.a_ready(cur);
    if constexpr (SP2) {
        PG8_STAGE(PG8_SB(0, 0), cB, voffB); PG8_STAGE(PG8_SB(0, 1), cB + hstep, voffB); PG8_STAGE(PG8_SA(0, 0), cA, voffA); PG8_STAGE(PG8_SA(0, 1), cA + hstep, voffA);
        if (wr == 1) PG8_BAR;
        PG8_WAIT_V(2); PG8_BAR;
        PG8_STAGE(PG8_SB(1, 0), cB + kstep, voffB); PG8_STAGE(PG8_SA(1, 0), cA + kstep, voffA); PG8_STAGE(PG8_SB(1, 1), cB + hstep + kstep, voffB);
        PG8_WAIT_V(6); PG8_BAR;
    } else {
        PG8_STAGE(PG8_SB(0, 0), cB, voffB); PG8_STAGE(PG8_SA(0, 0), cA, voffA); PG8_STAGE(PG8_SB(0, 1), cB + hstep, voffB); PG8_STAGE(PG8_SA(0, 1), cA + hstep, voffA);
        if (wr == 1) PG8_BAR;
        PG8_WAIT_V(4); PG8_BAR;
        PG8_STAGE(PG8_SB(1, 0), cB + kstep, voffB); PG8_STAGE(PG8_SA(1, 0), cA + kstep, voffA); PG8_STAGE(PG8_SB(1, 1), cB + hstep + kstep, voffB);
        PG8_WAIT_V(6); PG8_BAR;
    }
    for (;;) {
        const bool has_next = S.next(ui + 1, nxt);
        const char* nA = has_next ? (const char*)g.A + (size_t)nxt.pm * tstep : cA; const char* nB = has_next ? (const char*)g.Bt + (size_t)nxt.pn * tstep : cB;
        for (int t = 0; t < nt; t += 2) {
            const bool last = (t == nt - 2);
            const char* a1 = cA + (size_t)(t + 1) * kstep;
            const char* a2 = last ? nA : cA + (size_t)(t + 2) * kstep; const char* b2 = last ? nB : cB + (size_t)(t + 2) * kstep;
            const char* a3 = a2 + kstep; const char* b3 = b2 + kstep;
            if (last && has_next) S.a_ready(nxt);
            if constexpr (SP2) {
            PG8_LDB(B0, 0, 0); PG8_LDB(B1, 0, 1); PG8_SCHED; PG8_LDA(At, 0, 0); PG8_STAGE(PG8_SA(1, 1), a1 + hstep, voffA);
            PG8_WAIT_V(8); PG8_WAIT_L(0); PG8_BAR; PG8_MMA(0, 0, At, B0); PG8_MMA(0, 1, At, B1); PG8_BAR; PG8_SCHED;
            PG8_LDA(At, 0, 1); PG8_STAGE(PG8_SB(0, 0), b2, voffB); PG8_STAGE(PG8_SB(0, 1), b2 + hstep, voffB); PG8_STAGE(PG8_SA(0, 0), a2, voffA);
            PG8_WAIT_V(8); PG8_WAIT_L(0); PG8_BAR; PG8_MMA(1, 0, At, B0); PG8_MMA(1, 1, At, B1); PG8_BAR; PG8_SCHED;
            PG8_LDB(B0, 1, 0); PG8_LDB(B1, 1, 1); PG8_SCHED; PG8_LDA(At, 1, 0); PG8_STAGE(PG8_SA(0, 1), a2 + hstep, voffA);
            PG8_WAIT_V(8); PG8_WAIT_L(0); PG8_BAR; PG8_MMA(0, 0, At, B0); PG8_MMA(0, 1, At, B1); PG8_BAR; PG8_SCHED;
            PG8_LDA(At, 1, 1); PG8_STAGE(PG8_SB(1, 0), b3, voffB); PG8_STAGE(PG8_SB(1, 1), b3 + hstep, voffB); PG8_STAGE(PG8_SA(1, 0), a3, voffA);
            PG8_WAIT_V(8); PG8_WAIT_L(0); PG8_BAR; PG8_MMA(1, 0, At, B0); PG8_MMA(1, 1, At, B1); PG8_BAR; PG8_SCHED;
            } else {
            PG8_LDB(B0, 0, 0); PG8_SCHED; PG8_LDA(At, 0, 0); PG8_STAGE(PG8_SA(1, 1), a1 + hstep, voffA);
            PG8_WAIT_L(8); PG8_BAR; PG8_WAIT_L(0); PG8_MMA(0, 0, At, B0); PG8_BAR; PG8_SCHED;
            PG8_LDB(B1, 0, 1); PG8_STAGE(PG8_SB(0, 0), b2, voffB);
            PG8_BAR; PG8_WAIT_L(0); PG8_MMA(0, 1, At, B1); PG8_BAR;
            PG8_LDA(At, 0, 1); PG8_STAGE(PG8_SA(0, 0), a2, voffA);
            PG8_BAR; PG8_WAIT_L(0); PG8_MMA(1, 0, At, B0); PG8_BAR; PG8_SCHED;
            PG8_STAGE(PG8_SB(0, 1), b2 + hstep, voffB);
            PG8_WAIT_V(6); PG8_BAR; PG8_MMA(1, 1, At, B1); PG8_BAR;
            PG8_LDB(B0, 1, 0); PG8_SCHED; PG8_LDA(At, 1, 0); PG8_STAGE(PG8_SA(0, 1), a2 + hstep, voffA);
            PG8_WAIT_L(8); PG8_BAR; PG8_WAIT_L(0); PG8_MMA(0, 0, At, B0); PG8_BAR; PG8_SCHED;
            PG8_LDB(B1, 1, 1); PG8_STAGE(PG8_SB(1, 0), b3, voffB);
            PG8_BAR; PG8_WAIT_L(0); PG8_MMA(0, 1, At, B1); PG8_BAR;
            PG8_LDA(At, 1, 1); PG8_STAGE(PG8_SA(1, 0), a3, voffA);
            PG8_BAR; PG8_WAIT_L(0); PG8_MMA(1, 0, At, B0); PG8_BAR; PG8_SCHED;
            PG8_STAGE(PG8_SB(1, 1), b3 + hstep, voffB);
            PG8_WAIT_V(6); PG8_BAR; PG8_MMA(1, 1, At, B1); PG8_BAR;
            }
        }
        if constexpr (ALIGN_EPI) { if (wr == 0) PG8_BAR; }
        if constexpr (!Epi::AFTER_DRAIN) { E(acc, cur, wr, wc, fr, fq); S.done(cur); }
        if (!has_next) break;
#pragma unroll
        for (int a = 0; a < 2; ++a)
#pragma unroll
            for (int b = 0; b < 2; ++b)
#pragma unroll
                for (int m = 0; m < 4; ++m)
#pragma unroll
                    for (int n = 0; n < 2; ++n) acc[a][b][m][n] = (f32x4){0.f, 0.f, 0.f, 0.f};
        cur = nxt; cA = nA; cB = nB; ++ui;
        if constexpr (ALIGN_EPI) { if (wr == 1) PG8_BAR; }
    }
    PG8_WAIT_V(0);
    if constexpr (!ALIGN_EPI) { if (wr == 0) PG8_BAR; }
    PG8_BAR;
    if constexpr (Epi::AFTER_DRAIN) { E.fused(acc, cur, wr, wc, fr, fq, lds, wid, lane); S.done(cur); }
#undef PG8_SA
#undef PG8_SB
#undef PG8_STAGE
#undef PG8_LDA
#undef PG8_LDB
#undef PG8_MMA
#undef PG8_WAIT_V
#undef PG8_WAIT_L
#undef PG8_BAR
#undef PG8_SCHED
}
}

constexpr int NWAVES = 8;
constexpr size_t MiB = 1u << 20;
constexpr size_t WS_CTL = 0, CTL_ZERO_BYTES = 1 * MiB;
constexpr size_t WS_KSUM = 512 * 1024;
constexpr size_t WS_WIN = 2 * MiB, WS_WOUT = 10 * MiB, WS_WUP = 12 * MiB, WS_WDN = 20 * MiB;
constexpr size_t WS_GATE = 28 * MiB;
constexpr size_t WS_KSUMS = 29 * MiB;
constexpr size_t WS_XN = 32 * MiB;
constexpr size_t WS_SEG = 65 * MiB, SEG_BYTES = 17 * MiB;
constexpr size_t WS_H = 184 * MiB;
constexpr size_t WS_MIX = 217 * MiB;
constexpr size_t WS_X1 = 250 * MiB;
constexpr size_t WS_U = 320 * MiB;
constexpr size_t WS_END = 452 * MiB;
constexpr int CW_BAR = 4096;
constexpr int RING_OFF = 0, RING_BYTES = 131072;
constexpr int LDSCTL_OFF = RING_BYTES, MISC_OFF = LDSCTL_OFF + 320;
constexpr int LDS_BYTES = 147456;
#define GAS __attribute__((address_space(1)))
#define LAS __attribute__((address_space(3)))
typedef unsigned short bf16;
typedef unsigned v4u __attribute__((ext_vector_type(4)));
typedef float f32x4 __attribute__((ext_vector_type(4)));
typedef short bf16x8 __attribute__((ext_vector_type(8)));
typedef GAS unsigned gu32;
typedef GAS unsigned long long gu64;
#define RLX_AGENT __ATOMIC_RELAXED, __HIP_MEMORY_SCOPE_AGENT
#define LDS_WAIT() asm volatile("s_waitcnt lgkmcnt(0)" ::: "memory")
#define VM_WAIT() asm volatile("s_waitcnt vmcnt(0)" ::: "memory")
__device__ __forceinline__ unsigned long long rt() { return __builtin_amdgcn_s_memrealtime(); }
__device__ __forceinline__ unsigned f2bf(float f) { unsigned u = __builtin_bit_cast(unsigned, f); return (u + 0x7fffu + ((u >> 16) & 1u)) >> 16; }
__device__ __forceinline__ unsigned pk2(float lo, float hi) { return f2bf(lo) | (f2bf(hi) << 16); }

#define XB_TMO      128
#define XB_XCNT(j)  (256  + 64 * (j))
#define XB_XSUB(j)  (1280 + 64 * (j))
#define XB_XGEN(j)  (2304 + 64 * (j))
#define XB_TOP      3328
#define XB_TOPGEN   3392
#define XCD_BAR_WORDS 3456
#define XB_SPIN_CAP (1u << 18)

__device__ __forceinline__ unsigned xb_ld(unsigned* p)              { return __hip_atomic_load(p, __ATOMIC_RELAXED, __HIP_MEMORY_SCOPE_AGENT); }
__device__ __forceinline__ unsigned xb_add(unsigned* p, unsigned v) { return __hip_atomic_fetch_add(p, v, __ATOMIC_RELAXED, __HIP_MEMORY_SCOPE_AGENT); }
__device__ __forceinline__ unsigned xb_xcc_id() { return (unsigned)__builtin_amdgcn_s_getreg((3 << 11) | 20) & 0xFu; }
#define XB_SPIN(cond, bar) do { unsigned _sp = 0; while (cond) { __builtin_amdgcn_s_sleep(1); \
    if ((++_sp & 255u) == 0u) { if (xb_ld(&(bar)[XB_TMO])) break; if (_sp > XB_SPIN_CAP) { atomicAdd(&(bar)[XB_TMO], 1u); break; } } } } while (0)

struct XcdBarrier {
    unsigned* bar; unsigned x;
    volatile LAS unsigned* st;
};

__device__ __forceinline__ XcdBarrier xcd_barrier_post(unsigned* bar, volatile LAS unsigned* st) {
    XcdBarrier b; b.bar = bar; b.x = xb_xcc_id(); b.st = st;
    if (threadIdx.x == 0) (void)xb_add(&bar[XB_XCNT(b.x)], 1u);
    return b;
}
__device__ __forceinline__ void xcd_barrier_complete(unsigned* bar, unsigned x, unsigned& nloc, unsigned& nx) {
    const unsigned G = gridDim.x * gridDim.y * gridDim.z;
    unsigned sum, cnt, mine, sp = 0u;
    for (;;) {
        sum = 0u; cnt = 0u; mine = 0u;
#pragma unroll
        for (unsigned j = 0; j < 16; ++j) { const unsigned c = xb_ld(&bar[XB_XCNT(j)]); sum += c; cnt += (c > 0u) ? 1u : 0u; mine = (j == x) ? c : mine; }
        if (sum == G) break;
        __builtin_amdgcn_s_sleep(1);
        if ((++sp & 255u) == 0u) { if (xb_ld(&bar[XB_TMO])) break; if (sp > XB_SPIN_CAP) { atomicAdd(&bar[XB_TMO], 1u); break; } }
    }
    nloc = mine > 0u ? mine : 1u; nx = cnt > 0u ? cnt : 1u;
}

__device__ __forceinline__ void xcd_barrier(const XcdBarrier& b) {
    asm volatile("s_waitcnt vmcnt(0)" ::: "memory");
    __syncthreads();
    if (threadIdx.x == 0) {
        unsigned* bar = b.bar;
        __builtin_amdgcn_s_waitcnt(0);
        unsigned nloc = b.st[0], nx = b.st[1];
        if (nloc == 0u) { xcd_barrier_complete(bar, b.x, nloc, nx); b.st[0] = nloc; b.st[1] = nx; }
        const unsigned old = xb_add(&bar[XB_XSUB(b.x)], 1u);
        const unsigned gen = old / nloc;
        if (old + 1u == (gen + 1u) * nloc) {
            __builtin_amdgcn_fence(__ATOMIC_RELEASE, "agent");
            asm volatile("s_waitcnt vmcnt(0)" ::: "memory");
            const unsigned og = xb_add(&bar[XB_TOP], 1u);
            const unsigned tg = og / nx;
            if (og + 1u == (tg + 1u) * nx) xb_add(&bar[XB_TOPGEN], 1u);
            else XB_SPIN(xb_ld(&bar[XB_TOPGEN]) == tg, bar);
            __builtin_amdgcn_fence(__ATOMIC_ACQUIRE, "agent");
            xb_add(&bar[XB_XGEN(b.x)], 1u);
            asm volatile("s_waitcnt vmcnt(0)" ::: "memory");
        } else {
            XB_SPIN(xb_ld(&bar[XB_XGEN(b.x)]) == gen, bar);
            __builtin_amdgcn_fence(__ATOMIC_ACQUIRE, "agent");
            asm volatile("s_waitcnt vmcnt(0)" ::: "memory");
        }
    }
    __syncthreads();
}

struct Frame {
    LAS unsigned char* lds;
    volatile LAS unsigned* MISC;
    gu32* ctl;
    int tid, lane, wave, vcu, G;
    const float *xp, *xs, *cache_k, *cache_v, *state_C, *state_n, *state_m; const int* page_table;
    const float *rel_bias, *norm_mix, *w_in, *b_ig, *b_fg, *ml_norm, *w_out, *norm_ffn, *w_up, *w_down, *norm_final;
    float* out;
    bf16 *Win_t, *Wout_t, *Wup_t, *Wdn_t, *XN, *SEG, *MIX, *U;
    float *KSUM, *KSUMS, *IG, *LF, *H, *X1;
};
constexpr size_t SEG_ELEMS = SEG_BYTES / 2;
#define SEG_AQ(F) ((F).SEG + 0 * SEG_ELEMS)
#define SEG_AK(F) ((F).SEG + 1 * SEG_ELEMS)
#define SEG_AV(F) ((F).SEG + 2 * SEG_ELEMS)
#define SEG_MQ(F) ((F).SEG + 3 * SEG_ELEMS)
#define SEG_MK(F) ((F).SEG + 4 * SEG_ELEMS)
#define SEG_MV(F) ((F).SEG + 5 * SEG_ELEMS)
#define SEG_MO(F) ((F).SEG + 6 * SEG_ELEMS)

__device__ __forceinline__ float bf2f(unsigned short b) { return __builtin_bit_cast(float, (unsigned)b << 16); }
__device__ __forceinline__ float wave_sum(float v) {
#pragma unroll
    for (int o = 1; o < 64; o <<= 1) v += __shfl_xor(v, o);
    return v;
}
__device__ __forceinline__ void p0_transpose_item(const float* W, int K, int ldw, int N, bf16* WT, LAS float* scr, int item, int lane) {
    const int nblk = N / 32, kb = item / nblk, nb = item % nblk, k0 = 64 * kb, n0 = 32 * nb;
#pragma unroll 8
    for (int i = 0; i < 32; ++i) { const int kk = 2 * i + (lane >> 5); scr[kk * 33 + (lane & 31)] = W[(size_t)(k0 + kk) * ldw + n0 + (lane & 31)]; }
    LDS_WAIT(); asm volatile("" ::: "memory");
    const int c = lane & 7;
#pragma unroll
    for (int j = 0; j < 4; ++j) { const int n = (lane >> 3) + 8 * j; const LAS float* s = scr + (8 * c) * 33 + n;
        v4u o; o.x = pk2(s[0 * 33], s[1 * 33]); o.y = pk2(s[2 * 33], s[3 * 33]); o.z = pk2(s[4 * 33], s[5 * 33]); o.w = pk2(s[6 * 33], s[7 * 33]);
        *(GAS v4u*)(WT + (size_t)(n0 + n) * K + k0 + 8 * c) = o; }
    LDS_WAIT(); asm volatile("" ::: "memory");
}
template <bool GATES>
__device__ __forceinline__ void rms_row_to_bf16(Frame& F, const float* xrow, const float* gain, bf16* orow, int m) {
    const GAS f32x4* xr = (const GAS f32x4*)xrow + F.lane; const GAS f32x4* gr = (const GAS f32x4*)gain + F.lane;
    f32x4 v[4]; float s = 0.f;
#pragma unroll
    for (int j = 0; j < 4; ++j) { v[j] = xr[64 * j]; s += (v[j].x * v[j].x + v[j].y * v[j].y) + (v[j].z * v[j].z + v[j].w * v[j].w); }
#pragma unroll
    for (int j = 0; j < 4; ++j) v[j] = v[j] * gr[64 * j];
    float g8[8];
    if (GATES) {
#pragma unroll
        for (int c = 0; c < 8; ++c) g8[c] = 0.f;
#pragma unroll
        for (int j = 0; j < 4; ++j)
#pragma unroll
            for (int i = 0; i < 4; ++i) { const int k = 256 * j + 4 * F.lane + i; const GAS f32x4* wr = (const GAS f32x4*)(F.w_in + (size_t)k * NPROJ + NPG); const f32x4 w0 = wr[0], w1 = wr[1]; const float xv = v[j][i];
                g8[0] += xv * w0.x; g8[1] += xv * w0.y; g8[2] += xv * w0.z; g8[3] += xv * w0.w; g8[4] += xv * w1.x; g8[5] += xv * w1.y; g8[6] += xv * w1.z; g8[7] += xv * w1.w; }
    }
    const float rstd = 1.f / sqrtf(wave_sum(s) * (1.f / D) + RMS_EPS);
    GAS unsigned long long* o8 = (GAS unsigned long long*)orow + F.lane;
#pragma unroll
    for (int j = 0; j < 4; ++j) o8[64 * j] = (unsigned long long)pk2(v[j].x * rstd, v[j].y * rstd) | ((unsigned long long)pk2(v[j].z * rstd, v[j].w * rstd) << 32);
    if (GATES) {
#pragma unroll
        for (int c = 0; c < 8; ++c) g8[c] = wave_sum(g8[c]) * rstd;
        if (F.lane < 8) { float z = 0.f;
#pragma unroll
            for (int c = 0; c < 8; ++c) z = (F.lane == c) ? g8[c] : z;
            if (F.lane < 4) { F.IG[(size_t)m * 4 + F.lane] = z + F.b_ig[F.lane]; }
            else { const int h = F.lane - 4; z += F.b_fg[h]; F.LF[(size_t)m * 4 + h] = fminf(z, 0.f) - log1pf(expf(-fabsf(z))); } }
    }
}
__device__ __forceinline__ const float* xrow_of(Frame& F, int m) { return (m < MP) ? F.xp + (size_t)m * D : F.xs + (size_t)(m - MP) * D; }

__device__ __forceinline__ void p0_prologue(Frame& F) {
    LAS float* scr = (LAS float*)(F.lds + RING_OFF + F.wave * 16384);
    const int gw = F.vcu * NWAVES + F.wave, NGW = F.G * NWAVES;
    constexpr int I_IN = (D / 64) * (NPG / 32), I_O = (D / 64) * (D / 32), I_UP = (D / 64) * (FF / 32), I_DN = (FF / 64) * (D / 32);
    constexpr int NITEMS = I_IN + I_O + I_UP + I_DN;
    for (int it = gw; it < NITEMS; it += NGW) {
        int r = it;
        if (r < I_IN) { p0_transpose_item(F.w_in, D, NPROJ, NPG, F.Win_t, scr, r, F.lane); continue; } r -= I_IN;
        if (r < I_O) { p0_transpose_item(F.w_out, D, D, D, F.Wout_t, scr, r, F.lane); continue; } r -= I_O;
        if (r < I_UP) { p0_transpose_item(F.w_up, D, FF, FF, F.Wup_t, scr, r, F.lane); continue; } r -= I_UP;
        p0_transpose_item(F.w_down, FF, D, D, F.Wdn_t, scr, r, F.lane);
    }
    for (int m = gw; m < M; m += NGW) rms_row_to_bf16<true>(F, xrow_of(F, m), F.norm_mix, F.XN + (size_t)m * D, m);
    for (int u = gw; u < DB * NBLK_S; u += NGW) {
        const int sb = u / NBLK_S, n = u % NBLK_S;
        f32x4 a0 = {0.f, 0.f, 0.f, 0.f}, a1 = {0.f, 0.f, 0.f, 0.f};
#pragma unroll
        for (int pg = 0; pg < 2; ++pg) {
            const int page = F.page_table[sb * NPAGES + 2 * n + pg];
            const GAS f32x4* base = (const GAS f32x4*)(F.cache_k + (size_t)page * PAGE * AW) + 2 * F.lane;
#pragma unroll 8
            for (int r = 0; r < PAGE; ++r) { a0 += base[(size_t)r * (AW / 4)]; a1 += base[(size_t)r * (AW / 4) + 1]; }
        }
        GAS f32x4* o = (GAS f32x4*)(F.KSUMS + (size_t)u * AW) + 2 * F.lane; o[0] = a0; o[1] = a1;
    }
}

__device__ __forceinline__ int t5_bucket_small(int n) {
    if (n < 16) return n;
    int b = 16 + (int)(logf((float)n * (1.0f / 16.0f)) / 2.0794415416798357f * 16.0f);
    return b < 31 ? b : 31;
}

__device__ __forceinline__ void naive_attn_prompt(Frame& F, const LAS int* bucket) {
    const int gid = blockIdx.x * (NWAVES * 64) + F.tid, nth = F.G * NWAVES * 64;
    for (int idx = gid; idx < MP * AH; idx += nth) {
        const int m = idx >> 3, h = idx & 7, b = m >> 12, t = m & 4095, own = t >> 8;
        float q[64];
        { const v4u* qp = (const v4u*)(SEG_AQ(F) + (size_t)m * AW + h * AD);
#pragma unroll
          for (int c = 0; c < 8; ++c) { const v4u w = qp[c];
              q[8 * c + 0] = __builtin_bit_cast(float, w.x << 16); q[8 * c + 1] = __builtin_bit_cast(float, w.x & 0xffff0000u);
              q[8 * c + 2] = __builtin_bit_cast(float, w.y << 16); q[8 * c + 3] = __builtin_bit_cast(float, w.y & 0xffff0000u);
              q[8 * c + 4] = __builtin_bit_cast(float, w.z << 16); q[8 * c + 5] = __builtin_bit_cast(float, w.z & 0xffff0000u);
              q[8 * c + 6] = __builtin_bit_cast(float, w.w << 16); q[8 * c + 7] = __builtin_bit_cast(float, w.w & 0xffff0000u); } }
        float s0 = -INFINITY, s1 = -INFINITY, s2 = -INFINITY; int i0 = -1, i1 = -1, i2 = -1;
        for (int n = 0; n < own; ++n) {
            const float* ks = F.KSUM + ((size_t)(b * NBLK_P + n)) * AW + h * AD; float s = 0.f;
#pragma unroll
            for (int d = 0; d < 64; ++d) s += q[d] * ks[d];
            if (s > s0) { s2 = s1; i2 = i1; s1 = s0; i1 = i0; s0 = s; i0 = n; }
            else if (s > s1) { s2 = s1; i2 = i1; s1 = s; i1 = n; }
            else if (s > s2) { s2 = s; i2 = n; }
        }
        float o[64];
#pragma unroll
        for (int d = 0; d < 64; ++d) o[d] = 0.f;
        float mx = -1e30f, l = 0.f;
        const float b31 = F.rel_bias[31 * AH + h];
        for (int j = 0; j < 4; ++j) {
            const int blk = (j == 0) ? own : (j == 1 ? i0 : (j == 2 ? i1 : i2));
            if (blk < 0) continue;
            const int kend = (blk == own) ? (t - own * 256 + 1) : 256;
            for (int p = 0; p < kend; ++p) {
                const int kpos = blk * 256 + p, dist = t - kpos;
                const size_t krow = ((size_t)(b * SEQ + kpos)) * AW + h * AD;
                const v4u* kp = (const v4u*)(SEG_AK(F) + krow); float s = 0.f;
#pragma unroll
                for (int c = 0; c < 8; ++c) { const v4u w = kp[c];
                    s += q[8 * c + 0] * __builtin_bit_cast(float, w.x << 16) + q[8 * c + 1] * __builtin_bit_cast(float, w.x & 0xffff0000u)
                       + q[8 * c + 2] * __builtin_bit_cast(float, w.y << 16) + q[8 * c + 3] * __builtin_bit_cast(float, w.y & 0xffff0000u)
                       + q[8 * c + 4] * __builtin_bit_cast(float, w.z << 16) + q[8 * c + 5] * __builtin_bit_cast(float, w.z & 0xffff0000u)
                       + q[8 * c + 6] * __builtin_bit_cast(float, w.w << 16) + q[8 * c + 7] * __builtin_bit_cast(float, w.w & 0xffff0000u); }
                s += (dist < 128) ? F.rel_bias[bucket[dist] * AH + h] : b31;
                const float mn = fmaxf(mx, s), f = __expf(mx - mn), pw = __expf(s - mn);
                l = l * f + pw; mx = mn;
                const v4u* vp = (const v4u*)(SEG_AV(F) + krow);
#pragma unroll
                for (int c = 0; c < 8; ++c) { const v4u w = vp[c];
                    o[8 * c + 0] = o[8 * c + 0] * f + pw * __builtin_bit_cast(float, w.x << 16); o[8 * c + 1] = o[8 * c + 1] * f + pw * __builtin_bit_cast(float, w.x & 0xffff0000u);
                    o[8 * c + 2] = o[8 * c + 2] * f + pw * __builtin_bit_cast(float, w.y << 16); o[8 * c + 3] = o[8 * c + 3] * f + pw * __builtin_bit_cast(float, w.y & 0xffff0000u);
                    o[8 * c + 4] = o[8 * c + 4] * f + pw * __builtin_bit_cast(float, w.z << 16); o[8 * c + 5] = o[8 * c + 5] * f + pw * __builtin_bit_cast(float, w.z & 0xffff0000u);
                    o[8 * c + 6] = o[8 * c + 6] * f + pw * __builtin_bit_cast(float, w.w << 16); o[8 * c + 7] = o[8 * c + 7] * f + pw * __builtin_bit_cast(float, w.w & 0xffff0000u); }
            }
        }
        const float rl = 1.f / l;
        v4u* op = (v4u*)(F.MIX + (size_t)m * D + h * AD);
#pragma unroll
        for (int c = 0; c < 8; ++c) { v4u w; w.x = pk2(o[8 * c] * rl, o[8 * c + 1] * rl); w.y = pk2(o[8 * c + 2] * rl, o[8 * c + 3] * rl); w.z = pk2(o[8 * c + 4] * rl, o[8 * c + 5] * rl); w.w = pk2(o[8 * c + 6] * rl, o[8 * c + 7] * rl); op[c] = w; }
    }
}
__device__ __forceinline__ void naive_attn_sample(Frame& F, const LAS int* bucket) {
    const int gid = blockIdx.x * (NWAVES * 64) + F.tid, nth = F.G * NWAVES * 64;
    for (int idx = gid; idx < MS * AH; idx += nth) {
        const int r = idx >> 3, h = idx & 7, sb = r >> 3, st = r & 7, m = MP + r;
        float q[64];
        { const bf16* qp = SEG_AQ(F) + (size_t)m * AW + h * AD;
#pragma unroll
          for (int d = 0; d < 64; ++d) q[d] = bf2f(qp[d]); }
        float s0 = -INFINITY, s1 = -INFINITY, s2 = -INFINITY; int i0 = -1, i1 = -1, i2 = -1;
        for (int n = 0; n < NBLK_S; ++n) {
            const float* ks = F.KSUMS + ((size_t)(sb * NBLK_S + n)) * AW + h * AD; float s = 0.f;
#pragma unroll
            for (int d = 0; d < 64; ++d) s += q[d] * ks[d];
            if (s > s0) { s2 = s1; i2 = i1; s1 = s0; i1 = i0; s0 = s; i0 = n; }
            else if (s > s1) { s2 = s1; i2 = i1; s1 = s; i1 = n; }
            else if (s > s2) { s2 = s; i2 = n; }
        }
        float o[64];
#pragma unroll
        for (int d = 0; d < 64; ++d) o[d] = 0.f;
        float mx = -1e30f, l = 0.f;
        const float b31 = F.rel_bias[31 * AH + h];
        const int qpos = PAST + st;
        for (int j = 0; j < 3; ++j) {
            const int blk = (j == 0) ? i0 : (j == 1 ? i1 : i2);
            for (int p = 0; p < 256; ++p) {
                const int kpos = blk * 256 + p, dist = qpos - kpos;
                const int page = F.page_table[sb * NPAGES + 2 * blk + (p >> 7)];
                const size_t off = ((size_t)page * PAGE + (p & 127)) * AW + h * AD;
                const float* kp = F.cache_k + off; float s = 0.f;
#pragma unroll
                for (int d = 0; d < 64; ++d) s += q[d] * kp[d];
                s += (dist < 128) ? F.rel_bias[bucket[dist] * AH + h] : b31;
                const float mn = fmaxf(mx, s), f = __expf(mx - mn), pw = __expf(s - mn);
                l = l * f + pw; mx = mn;
                const float* vp = F.cache_v + off;
#pragma unroll
                for (int d = 0; d < 64; ++d) o[d] = o[d] * f + pw * vp[d];
            }
        }
        for (int p = 0; p <= st; ++p) {
            const int dist = st - p;
            const size_t off = ((size_t)(MP + sb * DS + p)) * AW + h * AD;
            const bf16* kp = SEG_AK(F) + off; float s = 0.f;
#pragma unroll
            for (int d = 0; d < 64; ++d) s += q[d] * bf2f(kp[d]);
            s += F.rel_bias[bucket[dist] * AH + h];
            const float mn = fmaxf(mx, s), f = __expf(mx - mn), pw = __expf(s - mn);
            l = l * f + pw; mx = mn;
            const bf16* vp = SEG_AV(F) + off;
#pragma unroll
            for (int d = 0; d < 64; ++d) o[d] = o[d] * f + pw * bf2f(vp[d]);
        }
        const float rl = 1.f / l;
        bf16* op = F.MIX + (size_t)m * D + h * AD;
#pragma unroll
        for (int d = 0; d < 64; ++d) op[d] = (bf16)f2bf(o[d] * rl);
    }
}
__device__ __forceinline__ void naive_mlstm_unit(Frame& F, int row0, int T, int h, int slice, const float* C0, const float* n0, const float* m0, float* Cout, float* nout, float* mout) {
    const int g = F.lane & 31, el = 2 * F.wave + (F.lane >> 5), e = 16 * slice + el;
    float C[4], nn[4], mm;
    if (C0) {
#pragma unroll
        for (int i = 0; i < 4; ++i) { C[i] = C0[(size_t)(4 * g + i) * MD + e]; nn[i] = n0[4 * g + i]; }
        mm = m0[0];
    } else {
#pragma unroll
        for (int i = 0; i < 4; ++i) { C[i] = 0.f; nn[i] = 0.f; }
        mm = 0.f;
    }
    const size_t cq = (size_t)h * MD + 4 * g, cv = (size_t)h * MD + e;
    unsigned long long qw = *(const unsigned long long*)(SEG_MQ(F) + (size_t)row0 * MW + cq), kw = *(const unsigned long long*)(SEG_MK(F) + (size_t)row0 * MW + cq);
    unsigned short vw = SEG_MV(F)[(size_t)row0 * MW + cv]; float ig = F.IG[(size_t)row0 * 4 + h], lf = F.LF[(size_t)row0 * 4 + h];
    for (int t = 0; t < T; ++t) {
        const size_t row = (size_t)(row0 + t), rn = (size_t)(row0 + ((t + 1 < T) ? t + 1 : t));
        const unsigned long long qw_n = *(const unsigned long long*)(SEG_MQ(F) + rn * MW + cq), kw_n = *(const unsigned long long*)(SEG_MK(F) + rn * MW + cq);
        const unsigned short vw_n = SEG_MV(F)[rn * MW + cv]; const float ig_n = F.IG[rn * 4 + h], lf_n = F.LF[rn * 4 + h];
        const float v = bf2f(vw);
        const float mn = fmaxf(lf + mm, ig), fs = __expf(lf + mm - mn), is = __expf(ig - mn);
        float num = 0.f, den = 0.f;
#pragma unroll
        for (int i = 0; i < 4; ++i) {
            const float qv = bf2f((unsigned short)(qw >> (16 * i))), kv = bf2f((unsigned short)(kw >> (16 * i)));
            C[i] = fs * C[i] + is * kv * v; nn[i] = fs * nn[i] + is * kv;
            num += qv * C[i]; den += qv * nn[i];
        }
#pragma unroll
        for (int o = 1; o < 32; o <<= 1) { num += __shfl_xor(num, o); den += __shfl_xor(den, o); }
        mm = mn;
        if (g == 0) F.H[row * MW + h * MD + e] = num / fmaxf(fabsf(den), __expf(-mn));
        qw = qw_n; kw = kw_n; vw = vw_n; ig = ig_n; lf = lf_n;
    }
#pragma unroll
    for (int i = 0; i < 4; ++i) Cout[(size_t)(4 * g + i) * MD + e] = C[i];
    if (slice == 0 && el == 0) {
#pragma unroll
        for (int i = 0; i < 4; ++i) nout[4 * g + i] = nn[i];
        if (g == 0) mout[0] = mm;
    }
}
__device__ __forceinline__ void naive_mlstm(Frame& F) {
    const int bx = blockIdx.x;
    for (int u = bx; u < NBATCH * MH * 8; u += F.G) {
        if (bx >= 128 && F.G >= 256) break;
        const int seq = u >> 3, slice = u & 7, b = seq >> 2, h = seq & 3;
        naive_mlstm_unit(F, b * SEQ, SEQ, h, slice, nullptr, nullptr, nullptr, F.out + O_CP + (size_t)seq * MD * MD, F.out + O_NP + (size_t)seq * MD, F.out + O_MP + seq);
    }
    const int nsb = (F.G >= 256) ? F.G - 128 : F.G, sb0 = (F.G >= 256) ? bx - 128 : bx;
    if (sb0 >= 0)
        for (int u = sb0; u < DB * MH * 8; u += nsb) {
            const int seq = u >> 3, slice = u & 7, sb = seq >> 2, h = seq & 3;
            naive_mlstm_unit(F, MP + sb * DS, DS, h, slice, F.state_C + (size_t)seq * MD * MD, F.state_n + (size_t)seq * MD, F.state_m + seq,
                             F.out + O_CS + (size_t)seq * MD * MD, F.out + O_NS + (size_t)seq * MD, F.out + O_MS + seq);
        }
}
__device__ __forceinline__ void ml_gate_rows(Frame& F) {
    const int gw = F.vcu * NWAVES + F.wave, NGW = F.G * NWAVES;
    for (int m = gw; m < M; m += NGW) {
        const f32x4* hp = (const f32x4*)(F.H + (size_t)m * MW) + 2 * F.lane; const f32x4 a = hp[0], b = hp[1];
        float s = (a.x * a.x + a.y * a.y) + (a.z * a.z + a.w * a.w) + (b.x * b.x + b.y * b.y) + (b.z * b.z + b.w * b.w);
        s += __shfl_xor(s, 1); s += __shfl_xor(s, 2); s += __shfl_xor(s, 4); s += __shfl_xor(s, 8);
        const float rstd = 1.f / sqrtf(s * (1.f / MD) + RMS_EPS);
        const f32x4* gp = (const f32x4*)(F.ml_norm) + 2 * F.lane; const f32x4 g0 = gp[0], g1 = gp[1];
        const v4u mo = *((const v4u*)(SEG_MO(F) + (size_t)m * MW) + F.lane);
        float hv[8] = {a.x, a.y, a.z, a.w, b.x, b.y, b.z, b.w}, gv[8] = {g0.x, g0.y, g0.z, g0.w, g1.x, g1.y, g1.z, g1.w};
        unsigned mw[4] = {mo.x, mo.y, mo.z, mo.w}; float r[8];
#pragma unroll
        for (int i = 0; i < 8; ++i) { const float z = __builtin_bit_cast(float, (i & 1) ? (mw[i >> 1] & 0xffff0000u) : (mw[i >> 1] << 16)); r[i] = hv[i] * rstd * gv[i] / (1.f + __expf(-z)); }
        v4u w; w.x = pk2(r[0], r[1]); w.y = pk2(r[2], r[3]); w.z = pk2(r[4], r[5]); w.w = pk2(r[6], r[7]);
        *((v4u*)(F.MIX + (size_t)m * D + AW) + F.lane) = w;
    }
}
__device__ __forceinline__ void final_norm_rows(Frame& F) {
    const int gw = F.vcu * NWAVES + F.wave, NGW = F.G * NWAVES;
    for (int m = gw; m < M; m += NGW) {
        const f32x4* xr = (const f32x4*)(F.X1 + (size_t)m * D) + F.lane; const f32x4* gr = (const f32x4*)F.norm_final + F.lane;
        f32x4 v[4]; float s = 0.f;
#pragma unroll
        for (int j = 0; j < 4; ++j) { v[j] = xr[64 * j]; s += (v[j].x * v[j].x + v[j].y * v[j].y) + (v[j].z * v[j].z + v[j].w * v[j].w); }
        const float rstd = 1.f / sqrtf(wave_sum(s) * (1.f / D) + RMS_EPS);
        f32x4* o = (f32x4*)(F.out + ((m < MP) ? O_YP + (size_t)m * D : O_YS + (size_t)(m - MP) * D)) + F.lane;
#pragma unroll
        for (int j = 0; j < 4; ++j) o[64 * j] = v[j] * rstd * gr[64 * j];
    }
}

#ifndef MK_ONE_LAUNCH
#define MK_ONE_LAUNCH 0
#endif
constexpr int N_PHASES = 9;
struct Args { const void* in[19]; float* out; unsigned char* ws; int ph_lo, ph_hi; };
static_assert(sizeof(Args) == 19 * 8 + 8 + 8 + 8, "Args has no padding bytes");
__global__ void __launch_bounds__(NWAVES * 64, 2) hymba_fwd(Args args) {
    extern __shared__ __attribute__((aligned(16))) unsigned char lds[];
    Frame F;
    F.lds = (LAS unsigned char*)lds;
    F.MISC = (volatile LAS unsigned*)(F.lds + MISC_OFF);
    F.tid = threadIdx.x; F.lane = F.tid & 63; F.wave = __builtin_amdgcn_readfirstlane(F.tid >> 6);
    F.G = gridDim.x; { const int bx = blockIdx.x; F.vcu = (F.G % 8 == 0) ? (bx % 8) * (F.G / 8) + bx / 8 : bx; }
    unsigned char* ws = args.ws;
    F.ctl = (gu32*)(ws + WS_CTL);
    F.xp = (const float*)args.in[0]; F.xs = (const float*)args.in[1]; F.cache_k = (const float*)args.in[2]; F.cache_v = (const float*)args.in[3];
    F.state_C = (const float*)args.in[4]; F.state_n = (const float*)args.in[5]; F.state_m = (const float*)args.in[6]; F.page_table = (const int*)args.in[7];
    F.rel_bias = (const float*)args.in[8]; F.norm_mix = (const float*)args.in[9]; F.w_in = (const float*)args.in[10]; F.b_ig = (const float*)args.in[11];
    F.b_fg = (const float*)args.in[12]; F.ml_norm = (const float*)args.in[13]; F.w_out = (const float*)args.in[14]; F.norm_ffn = (const float*)args.in[15];
    F.w_up = (const float*)args.in[16]; F.w_down = (const float*)args.in[17]; F.norm_final = (const float*)args.in[18];
    F.out = args.out;
    F.Win_t = (bf16*)(ws + WS_WIN); F.Wout_t = (bf16*)(ws + WS_WOUT); F.Wup_t = (bf16*)(ws + WS_WUP); F.Wdn_t = (bf16*)(ws + WS_WDN);
    F.XN = (bf16*)(ws + WS_XN); F.SEG = (bf16*)(ws + WS_SEG); F.MIX = (bf16*)(ws + WS_MIX); F.U = (bf16*)(ws + WS_U);
    F.KSUM = (float*)(ws + WS_KSUM); F.KSUMS = (float*)(ws + WS_KSUMS); F.IG = (float*)(ws + WS_GATE); F.LF = (float*)(ws + WS_GATE + 512 * 1024);
    F.H = (float*)(ws + WS_H); F.X1 = (float*)(ws + WS_X1);
    for (int u = F.tid; u < (LDS_BYTES - LDSCTL_OFF) / 4; u += NWAVES * 64) ((LAS unsigned*)(F.lds + LDSCTL_OFF))[u] = 0u;
    __syncthreads();
    LAS int* bucket = (LAS int*)(F.lds + LDSCTL_OFF + 1024);
    if (F.tid < 128) bucket[F.tid] = t5_bucket_small(F.tid);
    __syncthreads();
    const int lo = args.ph_lo, hi = args.ph_hi;
    XcdBarrier bar; bar.bar = (unsigned*)(F.ctl + CW_BAR); bar.x = 0; bar.st = nullptr;
    if (hi - lo > 1) bar = xcd_barrier_post((unsigned*)(F.ctl + CW_BAR), F.MISC + 8);
#define IN(k) (lo <= (k) && (k) < hi)
#define SEAM(k) do { if (IN(k) && IN((k) + 1)) xcd_barrier(bar); } while (0)

    if (IN(0)) { p0_prologue(F); } SEAM(0);
    if (IN(1)) {
        pg8::Gemm g{F.XN, F.Win_t, M, NPG, D}; pg8::StaticOrder S; S.init(M, NPG, F.G, (int)blockIdx.x);
        pg8::EpiInProj E{F.SEG, SEG_ELEMS, F.out, F.KSUM};
        pg8::gemm_phase<pg8::EpiInProj, pg8::StaticOrder, true, true>(F.lds + RING_OFF, g, S, E);
    } SEAM(1);
    if (IN(2)) { naive_mlstm(F); naive_attn_prompt(F, bucket); naive_attn_sample(F, bucket); } SEAM(2);
    if (IN(3)) { ml_gate_rows(F); } SEAM(3);
    if (IN(4)) {
        pg8::Gemm g{F.MIX, F.Wout_t, M, D, D}; pg8::StaticOrder S; S.init(M, D, F.G, (int)blockIdx.x);
        pg8::EpiResid E{F.xp, F.xs, F.X1};
        pg8::gemm_phase<pg8::EpiResid, pg8::StaticOrder, true, true>(F.lds + RING_OFF, g, S, E);
    } SEAM(4);
    if (IN(5)) {
        const int gw = F.vcu * NWAVES + F.wave, NGW = F.G * NWAVES;
        for (int m = gw; m < M; m += NGW) rms_row_to_bf16<false>(F, F.X1 + (size_t)m * D, F.norm_ffn, F.XN + (size_t)m * D, m);
    } SEAM(5);
    if (IN(6)) {
        pg8::Gemm g{F.XN, F.Wup_t, M, FF, D}; pg8::StaticOrder S; S.init(M, FF, F.G, (int)blockIdx.x);
        pg8::EpiRelu2 E{F.U};
        pg8::gemm_phase<pg8::EpiRelu2, pg8::StaticOrder, true, true>(F.lds + RING_OFF, g, S, E);
    } SEAM(6);
    if (IN(7)) {
        pg8::Gemm g{F.U, F.Wdn_t, M, D, FF}; pg8::StaticOrder S; S.init(M, D, F.G, (int)blockIdx.x);
        pg8::EpiAccum E{F.X1};
        pg8::gemm_phase<pg8::EpiAccum, pg8::StaticOrder, true, true>(F.lds + RING_OFF, g, S, E);
    } SEAM(7);
    if (IN(8)) { final_norm_rows(F); }
#undef IN
#undef SEAM
}

extern "C" void kernel_launch(void* const* d_in, const int* in_sizes, int n_in, void* d_out, int out_size, void* d_ws, size_t ws_size, hipStream_t stream) {
    static int grid = 0;
    if (grid == 0) {
        if (n_in != 19 || (size_t)out_size != O_END || ws_size < WS_END) { fprintf(stderr, "kernel_launch: unexpected shapes (n_in %d out %d ws %zu)\n", n_in, out_size, ws_size); grid = -1; return; }
        int dev = 0, cus = 0, per_cu = 0;
        if (hipGetDevice(&dev) != hipSuccess || hipDeviceGetAttribute(&cus, hipDeviceAttributeMultiprocessorCount, dev) != hipSuccess) { grid = -1; return; }
        if (hipFuncSetAttribute((const void*)hymba_fwd, hipFuncAttributeMaxDynamicSharedMemorySize, LDS_BYTES) != hipSuccess) { fprintf(stderr, "kernel_launch: hipFuncSetAttribute failed\n"); grid = -1; return; }
        if (hipOccupancyMaxActiveBlocksPerMultiprocessor(&per_cu, (const void*)hymba_fwd, NWAVES * 64, LDS_BYTES) != hipSuccess || per_cu < 1)
            fprintf(stderr, "kernel_launch: note: occupancy query reports %d workgroups per CU\n", per_cu);
        (void)hipGetLastError();
        grid = cus;
    }
    if (grid < 0) return;
    if (hipMemsetAsync((char*)d_ws + WS_CTL, 0, CTL_ZERO_BYTES, stream) != hipSuccess) { fprintf(stderr, "kernel_launch: memset failed\n"); return; }
    Args a{};
    for (int i = 0; i < 19; ++i) a.in[i] = d_in[i];
    a.out = (float*)d_out; a.ws = (unsigned char*)d_ws;
#if MK_ONE_LAUNCH
    a.ph_lo = 0; a.ph_hi = N_PHASES;
    hipLaunchKernelGGL(hymba_fwd, dim3(grid), dim3(NWAVES * 64), LDS_BYTES, stream, a);
#else
    for (int p = 0; p < N_PHASES; ++p) {
        a.ph_lo = p; a.ph_hi = p + 1;
        hipLaunchKernelGGL(hymba_fwd, dim3(grid), dim3(NWAVES * 64), LDS_BYTES, stream, a);
    }
#endif
    const hipError_t le = hipPeekAtLastError();
    if (le != hipSuccess) fprintf(stderr, "kernel_launch: launch failed: %s\n", hipGetErrorName(le));
}
```

```cpp
#include <hip/hip_runtime.h>
#include <cstdio>
#include <cstdint>
#include <cmath>
constexpr int D = 1024, SEQ = 4096, NBATCH = 4, MP = NBATCH * SEQ  , DB = 32, DS = 8, MS = DB * DS  , M = MP + MS  ;
constexpr int FF = 4096, NPROJ = 3592, NPG = 3584  ;
constexpr int AH = 8, AD = 64, AW = 512, MH = 4, MD = 128, MW = 512;
constexpr int PAST = 8192, PAGE = 128, NPAGES = PAST / PAGE  , MBLK = 256, NBLK_P = SEQ / MBLK  , NBLK_S = PAST / MBLK  ;
constexpr float RMS_EPS = 1e-6f;
constexpr size_t O_YP = 0, O_YS = 16777216, O_KP = 17039360, O_VP = 25427968, O_CP = 33816576, O_NP = 34078720, O_MP = 34080768,
                 O_KS = 34080784, O_VS = 34211856, O_CS = 34342928, O_NS = 36440080, O_MS = 36456464, O_END = 36456592;
namespace pg8 {
#define PG8_LAS __attribute__((address_space(3)))
typedef unsigned short bf16_t;
typedef short bf16x8 __attribute__((ext_vector_type(8)));
typedef float f32x4 __attribute__((ext_vector_type(4)));
typedef unsigned u32x4 __attribute__((ext_vector_type(4)));
constexpr int BM = 256, BK = 64, HALF = 128, HTB = HALF * BK * 2  , STAGE_BYTES = 8 * HTB, NXCD = 8, WGM = 8;

__host__ __device__ __forceinline__ int lds_byte(int r, int c) { const int st = (r >> 4) * 2 + (c >> 5), rr = r & 15, cc = c & 31, ob = rr * 64 + cc * 2; return st * 1024 + (ob ^ (((ob >> 9) & 1) << 5)); }
__host__ __device__ __forceinline__ void stage_rc(int b, int& R, int& C) { const int st = b / 1024, sb = b % 1024, swz = sb ^ (((sb >> 9) & 1) << 5); R = (st >> 1) * 16 + swz / 64; C = (st & 1) * 32 + (swz % 64) / 2; }
__host__ __device__ __forceinline__ int perm32(int rho) { const int n = rho >> 4, i = rho & 15; return 8 * (i >> 2) + 4 * n + (i & 3); }

struct Unit { int pm, pn; };
struct Gemm { const bf16_t* A; const bf16_t* Bt; int M, N, K; };

struct StaticOrder {
    int nM, nN, nwg, G, c;
    __host__ __device__ void init(int M, int N, int G_, int c_) { nM = M / BM; nN = N / BM; nwg = nM * nN; G = G_; c = c_; }
    __host__ __device__ bool next(int i, Unit& u) const {
        const long L = (long)i * G + c; if (L >= nwg) return false;
        int wgid = (int)L; { const int q = nwg / NXCD, r = nwg % NXCD, xcd = wgid % NXCD, off = wgid / NXCD; wgid = (xcd < r ? xcd * (q + 1) : r * (q + 1) + (xcd - r) * q) + off; }
        const int nig = WGM * nN, gid = wgid / nig, fm = gid * WGM, gsz = (nM - fm) < WGM ? (nM - fm) : WGM;
        u.pm = fm + ((wgid % nig) % gsz); u.pn = (wgid % nig) / gsz; return true;
    }
    __device__ __forceinline__ void a_ready(const Unit&) const {}
    __device__ __forceinline__ void done(const Unit&) const {}
};

__device__ __forceinline__ unsigned cvt_pk_bf16(float lo, float hi) { unsigned r; asm volatile("v_cvt_pk_bf16_f32 %0, %1, %2" : "=v"(r) : "v"(lo), "v"(hi)); return r; }
typedef float f32x2 __attribute__((ext_vector_type(2)));
typedef unsigned u32x4_t __attribute__((ext_vector_type(4)));
__device__ __forceinline__ u32x4_t pack8(f32x4 v0, f32x4 v1) { u32x4_t w; w.x = cvt_pk_bf16(v0[0], v0[1]); w.y = cvt_pk_bf16(v0[2], v0[3]); w.z = cvt_pk_bf16(v1[0], v1[1]); w.w = cvt_pk_bf16(v1[2], v1[3]); return w; }
struct EpiInProj {
    static constexpr bool PERM = true, AFTER_DRAIN = false;
    bf16_t* seg0; size_t seg_stride; float* out; float* ksum;
    __device__ __forceinline__ void operator()(const f32x4 (&acc)[2][2][4][2], const Unit& u, int wr, int wc, int fr, int fq) const {
        const int seg = u.pn >> 1;
        const float sc = (seg == 0) ? 0.125f : ((seg == 4) ? 0.08838834764831845f : 1.0f);
        bf16_t* base = seg0 + (size_t)seg * seg_stride;
        const int cs0 = (u.pn & 1) * 256 + wc * 32 + 8 * fq;
        const int row0 = u.pm * BM + wr * 64 + fr;
        const bool kv = (seg == 1) || (seg == 2);
        const bool prompt = u.pm < (MP / BM);
        float* fo = out + (prompt ? (seg == 1 ? O_KP : O_VP) : (seg == 1 ? O_KS : O_VS));
        const int frow0 = prompt ? row0 : row0 - MP;
        f32x4 cs[2][2];
#pragma unroll
        for (int bj = 0; bj < 2; ++bj)
#pragma unroll
            for (int n = 0; n < 2; ++n) cs[bj][n] = (f32x4){0.f, 0.f, 0.f, 0.f};
#pragma unroll
        for (int ai = 0; ai < 2; ++ai)
#pragma unroll
            for (int m = 0; m < 4; ++m) {
                bf16_t* rowp = base + (size_t)(row0 + ai * HALF + m * 16) * 512 + cs0;
#pragma unroll
                for (int bj = 0; bj < 2; ++bj) {
                    f32x4 v0 = acc[ai][bj][m][0], v1 = acc[ai][bj][m][1];
                    if (kv) { float* fp = fo + (size_t)(frow0 + ai * HALF + m * 16) * 512 + cs0 + bj * HALF; __builtin_nontemporal_store(v0, (f32x4*)fp); __builtin_nontemporal_store(v1, (f32x4*)(fp + 4)); }
                    if (seg == 1) { cs[bj][0] += v0; cs[bj][1] += v1; }
                    v0 = v0 * sc; v1 = v1 * sc;
                    *(u32x4_t*)(rowp + bj * HALF) = pack8(v0, v1);
                }
            }
        if (seg == 1 && prompt) {
#pragma unroll
            for (int bj = 0; bj < 2; ++bj)
#pragma unroll
                for (int n = 0; n < 2; ++n)
#pragma unroll
                    for (int j = 0; j < 4; ++j) {
                        float v = cs[bj][n][j];
                        v += __shfl_xor(v, 1); v += __shfl_xor(v, 2); v += __shfl_xor(v, 4); v += __shfl_xor(v, 8);
                        if (fr == 0) __hip_atomic_fetch_add(ksum + (size_t)u.pm * 512 + cs0 + bj * HALF + n * 4 + j, v, __ATOMIC_RELAXED, __HIP_MEMORY_SCOPE_AGENT);
                    }
        }
    }
};
struct EpiResid {
    static constexpr bool PERM = false, AFTER_DRAIN = false;
    const float* xp; const float* xs; float* x1; const float* gain; bf16_t* xn; float* ssq;
    __device__ __forceinline__ void operator()(const f32x4 (&acc)[2][2][4][2], const Unit& u, int wr, int wc, int fr, int fq) const {
        const int row0 = u.pm * BM + wr * 64 + fr, col0 = u.pn * BM + wc * 32 + 4 * fq;
        const float* src = (u.pm < (MP / BM)) ? xp + (size_t)row0 * D : xs + (size_t)(row0 - MP) * D;
        float* dst = x1 + (size_t)row0 * D; bf16_t* dxn = xn + (size_t)row0 * D;
        f32x4 gv[2][2];
#pragma unroll
        for (int bj = 0; bj < 2; ++bj)
#pragma unroll
            for (int n = 0; n < 2; ++n) gv[bj][n] = *(const f32x4*)(gain + col0 + bj * HALF + n * 16);
#pragma unroll
        for (int ai = 0; ai < 2; ++ai)
#pragma unroll
            for (int m = 0; m < 4; ++m) {
                const size_t off = (size_t)(ai * HALF + m * 16) * D + col0; float sq = 0.f;
#pragma unroll
                for (int bj = 0; bj < 2; ++bj)
#pragma unroll
                    for (int n = 0; n < 2; ++n) { const f32x4 xv = *(const f32x4*)(src + off + bj * HALF + n * 16) + acc[ai][bj][m][n]; *(f32x4*)(dst + off + bj * HALF + n * 16) = xv;
                        sq += (xv[0] * xv[0] + xv[1] * xv[1]) + (xv[2] * xv[2] + xv[3] * xv[3]);
                        const f32x4 y = xv * gv[bj][n]; unsigned long long w = (unsigned long long)cvt_pk_bf16(y[0], y[1]) | ((unsigned long long)cvt_pk_bf16(y[2], y[3]) << 32);
                        *(unsigned long long*)(dxn + off + bj * HALF + n * 16) = w; }
                sq += __shfl_xor(sq, 16); sq += __shfl_xor(sq, 32);
                if (fq == 0) ssq[(size_t)(row0 + ai * HALF + m * 16) * 16 + u.pn * 4 + wc] = sq;
            }
    }
};
struct EpiAccum {
    static constexpr bool PERM = false, AFTER_DRAIN = false;
    float* x1;
    __device__ __forceinline__ void operator()(const f32x4 (&acc)[2][2][4][2], const Unit& u, int wr, int wc, int fr, int fq) const {
        const int row0 = u.pm * BM + wr * 64 + fr, col0 = u.pn * BM + wc * 32 + 4 * fq;
        float* dst = x1 + (size_t)row0 * D;
#pragma unroll
        for (int ai = 0; ai < 2; ++ai)
#pragma unroll
            for (int m = 0; m < 4; ++m) {
                const size_t off = (size_t)(ai * HALF + m * 16) * D + col0;
#pragma unroll
                for (int bj = 0; bj < 2; ++bj)
#pragma unroll
                    for (int n = 0; n < 2; ++n) { float* p = dst + off + bj * HALF + n * 16; const f32x4 xv = *(const f32x4*)p; *(f32x4*)p = xv + acc[ai][bj][m][n]; }
            }
    }
};
struct EpiRelu2 {
    static constexpr bool PERM = true, AFTER_DRAIN = false;
    bf16_t* U; const float* ssq;
    __device__ __forceinline__ void operator()(const f32x4 (&acc)[2][2][4][2], const Unit& u, int wr, int wc, int fr, int fq) const {
        const int row0 = u.pm * BM + wr * 64 + fr, col0 = u.pn * BM + wc * 32 + 8 * fq;
#pragma unroll
        for (int ai = 0; ai < 2; ++ai)
#pragma unroll
            for (int m = 0; m < 4; ++m) {
                const int row = row0 + ai * HALF + m * 16;
                const f32x4* sp = (const f32x4*)(ssq + (size_t)row * 16); const f32x4 s0 = sp[0], s1 = sp[1], s2 = sp[2], s3 = sp[3];
                const float tot = ((s0[0] + s0[1]) + (s0[2] + s0[3])) + ((s1[0] + s1[1]) + (s1[2] + s1[3])) + ((s2[0] + s2[1]) + (s2[2] + s2[3])) + ((s3[0] + s3[1]) + (s3[2] + s3[3]));
                const float r2 = 1.f / (tot * (1.f / D) + RMS_EPS);
                bf16_t* rowp = U + (size_t)row * FF + col0;
#pragma unroll
                for (int bj = 0; bj < 2; ++bj) {
                    f32x4 v0 = acc[ai][bj][m][0], v1 = acc[ai][bj][m][1];
#pragma unroll
                    for (int j = 0; j < 4; ++j) { const float a = fmaxf(v0[j], 0.f), b = fmaxf(v1[j], 0.f); v0[j] = a * a * r2; v1[j] = b * b * r2; }
                    *(u32x4_t*)(rowp + bj * HALF) = pack8(v0, v1);
                }
            }
    }
};

template <class Epi, class Sched, bool ALIGN_EPI = false, bool SP2 = false>
__device__ __forceinline__ void gemm_phase(PG8_LAS unsigned char* lds, const Gemm g, const Sched& S, const Epi& E) {
    const int tid = threadIdx.x, wid = __builtin_amdgcn_readfirstlane(tid >> 6), lane = tid & 63, wr = wid >> 2, wc = wid & 3, fr = lane & 15, fq = lane >> 4;
    const int K = g.K, nt = K / BK;
    unsigned voffA[2], voffB[2];
#pragma unroll
    for (int i = 0; i < 2; ++i) { int R, C; stage_rc(tid * 16 + i * 8192, R, C); const int Rb = Epi::PERM ? ((R & ~31) + perm32(R & 31)) : R;
        voffA[i] = (unsigned)(R * K + C) * 2u; voffB[i] = (unsigned)(Rb * K + C) * 2u; }
    const size_t kstep = (size_t)(BK * 2);
    const size_t hstep = (size_t)HALF * K * 2;
    const size_t tstep = 2 * hstep;
    const unsigned ldsw = (unsigned)wid * 1024u;
    const int aoff = lds_byte(wr * 64 + fr, fq * 8), boff = lds_byte(wc * 32 + fr, fq * 8);
#define PG8_SA(b, h) (((b) * 2 + (h)) * HTB)
#define PG8_SB(b, h) ((4 + (b) * 2 + (h)) * HTB)
#define PG8_STAGE(bufoff, gbase, voff) do { _Pragma("unroll") for (int _i = 0; _i < 2; ++_i) \
        __builtin_amdgcn_global_load_lds((const unsigned*)((const char*)(gbase) + (voff)[_i]), (PG8_LAS unsigned*)(lds + (bufoff) + ldsw + _i * 8192), 16, 0, 0); } while (0)
#define PG8_LDA(dst, b, h) do { _Pragma("unroll") for (int m = 0; m < 4; ++m) _Pragma("unroll") for (int k = 0; k < 2; ++k) dst[m][k] = *(const PG8_LAS bf16x8*)(lds + PG8_SA(b, h) + aoff + m * 2048 + k * 1024); } while (0)
#define PG8_LDB(dst, b, h) do { _Pragma("unroll") for (int n = 0; n < 2; ++n) _Pragma("unroll") for (int k = 0; k < 2; ++k) dst[n][k] = *(const PG8_LAS bf16x8*)(lds + PG8_SB(b, h) + boff + n * 2048 + k * 1024); } while (0)
#define PG8_MMA(ai, bj, At, Bt) do { __builtin_amdgcn_s_setprio(1); _Pragma("unroll") for (int m = 0; m < 4; ++m) _Pragma("unroll") for (int n = 0; n < 2; ++n) _Pragma("unroll") for (int k = 0; k < 2; ++k) \
        acc[ai][bj][m][n] = __builtin_amdgcn_mfma_f32_16x16x32_bf16(Bt[n][k], At[m][k], acc[ai][bj][m][n], 0, 0, 0); __builtin_amdgcn_s_setprio(0); } while (0)
#define PG8_WAIT_V(n) asm volatile("s_waitcnt vmcnt(" #n ")" ::: "memory")
#define PG8_WAIT_L(n) asm volatile("s_waitcnt lgkmcnt(" #n ")" ::: "memory")
#define PG8_BAR __builtin_amdgcn_s_barrier()
#define PG8_SCHED __builtin_amdgcn_sched_barrier(0)
    Unit cur, nxt; int ui = 0;
    if (!S.next(0, cur)) return;
    f32x4 acc[2][2][4][2];
#pragma unroll
    for (int a = 0; a < 2; ++a)
#pragma unroll
        for (int b = 0; b < 2; ++b)
#pragma unroll
            for (int m = 0; m < 4; ++m)
#pragma unroll
                for (int n = 0; n < 2; ++n) acc[a][b][m][n] = (f32x4){0.f, 0.f, 0.f, 0.f};
    bf16x8 At[4][2], B0[2][2], B1[2][2];
    const char* cA = (const char*)g.A + (size_t)cur.pm * tstep; const char* cB = (const char*)g.Bt + (size_t)cur.pn * tstep;
    S.a_ready(cur);
    if constexpr (SP2) {
        PG8_STAGE(PG8_SB(0, 0), cB, voffB); PG8_STAGE(PG8_SB(0, 1), cB + hstep, voffB); PG8_STAGE(PG8_SA(0, 0), cA, voffA); PG8_STAGE(PG8_SA(0, 1), cA + hstep, voffA);
        if (wr == 1) PG8_BAR;
        PG8_WAIT_V(2); PG8_BAR;
        PG8_STAGE(PG8_SB(1, 0), cB + kstep, voffB); PG8_STAGE(PG8_SA(1, 0), cA + kstep, voffA); PG8_STAGE(PG8_SB(1, 1), cB + hstep + kstep, voffB);
        PG8_WAIT_V(6); PG8_BAR;
    } else {
        PG8_STAGE(PG8_SB(0, 0), cB, voffB); PG8_STAGE(PG8_SA(0, 0), cA, voffA); PG8_STAGE(PG8_SB(0, 1), cB + hstep, voffB); PG8_STAGE(PG8_SA(0, 1), cA + hstep, voffA);
        if (wr == 1) PG8_BAR;
        PG8_WAIT_V(4); PG8_BAR;
        PG8_STAGE(PG8_SB(1, 0), cB + kstep, voffB); PG8_STAGE(PG8_SA(1, 0), cA + kstep, voffA); PG8_STAGE(PG8_SB(1, 1), cB + hstep + kstep, voffB);
        PG8_WAIT_V(6); PG8_BAR;
    }
    for (;;) {
        const bool has_next = S.next(ui + 1, nxt);
        const char* nA = has_next ? (const char*)g.A + (size_t)nxt.pm * tstep : cA; const char* nB = has_next ? (const char*)g.Bt + (size_t)nxt.pn * tstep : cB;
        for (int t = 0; t < nt; t += 2) {
            const bool last = (t == nt - 2);
            const char* a1 = cA + (size_t)(t + 1) * kstep;
            const char* a2 = last ? nA : cA + (size_t)(t + 2) * kstep; const char* b2 = last ? nB : cB + (size_t)(t + 2) * kstep;
            const char* a3 = a2 + kstep; const char* b3 = b2 + kstep;
            if (last && has_next) S.a_ready(nxt);
            if constexpr (SP2) {
            PG8_LDB(B0, 0, 0); PG8_LDB(B1, 0, 1); PG8_SCHED; PG8_LDA(At, 0, 0); PG8_STAGE(PG8_SA(1, 1), a1 + hstep, voffA);
            PG8_WAIT_V(8); PG8_WAIT_L(0); PG8_BAR; PG8_MMA(0, 0, At, B0); PG8_MMA(0, 1, At, B1); PG8_BAR; PG8_SCHED;
            PG8_LDA(At, 0, 1); PG8_STAGE(PG8_SB(0, 0), b2, voffB); PG8_STAGE(PG8_SB(0, 1), b2 + hstep, voffB); PG8_STAGE(PG8_SA(0, 0), a2, voffA);
            PG8_WAIT_V(8); PG8_WAIT_L(0); PG8_BAR; PG8_MMA(1, 0, At, B0); PG8_MMA(1, 1, At, B1); PG8_BAR; PG8_SCHED;
            PG8_LDB(B0, 1, 0); PG8_LDB(B1, 1, 1); PG8_SCHED; PG8_LDA(At, 1, 0); PG8_STAGE(PG8_SA(0, 1), a2 + hstep, voffA);
            PG8_WAIT_V(8); PG8_WAIT_L(0); PG8_BAR; PG8_MMA(0, 0, At, B0); PG8_MMA(0, 1, At, B1); PG8_BAR; PG8_SCHED;
            PG8_LDA(At, 1, 1); PG8_STAGE(PG8_SB(1, 0), b3, voffB); PG8_STAGE(PG8_SB(1, 1), b3 + hstep, voffB); PG8_STAGE(PG8_SA(1, 0), a3, voffA);
            PG8_WAIT_V(8); PG8_WAIT_L(0); PG8_BAR; PG8_MMA(1, 0, At, B0); PG8_MMA(1, 1, At, B1); PG8_BAR; PG8_SCHED;
            } else {
            PG8_LDB(B0, 0, 0); PG8_SCHED; PG8_LDA(At, 0, 0); PG8_STAGE(PG8_SA(1, 1), a1 + hstep, voffA);
            PG8_WAIT_L(8); PG8_BAR; PG8_WAIT_L(0); PG8_MMA(0, 0, At, B0); PG8_BAR; PG8_SCHED;
            PG8_LDB(B1, 0, 1); PG8_STAGE(PG8_SB(0, 0), b2, voffB);
            PG8_BAR; PG8_WAIT_L(0); PG8_MMA(0, 1, At, B1); PG8_BAR;
            PG8_LDA(At, 0, 1); PG8_STAGE(PG8_SA(0, 0), a2, voffA);
            PG8_BAR; PG8_WAIT_L(0); PG8_MMA(1, 0, At, B0); PG8_BAR; PG8_SCHED;
            PG8_STAGE(PG8_SB(0, 1), b2 + hstep, voffB);
            PG8_WAIT_V(6); PG8_BAR; PG8_MMA(1, 1, At, B1); PG8_BAR;
            PG8_LDB(B0, 1, 0); PG8_SCHED; PG8_LDA(At, 1, 0); PG8_STAGE(PG8_SA(0, 1), a2 + hstep, voffA);
            PG8_WAIT_L(8); PG8_BAR; PG8_WAIT_L(0); PG8_MMA(0, 0, At, B0); PG8_BAR; PG8_SCHED;
            PG8_LDB(B1, 1, 1); PG8_STAGE(PG8_SB(1, 0), b3, voffB);
            PG8_BAR; PG8_WAIT_L(0); PG8_MMA(0, 1, At, B1); PG8_BAR;
            PG8_LDA(At, 1, 1); PG8_STAGE(PG8_SA(1, 0), a3, voffA);
            PG8_BAR; PG8_WAIT_L(0); PG8_MMA(1, 0, At, B0); PG8_BAR; PG8_SCHED;
            PG8_STAGE(PG8_SB(1, 1), b3 + hstep, voffB);
            PG8_WAIT_V(6); PG8_BAR; PG8_MMA(1, 1, At, B1); PG8_BAR;
            }
        }
        if constexpr (ALIGN_EPI) { if (wr == 0) PG8_BAR; }
        if constexpr (!Epi::AFTER_DRAIN) { E(acc, cur, wr, wc, fr, fq); S.done(cur); }
        if (!has_next) break;
#pragma unroll
        for (int a = 0; a < 2; ++a)
#pragma unroll
            for (int b = 0; b < 2; ++b)
#pragma unroll
                for (int m = 0; m < 4; ++m)
#pragma unroll
                    for (int n = 0; n < 2; ++n) acc[a][b][m][n] = (f32x4){0.f, 0.f, 0.f, 0.f};
        cur = nxt; cA = nA; cB = nB; ++ui;
        if constexpr (ALIGN_EPI) { if (wr == 1) PG8_BAR; }
    }
    PG8_WAIT_V(0);
    if constexpr (!ALIGN_EPI) { if (wr == 0) PG8_BAR; }
    PG8_BAR;
    if constexpr (Epi::AFTER_DRAIN) { E.fused(acc, cur, wr, wc, fr, fq, lds, wid, lane); S.done(cur); }
#undef PG8_SA
#undef PG8_SB
#undef PG8_STAGE
#undef PG8_LDA
#undef PG8_LDB
#undef PG8_MMA
#undef PG8_WAIT_V
#undef PG8_WAIT_L
#undef PG8_BAR
#undef PG8_SCHED
}
}

constexpr int NWAVES = 8;
constexpr size_t MiB = 1u << 20;
constexpr size_t WS_CTL = 0, CTL_ZERO_BYTES = 1 * MiB;
constexpr size_t WS_KSUM = 512 * 1024;
constexpr size_t WS_WIN = 2 * MiB, WS_WOUT = 10 * MiB, WS_WUP = 12 * MiB, WS_WDN = 20 * MiB;
constexpr size_t WS_GATE = 28 * MiB;
constexpr size_t WS_KSUMS = 29 * MiB;
constexpr size_t WS_XN = 32 * MiB;
constexpr size_t WS_SEG = 65 * MiB, SEG_BYTES = 17 * MiB;
constexpr size_t WS_H = 184 * MiB;
constexpr size_t WS_MIX = 217 * MiB;
constexpr size_t WS_X1 = 250 * MiB;
constexpr size_t WS_U = 320 * MiB;
constexpr size_t WS_END = 452 * MiB;
constexpr size_t WS_SSQ = 700 * MiB;
constexpr size_t WS_END_SSQ = 702 * MiB;
constexpr int CW_BAR = 4096;
constexpr int RING_OFF = 0, RING_BYTES = 131072;
constexpr int LDSCTL_OFF = RING_BYTES, MISC_OFF = LDSCTL_OFF + 320;
constexpr int LDS_BYTES = 147456;
#define GAS __attribute__((address_space(1)))
#define LAS __attribute__((address_space(3)))
typedef unsigned short bf16;
typedef unsigned v4u __attribute__((ext_vector_type(4)));
typedef float f32x4 __attribute__((ext_vector_type(4)));
typedef short bf16x8 __attribute__((ext_vector_type(8)));
typedef GAS unsigned gu32;
typedef GAS unsigned long long gu64;
#define RLX_AGENT __ATOMIC_RELAXED, __HIP_MEMORY_SCOPE_AGENT
#define LDS_WAIT() asm volatile("s_waitcnt lgkmcnt(0)" ::: "memory")
#define VM_WAIT() asm volatile("s_waitcnt vmcnt(0)" ::: "memory")
__device__ __forceinline__ unsigned long long rt() { return __builtin_amdgcn_s_memrealtime(); }
__device__ __forceinline__ unsigned pk2(float lo, float hi) { unsigned r; asm("v_cvt_pk_bf16_f32 %0, %1, %2" : "=v"(r) : "v"(lo), "v"(hi)); return r; }
__device__ __forceinline__ unsigned f2bf(float f) { return pk2(f, 0.f) & 0xffffu; }

#define XB_TMO      128
#define XB_XCNT(j)  (256  + 64 * (j))
#define XB_XSUB(j)  (1280 + 64 * (j))
#define XB_XGEN(j)  (2304 + 64 * (j))
#define XB_TOP      3328
#define XB_TOPGEN   3392
#define XCD_BAR_WORDS 3456
#define XB_SPIN_CAP (1u << 18)

__device__ __forceinline__ unsigned xb_ld(unsigned* p)              { return __hip_atomic_load(p, __ATOMIC_RELAXED, __HIP_MEMORY_SCOPE_AGENT); }
__device__ __forceinline__ unsigned xb_add(unsigned* p, unsigned v) { return __hip_atomic_fetch_add(p, v, __ATOMIC_RELAXED, __HIP_MEMORY_SCOPE_AGENT); }
__device__ __forceinline__ unsigned xb_xcc_id() { return (unsigned)__builtin_amdgcn_s_getreg((3 << 11) | 20) & 0xFu; }
#define XB_SPIN(cond, bar) do { unsigned _sp = 0; while (cond) { __builtin_amdgcn_s_sleep(1); \
    if ((++_sp & 255u) == 0u) { if (xb_ld(&(bar)[XB_TMO])) break; if (_sp > XB_SPIN_CAP) { atomicAdd(&(bar)[XB_TMO], 1u); break; } } } } while (0)

struct XcdBarrier {
    unsigned* bar; unsigned x;
    volatile LAS unsigned* st;
};

__device__ __forceinline__ XcdBarrier xcd_barrier_post(unsigned* bar, volatile LAS unsigned* st) {
    XcdBarrier b; b.bar = bar; b.x = xb_xcc_id(); b.st = st;
    if (threadIdx.x == 0) (void)xb_add(&bar[XB_XCNT(b.x)], 1u);
    return b;
}
__device__ __forceinline__ void xcd_barrier_complete(unsigned* bar, unsigned x, unsigned& nloc, unsigned& nx) {
    const unsigned G = gridDim.x * gridDim.y * gridDim.z;
    unsigned sum, cnt, mine, sp = 0u;
    for (;;) {
        sum = 0u; cnt = 0u; mine = 0u;
#pragma unroll
        for (unsigned j = 0; j < 16; ++j) { const unsigned c = xb_ld(&bar[XB_XCNT(j)]); sum += c; cnt += (c > 0u) ? 1u : 0u; mine = (j == x) ? c : mine; }
        if (sum == G) break;
        __builtin_amdgcn_s_sleep(1);
        if ((++sp & 255u) == 0u) { if (xb_ld(&bar[XB_TMO])) break; if (sp > XB_SPIN_CAP) { atomicAdd(&bar[XB_TMO], 1u); break; } }
    }
    nloc = mine > 0u ? mine : 1u; nx = cnt > 0u ? cnt : 1u;
}

__device__ __forceinline__ void xcd_barrier(const XcdBarrier& b) {
    asm volatile("s_waitcnt vmcnt(0)" ::: "memory");
    __syncthreads();
    if (threadIdx.x == 0) {
        unsigned* bar = b.bar;
        __builtin_amdgcn_s_waitcnt(0);
        unsigned nloc = b.st[0], nx = b.st[1];
        if (nloc == 0u) { xcd_barrier_complete(bar, b.x, nloc, nx); b.st[0] = nloc; b.st[1] = nx; }
        const unsigned old = xb_add(&bar[XB_XSUB(b.x)], 1u);
        const unsigned gen = old / nloc;
        if (old + 1u == (gen + 1u) * nloc) {
            __builtin_amdgcn_fence(__ATOMIC_RELEASE, "agent");
            asm volatile("s_waitcnt vmcnt(0)" ::: "memory");
            const unsigned og = xb_add(&bar[XB_TOP], 1u);
            const unsigned tg = og / nx;
            if (og + 1u == (tg + 1u) * nx) xb_add(&bar[XB_TOPGEN], 1u);
            else XB_SPIN(xb_ld(&bar[XB_TOPGEN]) == tg, bar);
            __builtin_amdgcn_fence(__ATOMIC_ACQUIRE, "agent");
            xb_add(&bar[XB_XGEN(b.x)], 1u);
            asm volatile("s_waitcnt vmcnt(0)" ::: "memory");
        } else {
            XB_SPIN(xb_ld(&bar[XB_XGEN(b.x)]) == gen, bar);
            __builtin_amdgcn_fence(__ATOMIC_ACQUIRE, "agent");
            asm volatile("s_waitcnt vmcnt(0)" ::: "memory");
        }
    }
    __syncthreads();
}

struct Frame {
    LAS unsigned char* lds;
    volatile LAS unsigned* MISC;
    gu32* ctl;
    int tid, lane, wave, vcu, G;
    const float *xp, *xs, *cache_k, *cache_v, *state_C, *state_n, *state_m; const int* page_table;
    const float *rel_bias, *norm_mix, *w_in, *b_ig, *b_fg, *ml_norm, *w_out, *norm_ffn, *w_up, *w_down, *norm_final;
    float* out; unsigned char* ws;
    bf16 *Win_t, *Wout_t, *Wup_t, *Wdn_t, *XN, *SEG, *MIX, *U;
    float *KSUM, *KSUMS, *IG, *LF, *H, *X1;
};
constexpr size_t SEG_ELEMS = SEG_BYTES / 2;
#define SEG_AQ(F) ((F).SEG + 0 * SEG_ELEMS)
#define SEG_AK(F) ((F).SEG + 1 * SEG_ELEMS)
#define SEG_AV(F) ((F).SEG + 2 * SEG_ELEMS)
#define SEG_MQ(F) ((F).SEG + 3 * SEG_ELEMS)
#define SEG_MK(F) ((F).SEG + 4 * SEG_ELEMS)
#define SEG_MV(F) ((F).SEG + 5 * SEG_ELEMS)
#define SEG_MO(F) ((F).SEG + 6 * SEG_ELEMS)

__device__ __forceinline__ float bf2f(unsigned short b) { return __builtin_bit_cast(float, (unsigned)b << 16); }
__device__ __forceinline__ float wave_sum(float v) {
#pragma unroll
    for (int o = 1; o < 64; o <<= 1) v += __shfl_xor(v, o);
    return v;
}
__device__ __forceinline__ void p0_transpose_item(const float* W, int K, int ldw, int N, bf16* WT, LAS float* scr, int item, int lane) {
    const int nblk = N / 32, kb = item / nblk, nb = item % nblk, k0 = 64 * kb, n0 = 32 * nb;
    float wv[32];
#pragma unroll
    for (int i = 0; i < 32; ++i) wv[i] = W[(size_t)(k0 + 2 * i + (lane >> 5)) * ldw + n0 + (lane & 31)];
#pragma unroll
    for (int i = 0; i < 32; i += 8) asm volatile("" : "+v"(wv[i]), "+v"(wv[i + 1]), "+v"(wv[i + 2]), "+v"(wv[i + 3]), "+v"(wv[i + 4]), "+v"(wv[i + 5]), "+v"(wv[i + 6]), "+v"(wv[i + 7]));
#pragma unroll
    for (int i = 0; i < 32; ++i) scr[(2 * i + (lane >> 5)) * 33 + (lane & 31)] = wv[i];
    LDS_WAIT(); asm volatile("" ::: "memory");
    const int c = lane & 7;
#pragma unroll
    for (int j = 0; j < 4; ++j) { const int n = (lane >> 3) + 8 * j; const LAS float* s = scr + (8 * c) * 33 + n;
        v4u o; o.x = pk2(s[0 * 33], s[1 * 33]); o.y = pk2(s[2 * 33], s[3 * 33]); o.z = pk2(s[4 * 33], s[5 * 33]); o.w = pk2(s[6 * 33], s[7 * 33]);
        *(GAS v4u*)(WT + (size_t)(n0 + n) * K + k0 + 8 * c) = o; }
    LDS_WAIT(); asm volatile("" ::: "memory");
}
__device__ __forceinline__ void load_row(const float* xrow, int lane, f32x4 (&v)[4]) {
    const GAS f32x4* xr = (const GAS f32x4*)xrow + lane;
#pragma unroll
    for (int j = 0; j < 4; ++j) v[j] = xr[64 * j];
}
__device__ __forceinline__ void load_row_nt(const float* xrow, int lane, f32x4 (&v)[4]) {
    const GAS f32x4* xr = (const GAS f32x4*)xrow + lane;
#pragma unroll
    for (int j = 0; j < 4; ++j) v[j] = __builtin_nontemporal_load(xr + 64 * j);
}
template <bool GATES>
__device__ __forceinline__ void rms_row_to_bf16(Frame& F, const f32x4 (&vin)[4], const float* gain, bf16* orow, int m) {
    const GAS f32x4* gr = (const GAS f32x4*)gain + F.lane;
    f32x4 v[4]; float s = 0.f;
#pragma unroll
    for (int j = 0; j < 4; ++j) { v[j] = vin[j]; s += (v[j].x * v[j].x + v[j].y * v[j].y) + (v[j].z * v[j].z + v[j].w * v[j].w); }
#pragma unroll
    for (int j = 0; j < 4; ++j) v[j] = v[j] * gr[64 * j];
    float g8[8];
    if (GATES) {
#pragma unroll
        for (int c = 0; c < 8; ++c) g8[c] = 0.f;
#pragma unroll
        for (int j = 0; j < 4; ++j)
#pragma unroll
            for (int i = 0; i < 4; ++i) { const int k = 256 * j + 4 * F.lane + i; const LAS f32x4* wr = (const LAS f32x4*)(F.lds + RING_OFF + 131072 - 32768) + 2 * k; const f32x4 w0 = wr[0], w1 = wr[1]; const float xv = v[j][i];
                g8[0] += xv * w0.x; g8[1] += xv * w0.y; g8[2] += xv * w0.z; g8[3] += xv * w0.w; g8[4] += xv * w1.x; g8[5] += xv * w1.y; g8[6] += xv * w1.z; g8[7] += xv * w1.w; }
    }
    const float rstd = 1.f / sqrtf(wave_sum(s) * (1.f / D) + RMS_EPS);
    GAS unsigned long long* o8 = (GAS unsigned long long*)orow + F.lane;
#pragma unroll
    for (int j = 0; j < 4; ++j) o8[64 * j] = (unsigned long long)pk2(v[j].x * rstd, v[j].y * rstd) | ((unsigned long long)pk2(v[j].z * rstd, v[j].w * rstd) << 32);
    if (GATES) {
#pragma unroll
        for (int c = 0; c < 8; ++c) g8[c] = wave_sum(g8[c]) * rstd;
        if (F.lane < 8) { float z = 0.f;
#pragma unroll
            for (int c = 0; c < 8; ++c) z = (F.lane == c) ? g8[c] : z;
            if (F.lane < 4) { F.IG[(size_t)m * 4 + F.lane] = z + F.b_ig[F.lane]; }
            else { const int h = F.lane - 4; z += F.b_fg[h]; F.LF[(size_t)m * 4 + h] = fminf(z, 0.f) - log1pf(expf(-fabsf(z))); } }
    }
}
__device__ __forceinline__ const float* xrow_of(Frame& F, int m) { return (m < MP) ? F.xp + (size_t)m * D : F.xs + (size_t)(m - MP) * D; }

constexpr int PS_SPLIT = 2048;
constexpr int P1_GEMM_WGS = 228;
__device__ __forceinline__ void page_sums(Frame& F, int u0, int u1, int w, int NW) {
    for (int u = u0 + w; u < u1; u += NW) {
        f32x4 a0 = {0.f, 0.f, 0.f, 0.f}, a1 = {0.f, 0.f, 0.f, 0.f};
        const int page = F.page_table[u];
        const GAS f32x4* base = (const GAS f32x4*)(F.cache_k + (size_t)page * PAGE * AW) + 2 * F.lane;
#pragma unroll 16
        for (int r = 0; r < PAGE; ++r) { a0 += __builtin_nontemporal_load(base + (size_t)r * (AW / 4)); a1 += __builtin_nontemporal_load(base + (size_t)r * (AW / 4) + 1); }
        GAS f32x4* o = (GAS f32x4*)(F.KSUMS + (size_t)u * AW) + 2 * F.lane; o[0] = a0; o[1] = a1;
    }
}
__device__ __forceinline__ void late_transposes(Frame& F, int w, int NW) {
    LAS float* scr = (LAS float*)(F.lds + RING_OFF + F.wave * 16384);
    constexpr int I_O = (D / 64) * (D / 32), I_UP = (D / 64) * (FF / 32), I_DN = (FF / 64) * (D / 32);
    for (int it = w; it < I_O + I_UP + I_DN; it += NW) {
        int r = it;
        if (r < I_O) { p0_transpose_item(F.w_out, D, D, D, F.Wout_t, scr, r, F.lane); continue; } r -= I_O;
        if (r < I_UP) { p0_transpose_item(F.w_up, D, FF, FF, F.Wup_t, scr, r, F.lane); continue; } r -= I_UP;
        p0_transpose_item(F.w_down, FF, D, D, F.Wdn_t, scr, r, F.lane);
    }
}
__device__ __forceinline__ void p0_prologue(Frame& F) {
    LAS float* scr = (LAS float*)(F.lds + RING_OFF + F.wave * 16384);
    const int gw = F.vcu * NWAVES + F.wave, NGW = F.G * NWAVES;
    constexpr int I_IN = (D / 64) * (NPG / 32);
    for (int it = gw; it < I_IN; it += NGW) p0_transpose_item(F.w_in, D, NPROJ, NPG, F.Win_t, scr, it, F.lane);
    __syncthreads();
    for (int i = F.tid; i < D * 2; i += NWAVES * 64) ((LAS f32x4*)(F.lds + RING_OFF + 131072 - 32768))[i] = *(const f32x4*)(F.w_in + (size_t)(i >> 1) * NPROJ + NPG + 4 * (i & 1));
    __syncthreads();
    {
        f32x4 r0[4], r1[4], r2[4];
        if (gw < M) load_row(xrow_of(F, gw), F.lane, r0);
        { const int m1 = (gw + NGW < M) ? gw + NGW : gw; load_row(xrow_of(F, m1 < M ? m1 : 0), F.lane, r1); }
        for (int m = gw; m < M; m += NGW) {
            const int m2 = (m + 2 * NGW < M) ? m + 2 * NGW : m; load_row(xrow_of(F, m2), F.lane, r2);
            rms_row_to_bf16<true>(F, r0, F.norm_mix, F.XN + (size_t)m * D, m);
#pragma unroll
            for (int j = 0; j < 4; ++j) { r0[j] = r1[j]; r1[j] = r2[j]; }
        }
    }
    page_sums(F, 0, PS_SPLIT, gw, NGW);
}

__device__ __forceinline__ int t5_bucket_small(int n) {
    if (n < 16) return n;
    int b = 16 + (int)(logf((float)n * (1.0f / 16.0f)) / 2.0794415416798357f * 16.0f);
    return b < 31 ? b : 31;
}

__device__ __forceinline__ void final_norm_rows(Frame& F) {
    const int gw = F.vcu * NWAVES + F.wave, NGW = F.G * NWAVES;
    f32x4 cur[4], nxt[4], nx2[4];
    if (gw < M) load_row_nt(F.X1 + (size_t)gw * D, F.lane, cur);
    { const int m1 = (gw + NGW < M) ? gw + NGW : (gw < M ? gw : 0); load_row_nt(F.X1 + (size_t)m1 * D, F.lane, nxt); }
    for (int m = gw; m < M; m += NGW) {
        const int m2 = (m + 2 * NGW < M) ? m + 2 * NGW : m; load_row_nt(F.X1 + (size_t)m2 * D, F.lane, nx2);
        const f32x4* gr = (const f32x4*)F.norm_final + F.lane;
        float s = 0.f;
#pragma unroll
        for (int j = 0; j < 4; ++j) s += (cur[j].x * cur[j].x + cur[j].y * cur[j].y) + (cur[j].z * cur[j].z + cur[j].w * cur[j].w);
        const float rstd = 1.f / sqrtf(wave_sum(s) * (1.f / D) + RMS_EPS);
        f32x4* o = (f32x4*)(F.out + ((m < MP) ? O_YP + (size_t)m * D : O_YS + (size_t)(m - MP) * D)) + F.lane;
#pragma unroll
        for (int j = 0; j < 4; ++j) __builtin_nontemporal_store(cur[j] * rstd * gr[64 * j], o + 64 * j);
#pragma unroll
        for (int j = 0; j < 4; ++j) { cur[j] = nxt[j]; nxt[j] = nx2[j]; }
    }
}

typedef float f32x16 __attribute__((ext_vector_type(16)));
typedef short s16x4 __attribute__((ext_vector_type(4)));
typedef short v4i16_t __attribute__((ext_vector_type(4)));
__device__ __forceinline__ f32x16 mfma32(bf16x8 a, bf16x8 b, f32x16 c) { return __builtin_amdgcn_mfma_f32_32x32x16_bf16(a, b, c, 0, 0, 0); }
__device__ __forceinline__ int crow(int r, int hi) { return (r & 3) + 8 * (r >> 2) + 4 * hi; }
__device__ __forceinline__ s16x4 vtr(const LAS unsigned char* p) { return __builtin_bit_cast(s16x4, __builtin_amdgcn_ds_read_tr16_b64_v4i16((LAS v4i16_t*)p)); }
__device__ __forceinline__ bf16x8 tfrag(const LAS unsigned char* tile, int T, int s, int ct, int lane) {
    const int i = lane & 15, hi = lane >> 5;
    const LAS unsigned char* p = tile + ct * (T * 64) + (16 * s + 4 * hi + (i >> 2)) * 64 + ((lane >> 4) & 1) * 32 + (i & 3) * 8;
    const s16x4 lo = vtr(p), hh = vtr(p + 512);
    return (bf16x8){lo[0], lo[1], lo[2], lo[3], hh[0], hh[1], hh[2], hh[3]};
}
__device__ __forceinline__ bf16x8 rfrag(const LAS unsigned char* tile, int T, int rt, int s, int lane) {
    return *(const LAS bf16x8*)(tile + (2 * s + (lane >> 5)) * (T * 16) + (32 * rt + (lane & 31)) * 16);
}
__device__ __forceinline__ float half_swap_add(float v) { return v + __shfl_xor(v, 32); }

constexpr int MLC = 256, NCH = SEQ / MLC  , NSEQ = NBATCH * MH  ;
constexpr size_t WS_DCT = 452 * MiB;
constexpr size_t WS_CT = 468 * MiB;
constexpr size_t WS_MLS = 476 * MiB;
constexpr size_t MLS_DN = 0, MLS_NC = 32768, MLS_SC = 65536, MLS_MC = 66048;
constexpr size_t WS_END2 = 477 * MiB;
constexpr int ML_TAB_OFF = LDSCTL_OFF + 2048;
constexpr int ML_MISC = 1280, ML_WSC = 1296;

__device__ __forceinline__ void ml_scalars(Frame& F, int row0, int h, float m0, LAS float* tab) {
    if (F.wave == 0) {
        const int l = F.lane; float lf[4], ig[4], b[4], u[4], pm[4];
#pragma unroll
        for (int i = 0; i < 4; ++i) { lf[i] = F.LF[(size_t)(row0 + 4 * l + i) * 4 + h]; ig[i] = F.IG[(size_t)(row0 + 4 * l + i) * 4 + h]; }
        b[0] = lf[0]; b[1] = b[0] + lf[1]; b[2] = b[1] + lf[2]; b[3] = b[2] + lf[3];
        float x = b[3];
#pragma unroll
        for (int o = 1; o < 64; o <<= 1) { const float y = __shfl_up(x, o); if (l >= o) x += y; }
        const float excl = x - b[3];
#pragma unroll
        for (int i = 0; i < 4; ++i) { b[i] += excl; u[i] = ig[i] - b[i]; }
        pm[0] = u[0]; pm[1] = fmaxf(pm[0], u[1]); pm[2] = fmaxf(pm[1], u[2]); pm[3] = fmaxf(pm[2], u[3]);
        float xm = pm[3];
#pragma unroll
        for (int o = 1; o < 64; o <<= 1) { const float y = __shfl_up(xm, o); if (l >= o) xm = fmaxf(xm, y); }
        float em = __shfl_up(xm, 1); if (l == 0) em = -INFINITY;
        em = fmaxf(em, m0);
#pragma unroll
        for (int i = 0; i < 4; ++i) { tab[4 * l + i] = b[i]; tab[256 + 4 * l + i] = u[i]; tab[512 + 4 * l + i] = fmaxf(em, pm[i]); }
        if (l == 63) { tab[ML_MISC] = xm; tab[ML_MISC + 1] = b[3]; }
    }
}
template <bool SCALE>
__device__ __forceinline__ void stage_T128(Frame& F, const bf16* src, LAS unsigned char* tile, const LAS float* utab, float Mloc) {
    v4u w[8];
#pragma unroll
    for (int i = 0; i < 8; ++i) { const int piece = F.tid + 512 * i, token = piece >> 4, ch = piece & 15; w[i] = *(const v4u*)(src + (size_t)token * 512 + 8 * ch); }
    asm volatile("" : "+v"(w[0]), "+v"(w[1]), "+v"(w[2]), "+v"(w[3]), "+v"(w[4]), "+v"(w[5]), "+v"(w[6]), "+v"(w[7]));
#pragma unroll
    for (int i = 0; i < 8; ++i) {
        const int piece = F.tid + 512 * i, token = piece >> 4, ch = piece & 15;
        v4u x = w[i];
        if (SCALE) { const float g = __expf(utab[token] - Mloc); unsigned ww[4] = {x.x, x.y, x.z, x.w};
#pragma unroll
            for (int k = 0; k < 4; ++k) ww[k] = pk2(__builtin_bit_cast(float, ww[k] << 16) * g, __builtin_bit_cast(float, ww[k] & 0xffff0000u) * g);
            x.x = ww[0]; x.y = ww[1]; x.z = ww[2]; x.w = ww[3]; }
        *(LAS v4u*)(tile + (ch >> 2) * (MLC * 64) + token * 64 + (ch & 3) * 16) = x;
    }
}
__device__ __forceinline__ void stage_R128(Frame& F, const bf16* src, LAS unsigned char* tile) {
    v4u w[8];
#pragma unroll
    for (int i = 0; i < 8; ++i) { const int piece = F.tid + 512 * i, token = piece >> 4, ch = piece & 15; w[i] = *(const v4u*)(src + (size_t)token * 512 + 8 * ch); }
    asm volatile("" : "+v"(w[0]), "+v"(w[1]), "+v"(w[2]), "+v"(w[3]), "+v"(w[4]), "+v"(w[5]), "+v"(w[6]), "+v"(w[7]));
#pragma unroll
    for (int i = 0; i < 8; ++i) { const int piece = F.tid + 512 * i, token = piece >> 4, ch = piece & 15; *(LAS v4u*)(tile + ch * (MLC * 16) + token * 16) = w[i]; }
}
__device__ __forceinline__ void mlstm_stepA(Frame& F, int unit) {
    const int seq = unit >> 4, c = unit & 15, b = seq >> 2, h = seq & 3, row0 = b * SEQ + c * MLC;
    LAS float* tab = (LAS float*)(F.lds + ML_TAB_OFF);
    LAS unsigned char* KT = F.lds + RING_OFF; LAS unsigned char* VT = F.lds + RING_OFF + 65536;
    float* mls = (float*)((unsigned char*)F.ws + WS_MLS);
    v4u kw[8], vw[8];
    { const bf16* ksrc = SEG_MK(F) + (size_t)row0 * MW + h * MD; const bf16* vsrc = SEG_MV(F) + (size_t)row0 * MW + h * MD;
#pragma unroll
      for (int i = 0; i < 8; ++i) { const int piece = F.tid + 512 * i, token = piece >> 4, ch = piece & 15; kw[i] = *(const v4u*)(ksrc + (size_t)token * 512 + 8 * ch); vw[i] = *(const v4u*)(vsrc + (size_t)token * 512 + 8 * ch); } }
    ml_scalars(F, row0, h, -INFINITY, tab);
    asm volatile("" : "+v"(kw[0]), "+v"(kw[1]), "+v"(kw[2]), "+v"(kw[3]), "+v"(kw[4]), "+v"(kw[5]), "+v"(kw[6]), "+v"(kw[7]));
    asm volatile("" : "+v"(vw[0]), "+v"(vw[1]), "+v"(vw[2]), "+v"(vw[3]), "+v"(vw[4]), "+v"(vw[5]), "+v"(vw[6]), "+v"(vw[7]));
    __syncthreads();
    const float Mloc = tab[ML_MISC];
#pragma unroll
    for (int i = 0; i < 8; ++i) {
        const int piece = F.tid + 512 * i, token = piece >> 4, ch = piece & 15;
        const float g = __expf(tab[256 + token] - Mloc); unsigned ww[4] = {kw[i].x, kw[i].y, kw[i].z, kw[i].w};
#pragma unroll
        for (int k = 0; k < 4; ++k) ww[k] = pk2(__builtin_bit_cast(float, ww[k] << 16) * g, __builtin_bit_cast(float, ww[k] & 0xffff0000u) * g);
        v4u x; x.x = ww[0]; x.y = ww[1]; x.z = ww[2]; x.w = ww[3];
        const int off = (ch >> 2) * (MLC * 64) + token * 64 + (ch & 3) * 16;
        *(LAS v4u*)(KT + off) = x; *(LAS v4u*)(VT + off) = vw[i];
    }
    __syncthreads();
    const int et = F.wave >> 1, dt0 = 2 * (F.wave & 1);
    f32x16 acc0 = {}, acc1 = {};
#pragma unroll 4
    for (int s = 0; s < 16; ++s) {
        const bf16x8 a = tfrag(VT, MLC, s, et, F.lane), b0 = tfrag(KT, MLC, s, dt0, F.lane), b1 = tfrag(KT, MLC, s, dt0 + 1, F.lane);
        acc0 = mfma32(a, b0, acc0); acc1 = mfma32(a, b1, acc1);
    }
    float* dct = (float*)((unsigned char*)F.ws + WS_DCT) + ((size_t)(seq * NCH + c)) * MD * MD;
    const int hi = F.lane >> 5, cl = F.lane & 31;
#pragma unroll
    for (int r = 0; r < 16; ++r) { const int e = 32 * et + crow(r, hi); dct[(size_t)e * MD + 32 * dt0 + cl] = acc0[r]; dct[(size_t)e * MD + 32 * (dt0 + 1) + cl] = acc1[r]; }
    { const int d = F.tid & 127, qd = F.tid >> 7; float s = 0.f;
      const LAS unsigned short* kp = (const LAS unsigned short*)(KT + (d >> 5) * (MLC * 64) + (d & 31) * 2);
#pragma unroll 8
      for (int j = 0; j < 64; ++j) s += bf2f(kp[(size_t)(64 * qd + j) * 32]);
      tab[768 + F.tid] = s; }
    __syncthreads();
    if (F.tid < 128) mls[MLS_DN + (size_t)(seq * NCH + c) * MD + F.tid] = (tab[768 + F.tid] + tab[768 + 128 + F.tid]) + (tab[768 + 256 + F.tid] + tab[768 + 384 + F.tid]);
    if (F.tid == 0) { mls[MLS_SC + (seq * NCH + c) * 2] = Mloc; mls[MLS_SC + (seq * NCH + c) * 2 + 1] = tab[ML_MISC + 1]; }
    __syncthreads();
}
__device__ __forceinline__ void mlstm_stepB(Frame& F, int unit) {
    const int seq = unit >> 4, sl = unit & 15, d = F.tid & 127, el = F.tid >> 7, e0 = 8 * sl + el, e1 = e0 + 4;
    float* mls = (float*)((unsigned char*)F.ws + WS_MLS);
    const float* dctb = (const float*)((unsigned char*)F.ws + WS_DCT) + (size_t)seq * NCH * MD * MD;
    bf16* ctb = (bf16*)((unsigned char*)F.ws + WS_CT) + (size_t)seq * NCH * MD * MD;
    float x0[NCH], x1[NCH], dn[NCH];
#pragma unroll
    for (int c = 0; c < NCH; ++c) { x0[c] = dctb[(size_t)c * MD * MD + (size_t)e0 * MD + d]; x1[c] = dctb[(size_t)c * MD * MD + (size_t)e1 * MD + d]; dn[c] = mls[MLS_DN + (size_t)(seq * NCH + c) * MD + d]; }
    float C0 = 0.f, C1 = 0.f, nv = 0.f, m = 0.f;
    const bool nwriter = (sl == 0) && (el == 0);
#pragma unroll
    for (int c = 0; c < NCH; ++c) {
        ctb[(size_t)c * MD * MD + (size_t)e0 * MD + d] = (bf16)f2bf(C0); ctb[(size_t)c * MD * MD + (size_t)e1 * MD + d] = (bf16)f2bf(C1);
        if (nwriter) { mls[MLS_NC + (size_t)(seq * NCH + c) * MD + d] = nv; if (d == 0) mls[MLS_MC + seq * NCH + c] = m; }
        const float Mloc = mls[MLS_SC + (seq * NCH + c) * 2], bL = mls[MLS_SC + (seq * NCH + c) * 2 + 1];
        const float Mt = fmaxf(m, Mloc), fa = __expf(m - Mt), fb = __expf(Mloc - Mt);
        C0 = fa * C0 + fb * x0[c]; C1 = fa * C1 + fb * x1[c]; nv = fa * nv + fb * dn[c];
        m = bL + Mt;
    }
    F.out[O_CP + (size_t)seq * MD * MD + (size_t)d * MD + e0] = C0; F.out[O_CP + (size_t)seq * MD * MD + (size_t)d * MD + e1] = C1;
    if (nwriter) { F.out[O_NP + (size_t)seq * MD + d] = nv; if (d == 0) F.out[O_MP + seq] = m; }
}
__device__ __forceinline__ void mlstm_stepC(Frame& F, int unit) {
    const int seq = unit >> 4, c = unit & 15, b = seq >> 2, h = seq & 3, row0 = b * SEQ + c * MLC;
    LAS float* tab = (LAS float*)(F.lds + ML_TAB_OFF);
    LAS unsigned char* KR = F.lds + RING_OFF; LAS unsigned char* VT = F.lds + RING_OFF + 65536;
    const float* mls = (const float*)((unsigned char*)F.ws + WS_MLS);
    const float m0 = mls[MLS_MC + seq * NCH + c];
    v4u kw[8], vw[8];
    { const bf16* ksrc = SEG_MK(F) + (size_t)row0 * MW + h * MD; const bf16* vsrc = SEG_MV(F) + (size_t)row0 * MW + h * MD;
#pragma unroll
      for (int i = 0; i < 8; ++i) { const int piece = F.tid + 512 * i, token = piece >> 4, ch = piece & 15; kw[i] = *(const v4u*)(ksrc + (size_t)token * 512 + 8 * ch); vw[i] = *(const v4u*)(vsrc + (size_t)token * 512 + 8 * ch); } }
    ml_scalars(F, row0, h, m0, tab);
    if (F.tid < 128) tab[768 + F.tid] = mls[MLS_NC + (size_t)(seq * NCH + c) * MD + F.tid];
    asm volatile("" : "+v"(kw[0]), "+v"(kw[1]), "+v"(kw[2]), "+v"(kw[3]), "+v"(kw[4]), "+v"(kw[5]), "+v"(kw[6]), "+v"(kw[7]));
    asm volatile("" : "+v"(vw[0]), "+v"(vw[1]), "+v"(vw[2]), "+v"(vw[3]), "+v"(vw[4]), "+v"(vw[5]), "+v"(vw[6]), "+v"(vw[7]));
#pragma unroll
    for (int i = 0; i < 8; ++i) { const int piece = F.tid + 512 * i, token = piece >> 4, ch = piece & 15;
        *(LAS v4u*)(KR + ch * (MLC * 16) + token * 16) = kw[i];
        *(LAS v4u*)(VT + (ch >> 2) * (MLC * 64) + token * 64 + (ch & 3) * 16) = vw[i]; }
    __syncthreads();
    const int w = F.wave, lane = F.lane, tl = lane & 31, hi = lane >> 5, t0 = 32 * w, t = t0 + tl;
    bf16x8 qf[8];
    { const bf16* qp = SEG_MQ(F) + (size_t)(row0 + t) * MW + h * MD + 8 * hi;
#pragma unroll
      for (int s = 0; s < 8; ++s) qf[s] = *(const bf16x8*)(qp + 16 * s); }
    float qn = 0.f;
#pragma unroll
    for (int s = 0; s < 8; ++s)
#pragma unroll
        for (int i = 0; i < 8; ++i) qn += bf2f((unsigned short)qf[s][i]) * tab[768 + 16 * s + 8 * hi + i];
    qn = half_swap_add(qn);
    const float Mt = tab[512 + t], wt = __expf(m0 - Mt);
    f32x16 acc[4];
    const bf16* ct = (const bf16*)((unsigned char*)F.ws + WS_CT) + (size_t)(seq * NCH + c) * MD * MD;
#pragma unroll
    for (int et = 0; et < 4; ++et) { acc[et] = (f32x16){};
#pragma unroll
        for (int s = 0; s < 8; ++s) { const bf16x8 cf = *(const bf16x8*)(ct + (size_t)(32 * et + tl) * MD + 16 * s + 8 * hi); acc[et] = mfma32(qf[s], cf, acc[et]); } }
    LAS float* wsc = tab + ML_WSC + 64 * w;
    if (hi == 0) wsc[tl] = wt;
    asm volatile("s_waitcnt lgkmcnt(0)" ::: "memory");
#pragma unroll
    for (int r = 0; r < 16; ++r) { const float ws_ = wsc[crow(r, hi)];
#pragma unroll
        for (int et = 0; et < 4; ++et) acc[et][r] *= ws_; }
    float rs = 0.f;
    for (int jt = 0; jt <= w; ++jt) {
        f32x16 st = {};
#pragma unroll
        for (int s = 0; s < 8; ++s) st = mfma32(rfrag(KR, MLC, jt, s, lane), qf[s], st);
#pragma unroll
        for (int r = 0; r < 16; ++r) { const int j = 32 * jt + crow(r, hi); const float v = st[r] * __expf(tab[256 + j] - Mt); st[r] = (j <= t) ? v : 0.f; rs += st[r]; }
        bf16x8 pa0, pa1;
#pragma unroll
        for (int i = 0; i < 4; ++i) { const unsigned p0 = pk2(st[2 * i], st[2 * i + 1]), p1 = pk2(st[8 + 2 * i], st[8 + 2 * i + 1]);
            pa0[2 * i] = (short)(p0 & 0xffff); pa0[2 * i + 1] = (short)(p0 >> 16); pa1[2 * i] = (short)(p1 & 0xffff); pa1[2 * i + 1] = (short)(p1 >> 16); }
#pragma unroll
        for (int et = 0; et < 4; ++et) { acc[et] = mfma32(pa0, tfrag(VT, MLC, 2 * jt, et, lane), acc[et]); acc[et] = mfma32(pa1, tfrag(VT, MLC, 2 * jt + 1, et, lane), acc[et]); }
    }
    rs = half_swap_add(rs);
    const float den = wt * qn + rs, mt = tab[t] + Mt, sc = 1.f / fmaxf(fabsf(den), __expf(-mt));
    asm volatile("s_waitcnt lgkmcnt(0)" ::: "memory");
    if (hi == 0) wsc[32 + tl] = sc;
    asm volatile("s_waitcnt lgkmcnt(0)" ::: "memory");
    __syncthreads();
    LAS float* hl = (LAS float*)(F.lds + RING_OFF) + w * 4096;
#pragma unroll
    for (int r = 0; r < 16; ++r) { const int tr = crow(r, hi); const float s_ = wsc[32 + tr];
#pragma unroll
        for (int et = 0; et < 4; ++et) hl[tr * 128 + 32 * et + tl] = acc[et][r] * s_; }
    asm volatile("s_waitcnt lgkmcnt(0)" ::: "memory");
    {
        const float g0 = F.ml_norm[h * MD + 2 * lane], g1 = F.ml_norm[h * MD + 2 * lane + 1];
        unsigned mo[32];
#pragma unroll
        for (int i = 0; i < 32; ++i) mo[i] = *(const unsigned*)(SEG_MO(F) + (size_t)(row0 + 32 * w + i) * MW + h * MD + 2 * lane);
#pragma unroll
        for (int i = 0; i < 32; ++i) { const size_t row = (size_t)(row0 + 32 * w + i);
            typedef float f32x2_l __attribute__((ext_vector_type(2))); const f32x2_l hv = *(const LAS f32x2_l*)(hl + i * 128 + 2 * lane);
            const float rstd = 1.f / sqrtf(wave_sum(hv.x * hv.x + hv.y * hv.y) * (1.f / MD) + RMS_EPS);
            const float z0 = __builtin_bit_cast(float, mo[i] << 16), z1 = __builtin_bit_cast(float, mo[i] & 0xffff0000u);
            *(unsigned*)(F.MIX + row * D + AW + h * MD + 2 * lane) = pk2(hv.x * rstd * g0 / (1.f + __expf(-z0)), hv.y * rstd * g1 / (1.f + __expf(-z1))); }
    }
    __syncthreads();
}

__device__ __forceinline__ void mlstm_sample_full(Frame& F, int seq) {
    const int sb = seq >> 2, h = seq & 3, e = F.tid & 127, dq = F.tid >> 7, row0 = MP + sb * DS;
    LAS float* red = (LAS float*)(F.lds + RING_OFF);
    float C[32], nn[32];
    const float* C0 = F.state_C + (size_t)seq * MD * MD;
#pragma unroll
    for (int i = 0; i < 32; ++i) { C[i] = C0[(size_t)(32 * dq + i) * MD + e]; nn[i] = F.state_n[(size_t)seq * MD + 32 * dq + i]; }
    float mm = F.state_m[seq];
    LAS unsigned* inb = (LAS unsigned*)(red + 2048);
    LAS float* gts = red + 2048 + 1536;
    __syncthreads();
    for (int i = F.tid; i < DS * 3 * 64; i += NWAVES * 64) { const int t = i / 192, r = i % 192, which = r >> 6, wd = r & 63;
        inb[i] = *((const unsigned*)(F.SEG + (size_t)(3 + which) * SEG_ELEMS + (size_t)(row0 + t) * MW + h * MD) + wd); }
    if (F.tid < DS * 2) { const int t = F.tid >> 1; gts[F.tid] = (F.tid & 1) ? F.LF[(size_t)(row0 + t) * 4 + h] : F.IG[(size_t)(row0 + t) * 4 + h]; }
    __syncthreads();
    for (int t = 0; t < DS; ++t) {
        const LAS v4u* qp = (const LAS v4u*)(inb + t * 192) + 4 * dq; const LAS v4u* kp = (const LAS v4u*)(inb + t * 192 + 64) + 4 * dq;
        const unsigned vw = inb[t * 192 + 128 + (e >> 1)]; const float v = __builtin_bit_cast(float, (e & 1) ? (vw & 0xffff0000u) : (vw << 16));
        const float ig = gts[2 * t], lf = gts[2 * t + 1];
        const float mn = fmaxf(lf + mm, ig), fs = __expf(lf + mm - mn), is = __expf(ig - mn);
        float num = 0.f, den = 0.f;
#pragma unroll
        for (int c = 0; c < 4; ++c) { const v4u qw = qp[c], kw = kp[c]; const unsigned qq[4] = {qw.x, qw.y, qw.z, qw.w}, kk[4] = {kw.x, kw.y, kw.z, kw.w};
#pragma unroll
            for (int j = 0; j < 8; ++j) { const int i = 8 * c + j;
                const float qv = __builtin_bit_cast(float, (j & 1) ? (qq[j >> 1] & 0xffff0000u) : (qq[j >> 1] << 16)), kv = __builtin_bit_cast(float, (j & 1) ? (kk[j >> 1] & 0xffff0000u) : (kk[j >> 1] << 16));
                C[i] = fs * C[i] + is * kv * v; nn[i] = fs * nn[i] + is * kv; num += qv * C[i]; den += qv * nn[i]; } }
        mm = mn;
        red[dq * 128 + e] = num; red[512 + dq * 128 + e] = den;
        __syncthreads();
        if (dq == 0) { const float nu = (red[e] + red[128 + e]) + (red[256 + e] + red[384 + e]), de = (red[512 + e] + red[640 + e]) + (red[768 + e] + red[896 + e]);
            red[1024 + t * 128 + e] = nu / fmaxf(fabsf(de), __expf(-mn)); }
        __syncthreads();
    }
    { const int t = F.wave; const size_t row = (size_t)(row0 + t);
      const float h0 = red[1024 + t * 128 + 2 * F.lane], h1 = red[1024 + t * 128 + 2 * F.lane + 1];
      const float rstd = 1.f / sqrtf(wave_sum(h0 * h0 + h1 * h1) * (1.f / MD) + RMS_EPS);
      const unsigned mo = *(const unsigned*)(SEG_MO(F) + row * MW + h * MD + 2 * F.lane);
      const float z0 = __builtin_bit_cast(float, mo << 16), z1 = __builtin_bit_cast(float, mo & 0xffff0000u);
      const float g0 = F.ml_norm[h * MD + 2 * F.lane], g1 = F.ml_norm[h * MD + 2 * F.lane + 1];
      *(unsigned*)(F.MIX + row * D + AW + h * MD + 2 * F.lane) = pk2(h0 * rstd * g0 / (1.f + __expf(-z0)), h1 * rstd * g1 / (1.f + __expf(-z1))); }
    float* Co = F.out + O_CS + (size_t)seq * MD * MD;
#pragma unroll
    for (int i = 0; i < 32; ++i) Co[(size_t)(32 * dq + i) * MD + e] = C[i];
    if (e == 0) {
#pragma unroll
        for (int i = 0; i < 32; ++i) F.out[O_NS + (size_t)seq * MD + 32 * dq + i] = nn[i];
        if (dq == 0) F.out[O_MS + seq] = mm;
    }
    __syncthreads();
}

constexpr size_t WS_LIST = 480 * MiB;
constexpr size_t WS_CNT = 484 * MiB;
constexpr size_t WS_PARTO = 485 * MiB;
constexpr size_t WS_PARTS = 534 * MiB;
constexpr size_t WS_END3 = 538 * MiB;
constexpr size_t WS_QG = 560 * MiB;
constexpr size_t WS_END_QG = 682 * MiB;
__host__ __device__ constexpr int past_item_index(int bh, int n, int o) { return bh * 120 + 15 * n - (n * (n - 1)) / 2 + (o - n - 1); }
constexpr int AT_WSC = 192;
constexpr int AT_LUT = 768;

__device__ __forceinline__ void build_lut(Frame& F, const LAS int* bucket, int h, LAS float* lut) {
    if (F.tid < 128) lut[F.tid] = F.rel_bias[bucket[F.tid] * AH + h];
    if (F.tid == 128) lut[128] = F.rel_bias[31 * AH + h];
}
__device__ __forceinline__ void stage_kv64(Frame& F, const bf16* ksrc, const bf16* vsrc, LAS unsigned char* KR, LAS unsigned char* VT) {
    v4u kk[4], vv[4];
#pragma unroll
    for (int i = 0; i < 4; ++i) { const int piece = F.tid + 512 * i, key = piece >> 3, ch = piece & 7;
        kk[i] = *(const v4u*)(ksrc + (size_t)key * AW + 8 * ch); vv[i] = *(const v4u*)(vsrc + (size_t)key * AW + 8 * ch); }
    asm volatile("" : "+v"(kk[0]), "+v"(kk[1]), "+v"(kk[2]), "+v"(kk[3]), "+v"(vv[0]), "+v"(vv[1]), "+v"(vv[2]), "+v"(vv[3]));
#pragma unroll
    for (int i = 0; i < 4; ++i) { const int piece = F.tid + 512 * i, key = piece >> 3, ch = piece & 7;
        *(LAS v4u*)(KR + ch * (256 * 16) + key * 16) = kk[i];
        *(LAS v4u*)(VT + (ch >> 2) * (256 * 64) + key * 64 + (ch & 3) * 16) = vv[i]; }
}
__device__ __forceinline__ void attn_select2(Frame& F, int ua, int ub) {
    const int half = F.tid >> 8, qt = F.tid & 255, unit = half ? ub : ua;
    const bool act = unit >= 0;
    const int bh = act ? unit / 15 : 0, o = act ? unit % 15 + 1 : 1, b = bh >> 3, h = bh & 7;
    LAS float* ks = (LAS float*)(F.lds + RING_OFF + half * 8192);
    LAS int* cnt = (LAS int*)(F.lds + RING_OFF + half * 8192 + 4096);
    __syncthreads();
    const int m = b * SEQ + o * 256 + qt;
    v4u qw[8];
    { const v4u* qp = (const v4u*)(SEG_AQ(F) + (size_t)m * AW + h * AD);
#pragma unroll
      for (int c = 0; c < 8; ++c) qw[c] = act ? qp[c] : (v4u){0u, 0u, 0u, 0u}; }
    float kv[4];
#pragma unroll
    for (int i = 0; i < 4; ++i) { const int idx = qt + 256 * i; kv[i] = (act && idx < o * 64) ? F.KSUM[((size_t)(b * NBLK_P + (idx >> 6))) * AW + h * AD + (idx & 63)] : 0.f; }
#pragma unroll
    for (int i = 0; i < 4; ++i) { const int idx = qt + 256 * i; if (idx < 15 * 64) ks[idx] = kv[i]; }
    if (qt < 16) cnt[qt] = 0;
    __syncthreads();
    if (act) {
        float q[64];
#pragma unroll
        for (int c = 0; c < 8; ++c) { const v4u w = qw[c];
            q[8 * c + 0] = __builtin_bit_cast(float, w.x << 16); q[8 * c + 1] = __builtin_bit_cast(float, w.x & 0xffff0000u);
            q[8 * c + 2] = __builtin_bit_cast(float, w.y << 16); q[8 * c + 3] = __builtin_bit_cast(float, w.y & 0xffff0000u);
            q[8 * c + 4] = __builtin_bit_cast(float, w.z << 16); q[8 * c + 5] = __builtin_bit_cast(float, w.z & 0xffff0000u);
            q[8 * c + 6] = __builtin_bit_cast(float, w.w << 16); q[8 * c + 7] = __builtin_bit_cast(float, w.w & 0xffff0000u); }
        float s0 = -INFINITY, s1 = -INFINITY, s2 = -INFINITY; int i0 = -1, i1 = -1, i2 = -1;
        for (int n = 0; n < o; ++n) {
            float s = 0.f;
#pragma unroll
            for (int d = 0; d < 64; ++d) s += q[d] * ks[n * 64 + d];
            if (s > s0) { s2 = s1; i2 = i1; s1 = s0; i1 = i0; s0 = s; i0 = n; }
            else if (s > s1) { s2 = s1; i2 = i1; s1 = s; i1 = n; }
            else if (s > s2) { s2 = s; i2 = n; }
        }
        unsigned short* list = (unsigned short*)(F.ws + WS_LIST);
#pragma unroll
        for (int j = 0; j < 3; ++j) {
            const int n = (j == 0) ? i0 : (j == 1 ? i1 : i2);
            if (n >= 0) { const int slot = __hip_atomic_fetch_add(&cnt[n], 1, __ATOMIC_RELAXED, __HIP_MEMORY_SCOPE_WORKGROUP);
                const size_t e = (size_t)past_item_index(bh, n, o) * 256 + slot;
                list[e] = (unsigned short)(qt | (j << 8));
                v4u* qg = (v4u*)((bf16*)(F.ws + WS_QG) + e * 64);
#pragma unroll
                for (int c = 0; c < 8; ++c) qg[c] = qw[c]; }
        }
    }
    __syncthreads();
    if (act && qt < o) ((int*)(F.ws + WS_CNT))[past_item_index(bh, qt, o)] = cnt[qt];
}
struct AttnOut { f32x16 o0, o1; float mx, l; };
__device__ __forceinline__ float max3f(float a, float b, float c) { float r; asm("v_max3_f32 %0, %1, %2, %3" : "=v"(r) : "v"(a), "v"(b), "v"(c)); return r; }
__device__ __forceinline__ void pack_p(const f32x16& p, bf16x8& pa0, bf16x8& pa1) {
#pragma unroll
    for (int i = 0; i < 4; ++i) { const unsigned p0 = pk2(p[2 * i], p[2 * i + 1]), p1 = pk2(p[8 + 2 * i], p[8 + 2 * i + 1]);
        pa0[2 * i] = (short)(p0 & 0xffff); pa0[2 * i + 1] = (short)(p0 >> 16); pa1[2 * i] = (short)(p1 & 0xffff); pa1[2 * i + 1] = (short)(p1 >> 16); }
}
template <bool CAUSAL>
__device__ __forceinline__ f32x16 score_tile(const LAS unsigned char* KR, const bf16x8 (&qf)[4], int lane, int kt, int tq, bool lutp, const LAS float* lut, float b31) {
    const int hi = lane >> 5;
    f32x16 a = {};
#pragma unroll
    for (int s = 0; s < 4; ++s) a = mfma32(rfrag(KR, 256, kt, s, lane), qf[s], a);
    if (lutp) {
#pragma unroll
        for (int r = 0; r < 16; ++r) { const int key = 32 * kt + crow(r, hi); int dist = tq - key; dist = dist < 0 ? 0 : (dist > 128 ? 128 : dist); a[r] += lut[dist]; if (CAUSAL && key > tq) a[r] = -INFINITY; }
    } else {
#pragma unroll
        for (int r = 0; r < 16; ++r) a[r] += b31;
    }
    return a;
}
template <bool CAUSAL>
__device__ __forceinline__ AttnOut wave_attend(const LAS unsigned char* KR, const LAS unsigned char* VT, const bf16x8 (&qf)[4], int lane, int nkt  ,
                                               int tq  , bool use_lut  , int lut_from_kt  , const LAS float* lut, float b31, int kt0 = 0  ) {
    AttnOut R; R.o0 = (f32x16){}; R.o1 = (f32x16){}; R.mx = -1e30f; R.l = 0.f;
    for (int kt = kt0; kt < nkt; kt += 2) {
        const bool two = (kt + 1 < nkt);
        f32x16 a0 = score_tile<CAUSAL>(KR, qf, lane, kt, tq, use_lut && kt >= lut_from_kt, lut, b31);
        f32x16 a1 = a0;
        if (two) a1 = score_tile<CAUSAL>(KR, qf, lane, kt + 1, tq, use_lut && kt + 1 >= lut_from_kt, lut, b31);
        float cm0 = max3f(a0[0], a0[1], a1[0]), cm1 = max3f(a0[2], a0[3], a1[1]);
        cm0 = max3f(cm0, a1[2], a1[3]);
#pragma unroll
        for (int r = 4; r < 16; r += 4) { cm0 = max3f(cm0, a0[r], a0[r + 1]); cm1 = max3f(cm1, a0[r + 2], a0[r + 3]); cm0 = max3f(cm0, a1[r], a1[r + 1]); cm1 = max3f(cm1, a1[r + 2], a1[r + 3]); }
        float cm = max3f(cm0, cm1, cm1);
        cm = fmaxf(cm, __shfl_xor(cm, 32));
        constexpr float L2E = 1.4426950408889634f;
        const float mn = fmaxf(R.mx, cm), f = __builtin_amdgcn_exp2f((R.mx - mn) * L2E), mnl = mn * L2E;
        R.mx = mn; R.l *= f;
#pragma unroll
        for (int r = 0; r < 16; ++r) { R.o0[r] *= f; R.o1[r] *= f; }
        float ls = 0.f;
#pragma unroll
        for (int r = 0; r < 16; ++r) { a0[r] = __builtin_amdgcn_exp2f(fmaf(a0[r], L2E, -mnl)); ls += a0[r]; }
        bf16x8 pa0, pa1;
        pack_p(a0, pa0, pa1);
        R.o0 = mfma32(tfrag(VT, 256, 2 * kt, 0, lane), pa0, R.o0); R.o1 = mfma32(tfrag(VT, 256, 2 * kt, 1, lane), pa0, R.o1);
        R.o0 = mfma32(tfrag(VT, 256, 2 * kt + 1, 0, lane), pa1, R.o0); R.o1 = mfma32(tfrag(VT, 256, 2 * kt + 1, 1, lane), pa1, R.o1);
        if (two) {
#pragma unroll
            for (int r = 0; r < 16; ++r) { a1[r] = __builtin_amdgcn_exp2f(fmaf(a1[r], L2E, -mnl)); ls += a1[r]; }
            pack_p(a1, pa0, pa1);
            R.o0 = mfma32(tfrag(VT, 256, 2 * kt + 2, 0, lane), pa0, R.o0); R.o1 = mfma32(tfrag(VT, 256, 2 * kt + 2, 1, lane), pa0, R.o1);
            R.o0 = mfma32(tfrag(VT, 256, 2 * kt + 3, 0, lane), pa1, R.o0); R.o1 = mfma32(tfrag(VT, 256, 2 * kt + 3, 1, lane), pa1, R.o1);
        }
        R.l += ls;
    }
    R.l += __shfl_xor(R.l, 32);
    return R;
}
constexpr int PAST_NITEMS = 32 * 120;
__device__ __forceinline__ void past_item_decode(int it, int& bh, int& n, int& o) { bh = it / 120; int pr = it % 120; n = 0; while (pr >= 15 - n) { pr -= 15 - n; ++n; } o = n + 1 + pr; }
__device__ __forceinline__ void attn_past_items(Frame& F, const LAS int* bucket) {
    LAS unsigned char* KR = F.lds + RING_OFF; LAS unsigned char* VT = F.lds + RING_OFF + 32768;
    LAS int* S = (LAS int*)(F.lds + RING_OFF + 65536);
    LAS int* C = S + 4096;
    LAS int* wsum = C + 4096;
    LAS float* tab = (LAS float*)(F.lds + ML_TAB_OFF); LAS float* lut = tab + AT_LUT;
    const int lane = F.lane, tl = lane & 31, hi = lane >> 5;
    const int* cntg = (const int*)(F.ws + WS_CNT);
    __syncthreads();
    {
        int cc[8] = {0, 0, 0, 0, 0, 0, 0, 0};
        if (8 * F.tid < PAST_NITEMS) { const int4 a = *(const int4*)(cntg + 8 * F.tid), bq = *(const int4*)(cntg + 8 * F.tid + 4); cc[0] = a.x; cc[1] = a.y; cc[2] = a.z; cc[3] = a.w; cc[4] = bq.x; cc[5] = bq.y; cc[6] = bq.z; cc[7] = bq.w; }
        int g[8], tot = 0;
#pragma unroll
        for (int k = 0; k < 8; ++k) { g[k] = (cc[k] + 31) >> 5; tot += g[k]; }
        int x = tot;
#pragma unroll
        for (int o = 1; o < 64; o <<= 1) { const int y = __shfl_up(x, o); if (lane >= o) x += y; }
        if (lane == 63) wsum[F.wave] = x;
        __syncthreads();
        int base = x - tot;
#pragma unroll
        for (int w = 0; w < 8; ++w) if (w < F.wave) base += wsum[w];
#pragma unroll
        for (int k = 0; k < 8; ++k) { const int it = 8 * F.tid + k; if (it < PAST_NITEMS) { S[it] = base; C[it] = cc[k]; } base += g[k]; }
        if (F.tid == 511) S[PAST_NITEMS] = base;
        __syncthreads();
    }
    const int T = S[PAST_NITEMS];
    const int lo = (int)(((long long)T * blockIdx.x) / F.G), hiG = (int)(((long long)T * (blockIdx.x + 1)) / F.G);
    int it = 0;
    { int a = 0, b = PAST_NITEMS; while (b - a > 1) { const int m = (a + b) >> 1; if (S[m] <= lo) a = m; else b = m; } it = a; }
    int cur_h = -1;
    while (lo < hiG && it < PAST_NITEMS && S[it] < hiG) {
        if (S[it + 1] == S[it] || S[it + 1] <= lo) { ++it; continue; }
        int bh, n, o0; past_item_decode(it, bh, n, o0);
        const int b = bh >> 3, h = bh & 7;
        const int run_end_item = it + (15 - o0) + 1;
        const int ra = S[it] > lo ? S[it] : lo;
        int rbx = S[run_end_item < PAST_NITEMS ? run_end_item : PAST_NITEMS]; const int rb = rbx < hiG ? rbx : hiG;
        int wi = it;
        int gamma = ra + F.wave;
        int p_dst = -1, p_tl = 0, p_o = 0; bf16x8 pq[4] = {};
        int r_dst = -1, r_tl = 0, r_o = 0; bf16x8 rq[4] = {};
#define PAST_FETCH(G_, DST_, TL_, O_, Q_) do { while (S[wi + 1] <= (G_)) ++wi; const int o_ = o0 + (wi - it); const int c_ = C[wi]; \
            const int qi_ = 32 * ((G_) - S[wi]) + tl; const bool v_ = qi_ < c_; const size_t e_ = (size_t)wi * 256 + (v_ ? qi_ : 0); \
            const unsigned ent_ = ((const unsigned short*)(F.ws + WS_LIST))[e_]; \
            const bf16* qp_ = (const bf16*)(F.ws + WS_QG) + e_ * 64 + 8 * hi; \
            _Pragma("unroll") for (int s_ = 0; s_ < 4; ++s_) (Q_)[s_] = *(const bf16x8*)(qp_ + 16 * s_); \
            (TL_) = ent_ & 255; (O_) = o_; (DST_) = v_ ? (((b * SEQ + o_ * 256 + (int)(ent_ & 255)) * AH + h) * 3 + (int)(ent_ >> 8)) : -1; } while (0)
        if (gamma < rb) PAST_FETCH(gamma, p_dst, p_tl, p_o, pq);
        if (gamma + 8 < rb) PAST_FETCH(gamma + 8, r_dst, r_tl, r_o, rq);
        __syncthreads();
        if (h != cur_h) { build_lut(F, bucket, h, lut); cur_h = h; }
        stage_kv64(F, SEG_AK(F) + (size_t)(b * SEQ + n * 256) * AW + h * AD, SEG_AV(F) + (size_t)(b * SEQ + n * 256) * AW + h * AD, KR, VT);
        __syncthreads();
        const float b31 = lut[128];
        while (gamma < rb) {
            const int dst = p_dst, t_local = p_tl; const bool adj = (p_o == n + 1);
            bf16x8 qf[4] = {pq[0], pq[1], pq[2], pq[3]};
            p_dst = r_dst; p_tl = r_tl; p_o = r_o; pq[0] = rq[0]; pq[1] = rq[1]; pq[2] = rq[2]; pq[3] = rq[3];
            if (gamma + 16 < rb) PAST_FETCH(gamma + 16, r_dst, r_tl, r_o, rq);
            AttnOut R = wave_attend<false>(KR, VT, qf, lane, 8, 256 + t_local, adj, 4, lut, b31);
            if (dst >= 0) {
                if (hi == 0) { float* ps = (float*)(F.ws + WS_PARTS) + (size_t)dst * 2; ps[0] = R.mx; ps[1] = R.l; }
                const float rl = 1.f / R.l;
                bf16* po = (bf16*)(F.ws + WS_PARTO) + (size_t)dst * 64 + 4 * hi;
#pragma unroll
                for (int g = 0; g < 4; ++g) {
                    *(unsigned long long*)(po + 8 * g) = (unsigned long long)pk2(R.o0[4 * g] * rl, R.o0[4 * g + 1] * rl) | ((unsigned long long)pk2(R.o0[4 * g + 2] * rl, R.o0[4 * g + 3] * rl) << 32);
                    *(unsigned long long*)(po + 32 + 8 * g) = (unsigned long long)pk2(R.o1[4 * g] * rl, R.o1[4 * g + 1] * rl) | ((unsigned long long)pk2(R.o1[4 * g + 2] * rl, R.o1[4 * g + 3] * rl) << 32);
                }
            }
            gamma += 8;
        }
#undef PAST_FETCH
        it = run_end_item;
    }
    __syncthreads();
}
struct OwnLoads { bf16x8 qf[4]; float pm[3], pl[3]; unsigned long long pw0[3][4], pw1[3][4]; };
__device__ __forceinline__ void own_group_load(Frame& F, int b, int h, int o, int grp, OwnLoads& L) {
    const int lane = F.lane, tl = lane & 31, hi = lane >> 5;
    const int row = b * SEQ + o * 256 + 32 * grp + tl;
    { const bf16* qp = SEG_AQ(F) + (size_t)row * AW + h * AD + 8 * hi;
#pragma unroll
      for (int s = 0; s < 4; ++s) L.qf[s] = *(const bf16x8*)(qp + 16 * s); }
    const int np = o < 3 ? o : 3;
    const float* ps = (const float*)(F.ws + WS_PARTS) + (size_t)(row * AH + h) * 6;
    const bf16* po = (const bf16*)(F.ws + WS_PARTO) + (size_t)(row * AH + h) * 3 * 64 + 4 * hi;
#pragma unroll
    for (int j = 0; j < 3; ++j) {
        if (j < np) { L.pm[j] = ps[2 * j]; L.pl[j] = ps[2 * j + 1];
#pragma unroll
            for (int g = 0; g < 4; ++g) { L.pw0[j][g] = *(const unsigned long long*)(po + j * 64 + 8 * g); L.pw1[j][g] = *(const unsigned long long*)(po + j * 64 + 32 + 8 * g); } }
        else { L.pm[j] = -INFINITY; L.pl[j] = 0.f;
#pragma unroll
            for (int g = 0; g < 4; ++g) { L.pw0[j][g] = 0ull; L.pw1[j][g] = 0ull; } }
    }
}
__device__ __forceinline__ void own_group_compute(Frame& F, const LAS unsigned char* KR, const LAS unsigned char* VT, const LAS float* lut, int b, int h, int o, int grp, const OwnLoads& L) {
    const int lane = F.lane, tl = lane & 31, hi = lane >> 5;
    const int t_local = 32 * grp + tl, row = b * SEQ + o * 256 + t_local, np = o < 3 ? o : 3;
    AttnOut R = wave_attend<true>(KR, VT, L.qf, lane, grp + 1, t_local, true, 0, lut, 0.f);
    float mt = R.mx;
#pragma unroll
    for (int j = 0; j < 3; ++j) mt = fmaxf(mt, L.pm[j]);
    const float e_own = __expf(R.mx - mt); float aj[3], Ls = e_own * R.l;
#pragma unroll
    for (int j = 0; j < 3; ++j) { aj[j] = (j < np) ? __expf(L.pm[j] - mt) * L.pl[j] : 0.f; Ls += aj[j]; }
    const float rL = 1.f / Ls, a_own = e_own * rL;
#pragma unroll
    for (int j = 0; j < 3; ++j) aj[j] *= rL;
    bf16* mp = F.MIX + (size_t)row * D + h * AD + 4 * hi;
#pragma unroll
    for (int g = 0; g < 4; ++g) {
        float v0[4], v1[4];
#pragma unroll
        for (int i = 0; i < 4; ++i) { v0[i] = R.o0[4 * g + i] * a_own; v1[i] = R.o1[4 * g + i] * a_own; }
#pragma unroll
        for (int j = 0; j < 3; ++j) {
#pragma unroll
            for (int i = 0; i < 4; ++i) { v0[i] += aj[j] * bf2f((unsigned short)(L.pw0[j][g] >> (16 * i))); v1[i] += aj[j] * bf2f((unsigned short)(L.pw1[j][g] >> (16 * i))); }
        }
        *(unsigned long long*)(mp + 8 * g) = (unsigned long long)pk2(v0[0], v0[1]) | ((unsigned long long)pk2(v0[2], v0[3]) << 32);
        *(unsigned long long*)(mp + 32 + 8 * g) = (unsigned long long)pk2(v1[0], v1[1]) | ((unsigned long long)pk2(v1[2], v1[3]) << 32);
    }
}
__device__ __forceinline__ void attn_own_pair(Frame& F, const LAS int* bucket, int ua, int ub) {
    const int bha = ua >> 4, oa = ua & 15, ba = bha >> 3, ha = bha & 7, bhb = ub >> 4, ob = ub & 15, bb = bhb >> 3, hb = bhb & 7;
    LAS unsigned char* KA = F.lds + RING_OFF; LAS unsigned char* VA = KA + 32768; LAS unsigned char* KB = KA + 65536; LAS unsigned char* VB = KA + 98304;
    LAS float* tab = (LAS float*)(F.lds + ML_TAB_OFF); LAS float* lutA = tab + AT_LUT; LAS float* lutB = tab + AT_LUT + 132;
    __syncthreads();
    build_lut(F, bucket, ha, lutA); build_lut(F, bucket, hb, lutB);
    OwnLoads LA; own_group_load(F, ba, ha, oa, F.wave, LA);
    {
        const bf16* ka = SEG_AK(F) + (size_t)(ba * SEQ + oa * 256) * AW + ha * AD; const bf16* va = SEG_AV(F) + (size_t)(ba * SEQ + oa * 256) * AW + ha * AD;
        const bf16* kb = SEG_AK(F) + (size_t)(bb * SEQ + ob * 256) * AW + hb * AD; const bf16* vb = SEG_AV(F) + (size_t)(bb * SEQ + ob * 256) * AW + hb * AD;
        v4u x[16];
#pragma unroll
        for (int i = 0; i < 4; ++i) { const int piece = F.tid + 512 * i, key = piece >> 3, ch = piece & 7; const size_t off = (size_t)key * AW + 8 * ch;
            x[4 * i] = *(const v4u*)(ka + off); x[4 * i + 1] = *(const v4u*)(va + off); x[4 * i + 2] = *(const v4u*)(kb + off); x[4 * i + 3] = *(const v4u*)(vb + off); }
        asm volatile("" : "+v"(x[0]), "+v"(x[1]), "+v"(x[2]), "+v"(x[3]), "+v"(x[4]), "+v"(x[5]), "+v"(x[6]), "+v"(x[7]));
        asm volatile("" : "+v"(x[8]), "+v"(x[9]), "+v"(x[10]), "+v"(x[11]), "+v"(x[12]), "+v"(x[13]), "+v"(x[14]), "+v"(x[15]));
#pragma unroll
        for (int i = 0; i < 4; ++i) { const int piece = F.tid + 512 * i, key = piece >> 3, ch = piece & 7;
            const int ko = ch * (256 * 16) + key * 16, vo = (ch >> 2) * (256 * 64) + key * 64 + (ch & 3) * 16;
            *(LAS v4u*)(KA + ko) = x[4 * i]; *(LAS v4u*)(VA + vo) = x[4 * i + 1]; *(LAS v4u*)(KB + ko) = x[4 * i + 2]; *(LAS v4u*)(VB + vo) = x[4 * i + 3]; }
    }
    __syncthreads();
    OwnLoads LB; own_group_load(F, bb, hb, ob, 7 - F.wave, LB);
    own_group_compute(F, KA, VA, lutA, ba, ha, oa, F.wave, LA);
    own_group_compute(F, KB, VB, lutB, bb, hb, ob, 7 - F.wave, LB);
}
constexpr size_t WS_SELS = 538 * MiB;
constexpr size_t WS_PARTOS = 539 * MiB;
constexpr size_t WS_PARTSS = 540 * MiB;
constexpr size_t WS_KSUMP = 541 * MiB;
constexpr size_t WS_SITEMS = 545 * MiB;
constexpr size_t WS_END4 = 546 * MiB;
constexpr int CW_SITEMS = 8192;
__device__ __forceinline__ void sample_select(Frame& F) {
    LAS unsigned* um = (LAS unsigned*)(F.lds + RING_OFF);
    const int lane = F.lane, n = lane & 31, st = 2 * F.wave + (lane >> 5);
    for (int pr = blockIdx.x; pr < DB * AH; pr += F.G) {
        const int sb = pr >> 3, h = pr & 7;
        __syncthreads();
        if (F.tid == 0) um[0] = 0u;
        __syncthreads();
        if (F.wave < 4) {
            const int m = MP + sb * DS + st;
            v4u qw[8]; f32x4 ka[16], kb[16];
            { const v4u* qp = (const v4u*)(SEG_AQ(F) + (size_t)m * AW + h * AD);
#pragma unroll
              for (int c = 0; c < 8; ++c) qw[c] = qp[c]; }
            { const f32x4* k0 = (const f32x4*)((const float*)(F.ws + WS_KSUMP) + ((size_t)(sb * NPAGES + 2 * n)) * AW + h * AD); const f32x4* k1 = k0 + AW / 4;
#pragma unroll
              for (int c = 0; c < 16; ++c) { ka[c] = k0[c]; kb[c] = k1[c]; } }
            float s = 0.f;
#pragma unroll
            for (int c = 0; c < 8; ++c) { const unsigned ww[4] = {qw[c].x, qw[c].y, qw[c].z, qw[c].w};
                const f32x4 a0 = ka[2 * c] + kb[2 * c], a1 = ka[2 * c + 1] + kb[2 * c + 1];
                s += __builtin_bit_cast(float, ww[0] << 16) * a0.x + __builtin_bit_cast(float, ww[0] & 0xffff0000u) * a0.y + __builtin_bit_cast(float, ww[1] << 16) * a0.z + __builtin_bit_cast(float, ww[1] & 0xffff0000u) * a0.w
                   + __builtin_bit_cast(float, ww[2] << 16) * a1.x + __builtin_bit_cast(float, ww[2] & 0xffff0000u) * a1.y + __builtin_bit_cast(float, ww[3] << 16) * a1.z + __builtin_bit_cast(float, ww[3] & 0xffff0000u) * a1.w; }
            int sel[3]; unsigned mask = 0u;
#pragma unroll
            for (int j = 0; j < 3; ++j) {
                float v = s; int bn = n;
#pragma unroll
                for (int o = 1; o < 32; o <<= 1) { const float ov = __shfl_xor(v, o); const int on = __shfl_xor(bn, o); if (ov > v || (ov == v && on < bn)) { v = ov; bn = on; } }
                sel[j] = bn; mask |= 1u << bn;
                if (bn == n) s = -INFINITY;
            }
            if (n == 0) { int* so = (int*)(F.ws + WS_SELS) + (size_t)((sb * DS + st) * AH + h) * 3; so[0] = sel[0]; so[1] = sel[1]; so[2] = sel[2];
                __hip_atomic_fetch_or(um, mask, __ATOMIC_RELAXED, __HIP_MEMORY_SCOPE_WORKGROUP); }
        }
        __syncthreads();
        if (F.wave == 0) {
            const unsigned mask = um[0];
            unsigned base = 0u;
            if (lane == 0) base = __hip_atomic_fetch_add((unsigned*)(F.ctl + CW_SITEMS), (unsigned)__popc(mask), __ATOMIC_RELAXED, __HIP_MEMORY_SCOPE_AGENT);
            base = __shfl(base, 0);
            if (lane < 32 && ((mask >> lane) & 1u)) ((int*)(F.ws + WS_SITEMS))[base + __popc(mask & ((1u << lane) - 1u))] = (sb << 8) | (h << 5) | lane;
        }
    }
    __syncthreads();
}
struct KvRegs { f32x4 a[11], b[11]; };
__device__ __forceinline__ void load_kv64_paged(Frame& F, int sb, int n, int h, KvRegs& R) {
    const int pg0 = F.page_table[sb * NPAGES + 2 * n], pg1 = F.page_table[sb * NPAGES + 2 * n + 1];
    const int lt = F.tid - 128;
#pragma unroll
    for (int i = 0; i < 11; ++i) {
        const int piece = lt + 384 * i;
        if (i < 10 || piece < 4096) {
            const int idx = piece & 2047, key = idx >> 3, ch = idx & 7;
            const float* base = (piece < 2048) ? F.cache_k : F.cache_v;
            const float* src = base + ((size_t)((key < PAGE) ? pg0 : pg1) * PAGE + (key & (PAGE - 1))) * AW + h * AD + 8 * ch;
            R.a[i] = __builtin_nontemporal_load((const f32x4*)src); R.b[i] = __builtin_nontemporal_load((const f32x4*)(src + 4));
        }
    }
}
__device__ __forceinline__ void store_kv64_tiles(Frame& F, const KvRegs& R, LAS unsigned char* KR, LAS unsigned char* VT) {
    const int lt = F.tid - 128;
#pragma unroll
    for (int i = 0; i < 11; ++i) {
        const int piece = lt + 384 * i;
        if (i < 10 || piece < 4096) {
            const int idx = piece & 2047, key = idx >> 3, ch = idx & 7;
            const f32x4 x0 = R.a[i], x1 = R.b[i];
            v4u w; w.x = pk2(x0.x, x0.y); w.y = pk2(x0.z, x0.w); w.z = pk2(x1.x, x1.y); w.w = pk2(x1.z, x1.w);
            LAS unsigned char* dst = (piece < 2048) ? KR + ch * (256 * 16) + key * 16 : VT + (ch >> 2) * (256 * 64) + key * 64 + (ch & 3) * 16;
            *(LAS v4u*)dst = w;
        }
    }
}
__device__ __forceinline__ void sample_past_items(Frame& F, const LAS int* bucket) {
    LAS float* tab = (LAS float*)(F.lds + ML_TAB_OFF);
    const int lane = F.lane, tl = lane & 31, hi = lane >> 5;
    const int L = (int)__hip_atomic_load((unsigned*)(F.ctl + CW_SITEMS), __ATOMIC_RELAXED, __HIP_MEMORY_SCOPE_AGENT);
    const int* items = (const int*)(F.ws + WS_SITEMS);
    const int* sels = (const int*)(F.ws + WS_SELS);
    int idx = blockIdx.x, cur = 0;
#define ITEM_AT(k) items[idx + (k) * F.G]
#define HAS(k) (idx + (k) * F.G < L)
#define LUT_BUILD(H_, DST_) do { const int lt_ = F.tid - 128; if (lt_ < 128) (DST_)[lt_] = F.rel_bias[bucket[lt_] * AH + (H_)]; if (lt_ == 128) (DST_)[128] = F.rel_bias[31 * AH + (H_)]; } while (0)
#define LOADER_STEP(RX) do { if (HAS(1)) { const int i1_ = ITEM_AT(1); LUT_BUILD((i1_ >> 5) & 7, tab + AT_LUT + (cur ^ 1) * 132); \
            LAS unsigned char* kb_ = F.lds + RING_OFF + (cur ^ 1) * 65536; store_kv64_tiles(F, RX, kb_, kb_ + 32768); \
            if (HAS(3)) { const int i3_ = ITEM_AT(3); load_kv64_paged(F, i3_ >> 8, i3_ & 31, (i3_ >> 5) & 7, RX); } } \
        __syncthreads(); cur ^= 1; idx += F.G; } while (0)
    __syncthreads();
    if (F.wave >= 2) {
        KvRegs RA, RB;
        if (HAS(0)) {
            const int it = ITEM_AT(0);
            load_kv64_paged(F, it >> 8, it & 31, (it >> 5) & 7, RA); store_kv64_tiles(F, RA, F.lds + RING_OFF, F.lds + RING_OFF + 32768);
            LUT_BUILD((it >> 5) & 7, tab + AT_LUT);
            if (HAS(1)) { const int i1 = ITEM_AT(1); load_kv64_paged(F, i1 >> 8, i1 & 31, (i1 >> 5) & 7, RA); }
            if (HAS(2)) { const int i2 = ITEM_AT(2); load_kv64_paged(F, i2 >> 8, i2 & 31, (i2 >> 5) & 7, RB); }
        }
        __syncthreads();
        while (idx < L) { LOADER_STEP(RA); if (idx >= L) break; LOADER_STEP(RB); }
    } else {
        int pj = -1, pst = 0; bf16x8 pq[4] = {};
#define SAMPLE_ITEM_QUERY(IT, J, ST, QF) do { const int n_ = (IT) & 31, h_ = ((IT) >> 5) & 7, sb_ = (IT) >> 8; int j_ = -1; \
        if (tl < 8) { const int* sp = sels + (size_t)((sb_ * DS + tl) * AH + h_) * 3; j_ = (sp[0] == n_) ? 0 : ((sp[1] == n_) ? 1 : ((sp[2] == n_) ? 2 : -1)); } \
        const unsigned long long bal_ = __ballot(j_ >= 0); (J) = j_; (ST) = (j_ >= 0) ? tl : ((int)(__ffsll((unsigned long long)bal_) - 1) & 7); \
        const bf16* qp_ = SEG_AQ(F) + (size_t)(MP + sb_ * DS + (ST)) * AW + h_ * AD + 8 * hi; \
        _Pragma("unroll") for (int s_ = 0; s_ < 4; ++s_) (QF)[s_] = *(const bf16x8*)(qp_ + 16 * s_); } while (0)
        LAS float* hand = tab + ML_WSC;
        volatile LAS int* flag = (volatile LAS int*)(tab + ML_WSC + 1160);
        if (HAS(0)) { const int it = ITEM_AT(0); SAMPLE_ITEM_QUERY(it, pj, pst, pq); }
        if (F.tid == 0) flag[0] = 0;
        __syncthreads();
        int seq = 0;
        for (; idx < L; idx += F.G) {
            const int it = ITEM_AT(0), n = it & 31, h = (it >> 5) & 7, sb = it >> 8;
            const LAS unsigned char* KR = F.lds + RING_OFF + cur * 65536; const LAS unsigned char* VT = KR + 32768; const LAS float* lut = tab + AT_LUT + cur * 132;
            const int j = pj, st = pst; const bool valid = j >= 0;
            bf16x8 qf[4] = {pq[0], pq[1], pq[2], pq[3]};
            if (HAS(1)) { const int i1 = ITEM_AT(1); SAMPLE_ITEM_QUERY(i1, pj, pst, pq); }
            ++seq;
            AttnOut O = wave_attend<false>(KR, VT, qf, lane, 4 + 4 * F.wave, 256 + st, n == NBLK_S - 1, 4, lut, lut[128], 4 * F.wave);
            LAS float* hp = hand + (seq & 1) * 576 + ((lane >> 5) * 8 + (tl & 7)) * 36;
            if (F.wave == 1) {
                if (tl < 8) { hp[0] = O.mx; hp[1] = O.l;
#pragma unroll
                    for (int r = 0; r < 16; ++r) { hp[2 + r] = O.o0[r]; hp[18 + r] = O.o1[r]; } }
                asm volatile("s_waitcnt lgkmcnt(0)" ::: "memory");
                if (lane == 0) flag[0] = seq;
            } else {
                while (flag[0] < seq) __builtin_amdgcn_s_sleep(1);
                asm volatile("" ::: "memory");
                if (valid) {
                    const float m1 = hp[0], l1 = hp[1], mt = fmaxf(O.mx, m1), f0 = __expf(O.mx - mt), f1 = __expf(m1 - mt), lt_ = O.l * f0 + l1 * f1;
                    const size_t dst = (size_t)((sb * DS + st) * AH + h) * 3 + j;
                    if (hi == 0) { float* ps = (float*)(F.ws + WS_PARTSS) + dst * 2; ps[0] = mt; ps[1] = lt_; }
                    const float rl = 1.f / lt_, g0 = f0 * rl, g1 = f1 * rl;
                    bf16* po = (bf16*)(F.ws + WS_PARTOS) + dst * 64 + 4 * hi;
#pragma unroll
                    for (int g = 0; g < 4; ++g) {
                        float a[4], b[4];
#pragma unroll
                        for (int i = 0; i < 4; ++i) { a[i] = O.o0[4 * g + i] * g0 + hp[2 + 4 * g + i] * g1; b[i] = O.o1[4 * g + i] * g0 + hp[18 + 4 * g + i] * g1; }
                        *(unsigned long long*)(po + 8 * g) = (unsigned long long)pk2(a[0], a[1]) | ((unsigned long long)pk2(a[2], a[3]) << 32);
                        *(unsigned long long*)(po + 32 + 8 * g) = (unsigned long long)pk2(b[0], b[1]) | ((unsigned long long)pk2(b[2], b[3]) << 32);
                    }
                }
            }
            __syncthreads();
            cur ^= 1;
        }
#undef SAMPLE_ITEM_QUERY
    }
#undef LOADER_STEP
#undef LUT_BUILD
#undef ITEM_AT
#undef HAS
    __syncthreads();
}
__device__ __forceinline__ void sample_own_merge(Frame& F, const LAS int* bucket) {
    const int gw = blockIdx.x * NWAVES + F.wave, NGW = F.G * NWAVES, d = F.lane;
    for (int idx = gw; idx < MS * AH; idx += NGW) {
        const int r = idx >> 3, h = idx & 7, sb = r >> 3, st = r & 7, m = MP + r;
        const float q = bf2f(SEG_AQ(F)[(size_t)m * AW + h * AD + d]);
        float s[8], vv[8];
#pragma unroll
        for (int p = 0; p < 8; ++p) { const size_t off = ((size_t)(MP + sb * DS + p)) * AW + h * AD + d; s[p] = q * bf2f(SEG_AK(F)[off]); vv[p] = bf2f(SEG_AV(F)[off]); }
#pragma unroll
        for (int p = 0; p < 8; ++p) { s[p] = wave_sum(s[p]); s[p] = (p <= st) ? s[p] + F.rel_bias[bucket[(st - p) & 7] * AH + h] : -INFINITY; }
        float mx = s[0];
#pragma unroll
        for (int p = 1; p < 8; ++p) mx = fmaxf(mx, s[p]);
        float l = 0.f, o = 0.f;
#pragma unroll
        for (int p = 0; p < 8; ++p) { const float pw = __expf(s[p] - mx); l += pw; o += pw * vv[p]; }
        const float* ps = (const float*)(F.ws + WS_PARTSS) + (size_t)idx * 6;
        float mt = mx; float pm[3], pl[3];
#pragma unroll
        for (int j = 0; j < 3; ++j) { pm[j] = ps[2 * j]; pl[j] = ps[2 * j + 1]; mt = fmaxf(mt, pm[j]); }
        const float e_own = __expf(mx - mt); float aj[3], L = e_own * l;
#pragma unroll
        for (int j = 0; j < 3; ++j) { aj[j] = __expf(pm[j] - mt) * pl[j]; L += aj[j]; }
        const float rL = 1.f / L;
        const bf16* po = (const bf16*)(F.ws + WS_PARTOS) + (size_t)idx * 3 * 64 + d;
        F.MIX[(size_t)m * D + h * AD + d] = (bf16)f2bf(rL * (o * e_own + aj[0] * bf2f(po[0]) + aj[1] * bf2f(po[64]) + aj[2] * bf2f(po[128])));
    }
}

template <int BATCH, class Epi>
__device__ __forceinline__ void skinny_gemm(Frame& F, const bf16* A, int lda, const bf16* Wt, int ldw, int ntile, int K, const Epi& E) {
    const int lane = F.lane, r = lane & 31, hi = lane >> 5, kw = K / 8;
    LAS float* red = (LAS float*)(F.lds + RING_OFF);
    for (int u = blockIdx.x; u < 8 * ntile; u += F.G) {
        const int rg = u & 7, ct = u >> 3, k0 = F.wave * kw;
        const bf16* ap = A + (size_t)(32 * rg + r) * lda + k0 + 8 * hi;
        const bf16* bp = Wt + (size_t)(32 * ct + r) * ldw + k0 + 8 * hi;
        f32x16 acc = {};
        for (int s = 0; s < kw / 16; s += BATCH) {
            bf16x8 af[BATCH], bfr[BATCH];
#pragma unroll
            for (int i = 0; i < BATCH; ++i) { af[i] = *(const bf16x8*)(ap + 16 * (s + i)); bfr[i] = *(const bf16x8*)(bp + 16 * (s + i)); }
#pragma unroll
            for (int i = 0; i < BATCH; ++i) acc = mfma32(af[i], bfr[i], acc);
        }
        __syncthreads();
#pragma unroll
        for (int i = 0; i < 16; ++i) red[(F.wave * 16 + i) * 64 + lane] = acc[i];
        __syncthreads();
#pragma unroll
        for (int q = 0; q < 2; ++q) {
            const int e = F.tid + 512 * q; float s = 0.f;
#pragma unroll
            for (int w = 0; w < 8; ++w) s += red[w * 1024 + e];
            const int reg = e >> 6, ln = e & 63;
            E(s, 32 * rg + crow(reg, ln >> 5), 32 * ct + (ln & 31));
        }
    }
    __syncthreads();
}
struct SkResid { const float* xs; float* x1; __device__ __forceinline__ void operator()(float s, int row, int col) const { x1[(size_t)(MP + row) * D + col] = xs[(size_t)row * D + col] + s; } };
struct SkAccum { float* x1; __device__ __forceinline__ void operator()(float s, int row, int col) const { float* p = x1 + (size_t)(MP + row) * D + col; *p = *p + s; } };
struct SkRelu2U { bf16* U; __device__ __forceinline__ void operator()(float s, int row, int col) const { const float a = fmaxf(s, 0.f); U[(size_t)(MP + row) * FF + col] = (bf16)f2bf(a * a); } };

__device__ __forceinline__ void skinny_up4(Frame& F) {
    const int lane = F.lane, r = lane & 31, hi = lane >> 5, kw = D / 8;
    LAS float* red = (LAS float*)(F.lds + RING_OFF);
    const bf16* A = F.XN + (size_t)MP * D;
    for (int u = blockIdx.x; u < 8 * (FF / 128); u += F.G) {
        const int rg = u & 7, c4 = u >> 3, k0 = F.wave * kw;
        const bf16* ap = A + (size_t)(32 * rg + r) * D + k0 + 8 * hi;
        bf16x8 af[8];
#pragma unroll
        for (int i = 0; i < 8; ++i) af[i] = *(const bf16x8*)(ap + 16 * i);
        f32x16 acc[4];
#pragma unroll
        for (int t = 0; t < 4; ++t) {
            const bf16* bp = F.Wup_t + (size_t)(32 * (4 * c4 + t) + r) * D + k0 + 8 * hi;
            bf16x8 bfr[8];
#pragma unroll
            for (int i = 0; i < 8; ++i) bfr[i] = *(const bf16x8*)(bp + 16 * i);
            acc[t] = (f32x16){};
#pragma unroll
            for (int i = 0; i < 8; ++i) acc[t] = mfma32(af[i], bfr[i], acc[t]);
        }
        __syncthreads();
#pragma unroll
        for (int t = 0; t < 4; ++t)
#pragma unroll
            for (int i = 0; i < 16; ++i) red[((t * 8 + F.wave) * 16 + i) * 64 + lane] = acc[t][i];
        __syncthreads();
#pragma unroll
        for (int q = 0; q < 8; ++q) {
            const int e4 = F.tid + 512 * q, t = e4 >> 10, e = e4 & 1023; float s = 0.f;
#pragma unroll
            for (int w = 0; w < 8; ++w) s += red[(t * 8 + w) * 1024 + e];
            const int reg = e >> 6, ln = e & 63; const float a = fmaxf(s, 0.f);
            F.U[(size_t)(MP + 32 * rg + crow(reg, ln >> 5)) * FF + 32 * (4 * c4 + t) + (ln & 31)] = (bf16)f2bf(a * a);
        }
    }
    __syncthreads();
}

__device__ __forceinline__ void sample_ffn_norm(Frame& F) {
    for (int u = blockIdx.x; u < 8 * (FF / 128); u += F.G) {
        const int rg = u & 7;
#pragma unroll
        for (int i = 0; i < 4; ++i) {
            const int r = 32 * rg + 4 * F.wave + i;
            f32x4 v[4]; load_row(F.X1 + (size_t)(MP + r) * D, F.lane, v);
            rms_row_to_bf16<false>(F, v, F.norm_ffn, F.XN + (size_t)(MP + r) * D, MP + r);
        }
    }
    asm volatile("s_waitcnt vmcnt(0)" ::: "memory");
    __syncthreads();
}

#ifndef MK_ONE_LAUNCH
#define MK_ONE_LAUNCH 1
#endif
constexpr int N_PHASES = 11;
struct Args { const void* in[19]; float* out; unsigned char* ws; int ph_lo, ph_hi; };
static_assert(sizeof(Args) == 19 * 8 + 8 + 8 + 8, "Args has no padding bytes");
__global__ void __launch_bounds__(NWAVES * 64, 2) hymba_fwd(Args args) {
    extern __shared__ __attribute__((aligned(16))) unsigned char lds[];
    Frame F;
    F.lds = (LAS unsigned char*)lds;
    F.MISC = (volatile LAS unsigned*)(F.lds + MISC_OFF);
    F.tid = threadIdx.x; F.lane = F.tid & 63; F.wave = __builtin_amdgcn_readfirstlane(F.tid >> 6);
    F.G = gridDim.x; { const int bx = blockIdx.x; F.vcu = (F.G % 8 == 0) ? (bx % 8) * (F.G / 8) + bx / 8 : bx; }
    unsigned char* ws = args.ws; F.ws = ws;
    F.ctl = (gu32*)(ws + WS_CTL);
    F.xp = (const float*)args.in[0]; F.xs = (const float*)args.in[1]; F.cache_k = (const float*)args.in[2]; F.cache_v = (const float*)args.in[3];
    F.state_C = (const float*)args.in[4]; F.state_n = (const float*)args.in[5]; F.state_m = (const float*)args.in[6]; F.page_table = (const int*)args.in[7];
    F.rel_bias = (const float*)args.in[8]; F.norm_mix = (const float*)args.in[9]; F.w_in = (const float*)args.in[10]; F.b_ig = (const float*)args.in[11];
    F.b_fg = (const float*)args.in[12]; F.ml_norm = (const float*)args.in[13]; F.w_out = (const float*)args.in[14]; F.norm_ffn = (const float*)args.in[15];
    F.w_up = (const float*)args.in[16]; F.w_down = (const float*)args.in[17]; F.norm_final = (const float*)args.in[18];
    F.out = args.out;
    F.Win_t = (bf16*)(ws + WS_WIN); F.Wout_t = (bf16*)(ws + WS_WOUT); F.Wup_t = (bf16*)(ws + WS_WUP); F.Wdn_t = (bf16*)(ws + WS_WDN);
    F.XN = (bf16*)(ws + WS_XN); F.SEG = (bf16*)(ws + WS_SEG); F.MIX = (bf16*)(ws + WS_MIX); F.U = (bf16*)(ws + WS_U);
    F.KSUM = (float*)(ws + WS_KSUM); F.KSUMS = (float*)(ws + WS_KSUMP); F.IG = (float*)(ws + WS_GATE); F.LF = (float*)(ws + WS_GATE + 512 * 1024);
    F.H = (float*)(ws + WS_H); F.X1 = (float*)(ws + WS_X1);
    for (int u = F.tid; u < (LDS_BYTES - LDSCTL_OFF) / 4; u += NWAVES * 64) ((LAS unsigned*)(F.lds + LDSCTL_OFF))[u] = 0u;
    __syncthreads();
    LAS int* bucket = (LAS int*)(F.lds + LDSCTL_OFF + 1024);
    if (F.tid < 128) bucket[F.tid] = t5_bucket_small(F.tid);
    __syncthreads();
    const int lo = args.ph_lo, hi = args.ph_hi;
    XcdBarrier bar; bar.bar = (unsigned*)(F.ctl + CW_BAR); bar.x = 0; bar.st = nullptr;
    if (hi - lo > 1) bar = xcd_barrier_post((unsigned*)(F.ctl + CW_BAR), F.MISC + 8);
#define IN(k) (lo <= (k) && (k) < hi)
#define SEAM(k) do { if (IN(k) && IN((k) + 1)) xcd_barrier(bar); } while (0)

    if (IN(0)) { p0_prologue(F); } SEAM(0);
    if (IN(1)) {
        const int gwg = (F.G > P1_GEMM_WGS) ? P1_GEMM_WGS : F.G;
        if ((int)blockIdx.x < gwg) {
            pg8::Gemm g{F.XN, F.Win_t, M, NPG, D}; pg8::StaticOrder S; S.init(M, NPG, gwg, (int)blockIdx.x); pg8::EpiInProj E{F.SEG, SEG_ELEMS, F.out, F.KSUM};
            pg8::gemm_phase<pg8::EpiInProj, pg8::StaticOrder, true, true>(F.lds + RING_OFF, g, S, E);
        }
        if (F.G > gwg) { if ((int)blockIdx.x >= gwg) { page_sums(F, PS_SPLIT, DB * NPAGES, ((int)blockIdx.x - gwg) * NWAVES + F.wave, (F.G - gwg) * NWAVES); late_transposes(F, ((int)blockIdx.x - gwg) * NWAVES + F.wave, (F.G - gwg) * NWAVES); } }
        else { page_sums(F, PS_SPLIT, DB * NPAGES, F.vcu * NWAVES + F.wave, F.G * NWAVES); late_transposes(F, F.vcu * NWAVES + F.wave, F.G * NWAVES); }
    } SEAM(1);
    if (IN(2)) {
        for (int u = blockIdx.x; u < NSEQ * NCH; u += F.G) mlstm_stepA(F, u);
        for (int u = blockIdx.x; u < 32 * 15; u += 2 * F.G) attn_select2(F, u, (u + F.G < 32 * 15) ? u + F.G : -1);
        sample_select(F);
    } SEAM(2);
    if (IN(3)) {
        for (int u = blockIdx.x; u < NSEQ * 16; u += F.G) mlstm_stepB(F, u);
        attn_past_items(F, bucket);
        sample_past_items(F, bucket);
    } SEAM(3);
    if (IN(4)) {
        for (int u = blockIdx.x; u < NSEQ * NCH; u += F.G) mlstm_stepC(F, u);
        for (int u = blockIdx.x; u < 16 * 16; u += F.G) attn_own_pair(F, bucket, u, u + 256);
        for (int u = blockIdx.x; u < DB * MH; u += F.G) mlstm_sample_full(F, u);
        __syncthreads();
        sample_own_merge(F, bucket);
    }
    if (IN(4) && IN(6)) xcd_barrier(bar);
    if (IN(6)) {
        pg8::Gemm g{F.MIX, F.Wout_t, MP, D, D}; pg8::StaticOrder S; S.init(MP, D, F.G, (int)blockIdx.x); pg8::EpiResid E{F.xp, F.xs, F.X1, F.norm_ffn, F.XN, (float*)(F.ws + WS_SSQ)};
        pg8::gemm_phase<pg8::EpiResid, pg8::StaticOrder, true, true>(F.lds + RING_OFF, g, S, E);
        skinny_gemm<8>(F, F.MIX + (size_t)MP * D, D, F.Wout_t, D, D / 32, D, SkResid{F.xs, F.X1});
    }
    if (IN(6) && IN(8)) xcd_barrier(bar);
    if (IN(8)) {
        pg8::Gemm g{F.XN, F.Wup_t, MP, FF, D}; pg8::StaticOrder S; S.init(MP, FF, F.G, (int)blockIdx.x); pg8::EpiRelu2 E{F.U, (const float*)(F.ws + WS_SSQ)};
        pg8::gemm_phase<pg8::EpiRelu2, pg8::StaticOrder, true, true>(F.lds + RING_OFF, g, S, E);
        sample_ffn_norm(F); skinny_up4(F);
    } SEAM(8);
    if (IN(9)) {
        pg8::Gemm g{F.U, F.Wdn_t, MP, D, FF}; pg8::StaticOrder S; S.init(MP, D, F.G, (int)blockIdx.x);
        pg8::EpiAccum E{F.X1};
        pg8::gemm_phase<pg8::EpiAccum, pg8::StaticOrder, true, true>(F.lds + RING_OFF, g, S, E);
        skinny_gemm<16>(F, F.U + (size_t)MP * FF, FF, F.Wdn_t, FF, D / 32, FF, SkAccum{F.X1});
    } SEAM(9);
    if (IN(10)) { final_norm_rows(F); }
#undef IN
#undef SEAM
}

extern "C" void kernel_launch(void* const* d_in, const int* in_sizes, int n_in, void* d_out, int out_size, void* d_ws, size_t ws_size, hipStream_t stream) {
    static int grid = 0;
    if (grid == 0) {
        if (n_in != 19 || (size_t)out_size != O_END || ws_size < WS_END_SSQ) { fprintf(stderr, "kernel_launch: unexpected shapes (n_in %d out %d ws %zu)\n", n_in, out_size, ws_size); grid = -1; return; }
        int dev = 0, cus = 0, per_cu = 0;
        if (hipGetDevice(&dev) != hipSuccess || hipDeviceGetAttribute(&cus, hipDeviceAttributeMultiprocessorCount, dev) != hipSuccess) { grid = -1; return; }
        if (hipFuncSetAttribute((const void*)hymba_fwd, hipFuncAttributeMaxDynamicSharedMemorySize, LDS_BYTES) != hipSuccess) { fprintf(stderr, "kernel_launch: hipFuncSetAttribute failed\n"); grid = -1; return; }
        if (hipOccupancyMaxActiveBlocksPerMultiprocessor(&per_cu, (const void*)hymba_fwd, NWAVES * 64, LDS_BYTES) != hipSuccess || per_cu < 1)
            fprintf(stderr, "kernel_launch: note: occupancy query reports %d workgroups per CU\n", per_cu);
        (void)hipGetLastError();
        grid = cus;
    }
    if (grid < 0) return;
    if (hipMemsetAsync((char*)d_ws + WS_CTL, 0, CTL_ZERO_BYTES, stream) != hipSuccess) { fprintf(stderr, "kernel_launch: memset failed\n"); return; }
    Args a{};
    for (int i = 0; i < 19; ++i) a.in[i] = d_in[i];
    a.out = (float*)d_out; a.ws = (unsigned char*)d_ws;
#if MK_ONE_LAUNCH
    a.ph_lo = 0; a.ph_hi = N_PHASES;
    hipLaunchKernelGGL(hymba_fwd, dim3(grid), dim3(NWAVES * 64), LDS_BYTES, stream, a);
#else
    for (int p = 0; p < N_PHASES; ++p) {
        a.ph_lo = p; a.ph_hi = p + 1;
        hipLaunchKernelGGL(hymba_fwd, dim3(grid), dim3(NWAVES * 64), LDS_BYTES, stream, a);
    }
#endif
    const hipError_t le = hipPeekAtLastError();
    if (le != hipSuccess) fprintf(stderr, "kernel_launch: launch failed: %s\n", hipGetErrorName(le));
}
```

```cpp
#include <hip/hip_runtime.h>
#include <cstdio>
#include <cstdint>
#include <cmath>
#ifndef PROBE_MASK
#define PROBE_MASK 0
#endif
#ifndef PROBE_T
#define PROBE_T 0
#endif
constexpr int D = 1024, SEQ = 4096, NBATCH = 4, MP = NBATCH * SEQ  , DB = 32, DS = 8, MS = DB * DS  , M = MP + MS  ;
constexpr int FF = 4096, NPROJ = 3592, NPG = 3584  ;
constexpr int AH = 8, AD = 64, AW = 512, MH = 4, MD = 128, MW = 512;
constexpr int PAST = 8192, PAGE = 128, NPAGES = PAST / PAGE  , MBLK = 256, NBLK_P = SEQ / MBLK  , NBLK_S = PAST / MBLK  ;
constexpr float RMS_EPS = 1e-6f;
constexpr size_t O_YP = 0, O_YS = 16777216, O_KP = 17039360, O_VP = 25427968, O_CP = 33816576, O_NP = 34078720, O_MP = 34080768,
                 O_KS = 34080784, O_VS = 34211856, O_CS = 34342928, O_NS = 36440080, O_MS = 36456464, O_END = 36456592;
namespace pg8 {
#define PG8_LAS __attribute__((address_space(3)))
typedef unsigned short bf16_t;
typedef short bf16x8 __attribute__((ext_vector_type(8)));
typedef float f32x4 __attribute__((ext_vector_type(4)));
typedef unsigned u32x4 __attribute__((ext_vector_type(4)));
constexpr int BM = 256, BK = 64, HALF = 128, HTB = HALF * BK * 2  , STAGE_BYTES = 8 * HTB, NXCD = 8, WGM = 8;

__host__ __device__ __forceinline__ int lds_byte(int r, int c) { const int st = (r >> 4) * 2 + (c >> 5), rr = r & 15, cc = c & 31, ob = rr * 64 + cc * 2; return st * 1024 + (ob ^ (((ob >> 9) & 1) << 5)); }
__host__ __device__ __forceinline__ void stage_rc(int b, int& R, int& C) { const int st = b / 1024, sb = b % 1024, swz = sb ^ (((sb >> 9) & 1) << 5); R = (st >> 1) * 16 + swz / 64; C = (st & 1) * 32 + (swz % 64) / 2; }
__host__ __device__ __forceinline__ int perm32(int rho) { const int n = rho >> 4, i = rho & 15; return 8 * (i >> 2) + 4 * n + (i & 3); }

struct Unit { int pm, pn; };
struct Gemm { const bf16_t* A; const bf16_t* Bt; int M, N, K; };

struct StaticOrder {
    int nM, nN, nwg, G, c;
    __host__ __device__ void init(int M, int N, int G_, int c_) { nM = M / BM; nN = N / BM; nwg = nM * nN; G = G_; c = c_; }
    __host__ __device__ bool next(int i, Unit& u) const {
        const long L = (long)i * G + c; if (L >= nwg) return false;
        int wgid = (int)L; { const int q = nwg / NXCD, r = nwg % NXCD, xcd = wgid % NXCD, off = wgid / NXCD; wgid = (xcd < r ? xcd * (q + 1) : r * (q + 1) + (xcd - r) * q) + off; }
        const int nig = WGM * nN, gid = wgid / nig, fm = gid * WGM, gsz = (nM - fm) < WGM ? (nM - fm) : WGM;
        u.pm = fm + ((wgid % nig) % gsz); u.pn = (wgid % nig) / gsz; return true;
    }
    __device__ __forceinline__ void a_ready(const Unit&) const {}
    __device__ __forceinline__ void done(const Unit&) const {}
};

__device__ __forceinline__ unsigned cvt_pk_bf16(float lo, float hi) { unsigned r; asm volatile("v_cvt_pk_bf16_f32 %0, %1, %2" : "=v"(r) : "v"(lo), "v"(hi)); return r; }
typedef float f32x2 __attribute__((ext_vector_type(2)));
typedef unsigned u32x4_t __attribute__((ext_vector_type(4)));
__device__ __forceinline__ u32x4_t pack8(f32x4 v0, f32x4 v1) { u32x4_t w; w.x = cvt_pk_bf16(v0[0], v0[1]); w.y = cvt_pk_bf16(v0[2], v0[3]); w.z = cvt_pk_bf16(v1[0], v1[1]); w.w = cvt_pk_bf16(v1[2], v1[3]); return w; }
struct EpiInProj {
    static constexpr bool PERM = true, AFTER_DRAIN = false;
    bf16_t* seg0; size_t seg_stride; float* out; float* ksum;
    __device__ __forceinline__ void operator()(const f32x4 (&acc)[2][2][4][2], const Unit& u, int wr, int wc, int fr, int fq) const {
        const int seg = u.pn >> 1;
        const float sc = (seg == 0) ? 0.125f : ((seg == 4) ? 0.08838834764831845f : 1.0f);
        bf16_t* base = seg0 + (size_t)seg * seg_stride;
        const int cs0 = (u.pn & 1) * 256 + wc * 32 + 8 * fq;
        const int row0 = u.pm * BM + wr * 64 + fr;
        const bool kv = (seg == 1) || (seg == 2);
        const bool prompt = u.pm < (MP / BM);
        float* fo = out + (prompt ? (seg == 1 ? O_KP : O_VP) : (seg == 1 ? O_KS : O_VS));
        const int frow0 = prompt ? row0 : row0 - MP;
        f32x4 cs[2][2];
#pragma unroll
        for (int bj = 0; bj < 2; ++bj)
#pragma unroll
            for (int n = 0; n < 2; ++n) cs[bj][n] = (f32x4){0.f, 0.f, 0.f, 0.f};
#pragma unroll
        for (int ai = 0; ai < 2; ++ai)
#pragma unroll
            for (int m = 0; m < 4; ++m) {
                bf16_t* rowp = base + (size_t)(row0 + ai * HALF + m * 16) * 512 + cs0;
#pragma unroll
                for (int bj = 0; bj < 2; ++bj) {
                    f32x4 v0 = acc[ai][bj][m][0], v1 = acc[ai][bj][m][1];
                    if (kv) { float* fp = fo + (size_t)(frow0 + ai * HALF + m * 16) * 512 + cs0 + bj * HALF; __builtin_nontemporal_store(v0, (f32x4*)fp); __builtin_nontemporal_store(v1, (f32x4*)(fp + 4)); }
                    if (seg == 1) { cs[bj][0] += v0; cs[bj][1] += v1; }
                    v0 = v0 * sc; v1 = v1 * sc;
                    *(u32x4_t*)(rowp + bj * HALF) = pack8(v0, v1);
                }
            }
        if (seg == 1 && prompt) {
#pragma unroll
            for (int bj = 0; bj < 2; ++bj)
#pragma unroll
                for (int n = 0; n < 2; ++n)
#pragma unroll
                    for (int j = 0; j < 4; ++j) {
                        float v = cs[bj][n][j];
                        v += __shfl_xor(v, 1); v += __shfl_xor(v, 2); v += __shfl_xor(v, 4); v += __shfl_xor(v, 8);
                        if (fr == 0) __hip_atomic_fetch_add(ksum + (size_t)u.pm * 512 + cs0 + bj * HALF + n * 4 + j, v, __ATOMIC_RELAXED, __HIP_MEMORY_SCOPE_AGENT);
                    }
        }
    }
};
struct EpiResid {
    static constexpr bool PERM = false, AFTER_DRAIN = false;
    const float* xp; const float* xs; float* x1; const float* gain; bf16_t* xn; float* ssq;
    __device__ __forceinline__ void operator()(const f32x4 (&acc)[2][2][4][2], const Unit& u, int wr, int wc, int fr, int fq) const {
        const int row0 = u.pm * BM + wr * 64 + fr, col0 = u.pn * BM + wc * 32 + 4 * fq;
        const float* src = (u.pm < (MP / BM)) ? xp + (size_t)row0 * D : xs + (size_t)(row0 - MP) * D;
        float* dst = x1 + (size_t)row0 * D; bf16_t* dxn = xn + (size_t)row0 * D;
        f32x4 gv[2][2];
#pragma unroll
        for (int bj = 0; bj < 2; ++bj)
#pragma unroll
            for (int n = 0; n < 2; ++n) gv[bj][n] = *(const f32x4*)(gain + col0 + bj * HALF + n * 16);
#pragma unroll
        for (int ai = 0; ai < 2; ++ai)
#pragma unroll
            for (int m = 0; m < 4; ++m) {
                const size_t off = (size_t)(ai * HALF + m * 16) * D + col0; float sq = 0.f;
#pragma unroll
                for (int bj = 0; bj < 2; ++bj)
#pragma unroll
                    for (int n = 0; n < 2; ++n) { const f32x4 xv = *(const f32x4*)(src + off + bj * HALF + n * 16) + acc[ai][bj][m][n]; *(f32x4*)(dst + off + bj * HALF + n * 16) = xv;
                        sq += (xv[0] * xv[0] + xv[1] * xv[1]) + (xv[2] * xv[2] + xv[3] * xv[3]);
                        const f32x4 y = xv * gv[bj][n]; unsigned long long w = (unsigned long long)cvt_pk_bf16(y[0], y[1]) | ((unsigned long long)cvt_pk_bf16(y[2], y[3]) << 32);
                        *(unsigned long long*)(dxn + off + bj * HALF + n * 16) = w; }
                sq += __shfl_xor(sq, 16); sq += __shfl_xor(sq, 32);
                if (fq == 0) ssq[(size_t)(row0 + ai * HALF + m * 16) * 16 + u.pn * 4 + wc] = sq;
            }
    }
};
struct EpiAccum {
    static constexpr bool PERM = false, AFTER_DRAIN = false;
    float* x1;
    __device__ __forceinline__ void operator()(const f32x4 (&acc)[2][2][4][2], const Unit& u, int wr, int wc, int fr, int fq) const {
        const int row0 = u.pm * BM + wr * 64 + fr, col0 = u.pn * BM + wc * 32 + 4 * fq;
        float* dst = x1 + (size_t)row0 * D;
#pragma unroll
        for (int ai = 0; ai < 2; ++ai)
#pragma unroll
            for (int m = 0; m < 4; ++m) {
                const size_t off = (size_t)(ai * HALF + m * 16) * D + col0;
#pragma unroll
                for (int bj = 0; bj < 2; ++bj)
#pragma unroll
                    for (int n = 0; n < 2; ++n) { float* p = dst + off + bj * HALF + n * 16; const f32x4 xv = *(const f32x4*)p; *(f32x4*)p = xv + acc[ai][bj][m][n]; }
            }
    }
};
struct EpiRelu2 {
    static constexpr bool PERM = true, AFTER_DRAIN = false;
    bf16_t* U; const float* ssq;
    __device__ __forceinline__ void operator()(const f32x4 (&acc)[2][2][4][2], const Unit& u, int wr, int wc, int fr, int fq) const {
        const int row0 = u.pm * BM + wr * 64 + fr, col0 = u.pn * BM + wc * 32 + 8 * fq;
#pragma unroll
        for (int ai = 0; ai < 2; ++ai)
#pragma unroll
            for (int m = 0; m < 4; ++m) {
                const int row = row0 + ai * HALF + m * 16;
                const f32x4* sp = (const f32x4*)(ssq + (size_t)row * 16); const f32x4 s0 = sp[0], s1 = sp[1], s2 = sp[2], s3 = sp[3];
                const float tot = ((s0[0] + s0[1]) + (s0[2] + s0[3])) + ((s1[0] + s1[1]) + (s1[2] + s1[3])) + ((s2[0] + s2[1]) + (s2[2] + s2[3])) + ((s3[0] + s3[1]) + (s3[2] + s3[3]));
                const float r2 = 1.f / (tot * (1.f / D) + RMS_EPS);
                bf16_t* rowp = U + (size_t)row * FF + col0;
#pragma unroll
                for (int bj = 0; bj < 2; ++bj) {
                    f32x4 v0 = acc[ai][bj][m][0], v1 = acc[ai][bj][m][1];
#pragma unroll
                    for (int j = 0; j < 4; ++j) { const float a = fmaxf(v0[j], 0.f), b = fmaxf(v1[j], 0.f); v0[j] = a * a * r2; v1[j] = b * b * r2; }
                    *(u32x4_t*)(rowp + bj * HALF) = pack8(v0, v1);
                }
            }
    }
};

template <class Epi, class Sched, bool ALIGN_EPI = false, bool SP2 = false>
__device__ __forceinline__ void gemm_phase(PG8_LAS unsigned char* lds, const Gemm g, const Sched& S, const Epi& E) {
    const int tid = threadIdx.x, wid = __builtin_amdgcn_readfirstlane(tid >> 6), lane = tid & 63, wr = wid >> 2, wc = wid & 3, fr = lane & 15, fq = lane >> 4;
    const int K = g.K, nt = K / BK;
    unsigned voffA[2], voffB[2];
#pragma unroll
    for (int i = 0; i < 2; ++i) { int R, C; stage_rc(tid * 16 + i * 8192, R, C); const int Rb = Epi::PERM ? ((R & ~31) + perm32(R & 31)) : R;
        voffA[i] = (unsigned)(R * K + C) * 2u; voffB[i] = (unsigned)(Rb * K + C) * 2u; }
    const size_t kstep = (size_t)(BK * 2);
    const size_t hstep = (size_t)HALF * K * 2;
    const size_t tstep = 2 * hstep;
    const unsigned ldsw = (unsigned)wid * 1024u;
    const int aoff = lds_byte(wr * 64 + fr, fq * 8), boff = lds_byte(wc * 32 + fr, fq * 8);
#define PG8_SA(b, h) (((b) * 2 + (h)) * HTB)
#define PG8_SB(b, h) ((4 + (b) * 2 + (h)) * HTB)
#define PG8_STAGE(bufoff, gbase, voff) do { _Pragma("unroll") for (int _i = 0; _i < 2; ++_i) \
        __builtin_amdgcn_global_load_lds((const unsigned*)((const char*)(gbase) + (voff)[_i]), (PG8_LAS unsigned*)(lds + (bufoff) + ldsw + _i * 8192), 16, 0, 0); } while (0)
#define PG8_LDA(dst, b, h) do { _Pragma("unroll") for (int m = 0; m < 4; ++m) _Pragma("unroll") for (int k = 0; k < 2; ++k) dst[m][k] = *(const PG8_LAS bf16x8*)(lds + PG8_SA(b, h) + aoff + m * 2048 + k * 1024); } while (0)
#define PG8_LDB(dst, b, h) do { _Pragma("unroll") for (int n = 0; n < 2; ++n) _Pragma("unroll") for (int k = 0; k < 2; ++k) dst[n][k] = *(const PG8_LAS bf16x8*)(lds + PG8_SB(b, h) + boff + n * 2048 + k * 1024); } while (0)
#define PG8_MMA(ai, bj, At, Bt) do { __builtin_amdgcn_s_setprio(1); _Pragma("unroll") for (int m = 0; m < 4; ++m) _Pragma("unroll") for (int n = 0; n < 2; ++n) _Pragma("unroll") for (int k = 0; k < 2; ++k) \
        acc[ai][bj][m][n] = __builtin_amdgcn_mfma_f32_16x16x32_bf16(Bt[n][k], At[m][k], acc[ai][bj][m][n], 0, 0, 0); __builtin_amdgcn_s_setprio(0); } while (0)
#define PG8_WAIT_V(n) asm volatile("s_waitcnt vmcnt(" #n ")" ::: "memory")
#define PG8_WAIT_L(n) asm volatile("s_waitcnt lgkmcnt(" #n ")" ::: "memory")
#define PG8_BAR __builtin_amdgcn_s_barrier()
#define PG8_SCHED __builtin_amdgcn_sched_barrier(0)
    Unit cur, nxt; int ui = 0;
    if (!S.next(0, cur)) return;
    f32x4 acc[2][2][4][2];
#pragma unroll
    for (int a = 0; a < 2; ++a)
#pragma unroll
        for (int b = 0; b < 2; ++b)
#pragma unroll
            for (int m = 0; m < 4; ++m)
#pragma unroll
                for (int n = 0; n < 2; ++n) acc[a][b][m][n] = (f32x4){0.f, 0.f, 0.f, 0.f};
    bf16x8 At[4][2], B0[2][2], B1[2][2];
    const char* cA = (const char*)g.A + (size_t)cur.pm * tstep; const char* cB = (const char*)g.Bt + (size_t)cur.pn * tstep;
    S.a_ready(cur);
    if constexpr (SP2) {
        PG8_STAGE(PG8_SB(0, 0), cB, voffB); PG8_STAGE(PG8_SB(0, 1), cB + hstep, voffB); PG8_STAGE(PG8_SA(0, 0), cA, voffA); PG8_STAGE(PG8_SA(0, 1), cA + hstep, voffA);
        if (wr == 1) PG8_BAR;
        PG8_WAIT_V(2); PG8_BAR;
        PG8_STAGE(PG8_SB(1, 0), cB + kstep, voffB); PG8_STAGE(PG8_SA(1, 0), cA + kstep, voffA); PG8_STAGE(PG8_SB(1, 1), cB + hstep + kstep, voffB);
        PG8_WAIT_V(6); PG8_BAR;
    } else {
        PG8_STAGE(PG8_SB(0, 0), cB, voffB); PG8_STAGE(PG8_SA(0, 0), cA, voffA); PG8_STAGE(PG8_SB(0, 1), cB + hstep, voffB); PG8_STAGE(PG8_SA(0, 1), cA + hstep, voffA);
        if (wr == 1) PG8_BAR;
        PG8_WAIT_V(4); PG8_BAR;
        PG8_STAGE(PG8_SB(1, 0), cB + kstep, voffB); PG8_STAGE(PG8_SA(1, 0), cA + kstep, voffA); PG8_STAGE(PG8_SB(1, 1), cB + hstep + kstep, voffB);
        PG8_WAIT_V(6); PG8_BAR;
    }
    for (;;) {
        const bool has_next = S.next(ui + 1, nxt);
        const char* nA = has_next ? (const char*)g.A + (size_t)nxt.pm * tstep : cA; const char* nB = has_next ? (const char*)g.Bt + (size_t)nxt.pn * tstep : cB;
        for (int t = 0; t < nt; t += 2) {
            const bool last = (t == nt - 2);
            const char* a1 = cA + (size_t)(t + 1) * kstep;
            const char* a2 = last ? nA : cA + (size_t)(t + 2) * kstep; const char* b2 = last ? nB : cB + (size_t)(t + 2) * kstep;
            const char* a3 = a2 + kstep; const char* b3 = b2 + kstep;
            if (last && has_next) S.a_ready(nxt);
            if constexpr (SP2) {
            PG8_LDB(B0, 0, 0); PG8_LDB(B1, 0, 1); PG8_SCHED; PG8_LDA(At, 0, 0); PG8_STAGE(PG8_SA(1, 1), a1 + hstep, voffA);
            PG8_WAIT_V(8); PG8_WAIT_L(0); PG8_BAR; PG8_MMA(0, 0, At, B0); PG8_MMA(0, 1, At, B1); PG8_BAR; PG8_SCHED;
            PG8_LDA(At, 0, 1); PG8_STAGE(PG8_SB(0, 0), b2, voffB); PG8_STAGE(PG8_SB(0, 1), b2 + hstep, voffB); PG8_STAGE(PG8_SA(0, 0), a2, voffA);
            PG8_WAIT_V(8); PG8_WAIT_L(0); PG8_BAR; PG8_MMA(1, 0, At, B0); PG8_MMA(1, 1, At, B1); PG8_BAR; PG8_SCHED;
            PG8_LDB(B0, 1, 0); PG8_LDB(B1, 1, 1); PG8_SCHED; PG8_LDA(At, 1, 0); PG8_STAGE(PG8_SA(0, 1), a2 + hstep, voffA);
            PG8_WAIT_V(8); PG8_WAIT_L(0); PG8_BAR; PG8_MMA(0, 0, At, B0); PG8_MMA(0, 1, At, B1); PG8_BAR; PG8_SCHED;
            PG8_LDA(At, 1, 1); PG8_STAGE(PG8_SB(1, 0), b3, voffB); PG8_STAGE(PG8_SB(1, 1), b3 + hstep, voffB); PG8_STAGE(PG8_SA(1, 0), a3, voffA);
            PG8_WAIT_V(8); PG8_WAIT_L(0); PG8_BAR; PG8_MMA(1, 0, At, B0); PG8_MMA(1, 1, At, B1); PG8_BAR; PG8_SCHED;
            } else {
            PG8_LDB(B0, 0, 0); PG8_SCHED; PG8_LDA(At, 0, 0); PG8_STAGE(PG8_SA(1, 1), a1 + hstep, voffA);
            PG8_WAIT_L(8); PG8_BAR; PG8_WAIT_L(0); PG8_MMA(0, 0, At, B0); PG8_BAR; PG8_SCHED;
            PG8_LDB(B1, 0, 1); PG8_STAGE(PG8_SB(0, 0), b2, voffB);
            PG8_BAR; PG8_WAIT_L(0); PG8_MMA(0, 1, At, B1); PG8_BAR;
            PG8_LDA(At, 0, 1); PG8_STAGE(PG8_SA(0, 0), a2, voffA);
            PG8_BAR; PG8_WAIT_L(0); PG8_MMA(1, 0, At, B0); PG8_BAR; PG8_SCHED;
            PG8_STAGE(PG8_SB(0, 1), b2 + hstep, voffB);
            PG8_WAIT_V(6); PG8_BAR; PG8_MMA(1, 1, At, B1); PG8_BAR;
            PG8_LDB(B0, 1, 0); PG8_SCHED; PG8_LDA(At, 1, 0); PG8_STAGE(PG8_SA(0, 1), a2 + hstep, voffA);
            PG8_WAIT_L(8); PG8_BAR; PG8_WAIT_L(0); PG8_MMA(0, 0, At, B0); PG8_BAR; PG8_SCHED;
            PG8_LDB(B1, 1, 1); PG8_STAGE(PG8_SB(1, 0), b3, voffB);
            PG8_BAR; PG8_WAIT_L(0); PG8_MMA(0, 1, At, B1); PG8_BAR;
            PG8_LDA(At, 1, 1); PG8_STAGE(PG8_SA(1, 0), a3, voffA);
            PG8_BAR; PG8_WAIT_L(0); PG8_MMA(1, 0, At, B0); PG8_BAR; PG8_SCHED;
            PG8_STAGE(PG8_SB(1, 1), b3 + hstep, voffB);
            PG8_WAIT_V(6); PG8_BAR; PG8_MMA(1, 1, At, B1); PG8_BAR;
            }
        }
        if constexpr (ALIGN_EPI) { if (wr == 0) PG8_BAR; }
        if constexpr (!Epi::AFTER_DRAIN) { E(acc, cur, wr, wc, fr, fq); S.done(cur); }
        if (!has_next) break;
#pragma unroll
        for (int a = 0; a < 2; ++a)
#pragma unroll
            for (int b = 0; b < 2; ++b)
#pragma unroll
                for (int m = 0; m < 4; ++m)
#pragma unroll
                    for (int n = 0; n < 2; ++n) acc[a][b][m][n] = (f32x4){0.f, 0.f, 0.f, 0.f};
        cur = nxt; cA = nA; cB = nB; ++ui;
        if constexpr (ALIGN_EPI) { if (wr == 1) PG8_BAR; }
    }
    PG8_WAIT_V(0);
    if constexpr (!ALIGN_EPI) { if (wr == 0) PG8_BAR; }
    PG8_BAR;
    if constexpr (Epi::AFTER_DRAIN) { E.fused(acc, cur, wr, wc, fr, fq, lds, wid, lane); S.done(cur); }
#undef PG8_SA
#undef PG8_SB
#undef PG8_STAGE
#undef PG8_LDA
#undef PG8_LDB
#undef PG8_MMA
#undef PG8_WAIT_V
#undef PG8_WAIT_L
#undef PG8_BAR
#undef PG8_SCHED
}
}

constexpr int NWAVES = 8;
constexpr size_t MiB = 1u << 20;
constexpr size_t WS_CTL = 0, CTL_ZERO_BYTES = 1 * MiB;
constexpr size_t WS_KSUM = 512 * 1024;
constexpr size_t WS_WIN = 2 * MiB, WS_WOUT = 10 * MiB, WS_WUP = 12 * MiB, WS_WDN = 20 * MiB;
constexpr size_t WS_GATE = 28 * MiB;
constexpr size_t WS_KSUMS = 29 * MiB;
constexpr size_t WS_XN = 32 * MiB;
constexpr size_t WS_SEG = 65 * MiB, SEG_BYTES = 17 * MiB;
constexpr size_t WS_H = 184 * MiB;
constexpr size_t WS_MIX = 217 * MiB;
constexpr size_t WS_X1 = 250 * MiB;
constexpr size_t WS_U = 320 * MiB;
constexpr size_t WS_END = 452 * MiB;
constexpr size_t WS_SSQ = 700 * MiB;
constexpr size_t WS_END_SSQ = 702 * MiB;
constexpr int CW_BAR = 4096;
constexpr int RING_OFF = 0, RING_BYTES = 131072;
constexpr int LDSCTL_OFF = RING_BYTES, MISC_OFF = LDSCTL_OFF + 320;
constexpr int LDS_BYTES = 151552;
constexpr int LUT8_OFF = LDSCTL_OFF + 13568;
#define GAS __attribute__((address_space(1)))
#define LAS __attribute__((address_space(3)))
typedef unsigned short bf16;
typedef unsigned v4u __attribute__((ext_vector_type(4)));
typedef float f32x4 __attribute__((ext_vector_type(4)));
typedef short bf16x8 __attribute__((ext_vector_type(8)));
typedef GAS unsigned gu32;
typedef GAS unsigned long long gu64;
#define RLX_AGENT __ATOMIC_RELAXED, __HIP_MEMORY_SCOPE_AGENT
#define LDS_WAIT() asm volatile("s_waitcnt lgkmcnt(0)" ::: "memory")
#define VM_WAIT() asm volatile("s_waitcnt vmcnt(0)" ::: "memory")
__device__ __forceinline__ unsigned long long rt() { return __builtin_amdgcn_s_memrealtime(); }
__device__ __forceinline__ unsigned pk2(float lo, float hi) { unsigned r; asm("v_cvt_pk_bf16_f32 %0, %1, %2" : "=v"(r) : "v"(lo), "v"(hi)); return r; }
__device__ __forceinline__ unsigned f2bf(float f) { return pk2(f, 0.f) & 0xffffu; }

#define XB_TMO      128
#define XB_XCNT(j)  (256  + 64 * (j))
#define XB_XSUB(j)  (1280 + 64 * (j))
#define XB_XGEN(j)  (2304 + 64 * (j))
#define XB_TOP      3328
#define XB_TOPGEN   3392
#define XCD_BAR_WORDS 3456
#define XB_SPIN_CAP (1u << 18)

__device__ __forceinline__ unsigned xb_ld(unsigned* p)              { return __hip_atomic_load(p, __ATOMIC_RELAXED, __HIP_MEMORY_SCOPE_AGENT); }
__device__ __forceinline__ unsigned xb_add(unsigned* p, unsigned v) { return __hip_atomic_fetch_add(p, v, __ATOMIC_RELAXED, __HIP_MEMORY_SCOPE_AGENT); }
__device__ __forceinline__ unsigned xb_xcc_id() { return (unsigned)__builtin_amdgcn_s_getreg((3 << 11) | 20) & 0xFu; }
#define XB_SPIN(cond, bar) do { unsigned _sp = 0; while (cond) { __builtin_amdgcn_s_sleep(1); \
    if ((++_sp & 255u) == 0u) { if (xb_ld(&(bar)[XB_TMO])) break; if (_sp > XB_SPIN_CAP) { atomicAdd(&(bar)[XB_TMO], 1u); break; } } } } while (0)

struct XcdBarrier {
    unsigned* bar; unsigned x;
    volatile LAS unsigned* st;
};

__device__ __forceinline__ XcdBarrier xcd_barrier_post(unsigned* bar, volatile LAS unsigned* st) {
    XcdBarrier b; b.bar = bar; b.x = xb_xcc_id(); b.st = st;
    if (threadIdx.x == 0) (void)xb_add(&bar[XB_XCNT(b.x)], 1u);
    return b;
}
__device__ __forceinline__ void xcd_barrier_complete(unsigned* bar, unsigned x, unsigned& nloc, unsigned& nx) {
    const unsigned G = gridDim.x * gridDim.y * gridDim.z;
    unsigned sum, cnt, mine, sp = 0u;
    for (;;) {
        sum = 0u; cnt = 0u; mine = 0u;
#pragma unroll
        for (unsigned j = 0; j < 16; ++j) { const unsigned c = xb_ld(&bar[XB_XCNT(j)]); sum += c; cnt += (c > 0u) ? 1u : 0u; mine = (j == x) ? c : mine; }
        if (sum == G) break;
        __builtin_amdgcn_s_sleep(1);
        if ((++sp & 255u) == 0u) { if (xb_ld(&bar[XB_TMO])) break; if (sp > XB_SPIN_CAP) { atomicAdd(&bar[XB_TMO], 1u); break; } }
    }
    nloc = mine > 0u ? mine : 1u; nx = cnt > 0u ? cnt : 1u;
}

__device__ __forceinline__ void xcd_barrier(const XcdBarrier& b) {
    asm volatile("s_waitcnt vmcnt(0)" ::: "memory");
    __syncthreads();
    if (threadIdx.x == 0) {
        unsigned* bar = b.bar;
        __builtin_amdgcn_s_waitcnt(0);
        unsigned nloc = b.st[0], nx = b.st[1];
        if (nloc == 0u) { xcd_barrier_complete(bar, b.x, nloc, nx); b.st[0] = nloc; b.st[1] = nx; }
        const unsigned old = xb_add(&bar[XB_XSUB(b.x)], 1u);
        const unsigned gen = old / nloc;
        if (old + 1u == (gen + 1u) * nloc) {
            __builtin_amdgcn_fence(__ATOMIC_RELEASE, "agent");
            asm volatile("s_waitcnt vmcnt(0)" ::: "memory");
            const unsigned og = xb_add(&bar[XB_TOP], 1u);
            const unsigned tg = og / nx;
            if (og + 1u == (tg + 1u) * nx) xb_add(&bar[XB_TOPGEN], 1u);
            else XB_SPIN(xb_ld(&bar[XB_TOPGEN]) == tg, bar);
            __builtin_amdgcn_fence(__ATOMIC_ACQUIRE, "agent");
            xb_add(&bar[XB_XGEN(b.x)], 1u);
            asm volatile("s_waitcnt vmcnt(0)" ::: "memory");
        } else {
            XB_SPIN(xb_ld(&bar[XB_XGEN(b.x)]) == gen, bar);
            __builtin_amdgcn_fence(__ATOMIC_ACQUIRE, "agent");
            asm volatile("s_waitcnt vmcnt(0)" ::: "memory");
        }
    }
    __syncthreads();
}

struct Frame {
    LAS unsigned char* lds;
    volatile LAS unsigned* MISC;
    gu32* ctl;
    int tid, lane, wave, vcu, G;
    const float *xp, *xs, *cache_k, *cache_v, *state_C, *state_n, *state_m; const int* page_table;
    const float *rel_bias, *norm_mix, *w_in, *b_ig, *b_fg, *ml_norm, *w_out, *norm_ffn, *w_up, *w_down, *norm_final;
    float* out; unsigned char* ws;
    bf16 *Win_t, *Wout_t, *Wup_t, *Wdn_t, *XN, *SEG, *MIX, *U;
    float *KSUM, *KSUMS, *IG, *LF, *H, *X1;
};
constexpr size_t SEG_ELEMS = SEG_BYTES / 2;
#define LUT8(F) ((const LAS float*)((F).lds + LUT8_OFF))
#define SEG_AQ(F) ((F).SEG + 0 * SEG_ELEMS)
#define SEG_AK(F) ((F).SEG + 1 * SEG_ELEMS)
#define SEG_AV(F) ((F).SEG + 2 * SEG_ELEMS)
#define SEG_MQ(F) ((F).SEG + 3 * SEG_ELEMS)
#define SEG_MK(F) ((F).SEG + 4 * SEG_ELEMS)
#define SEG_MV(F) ((F).SEG + 5 * SEG_ELEMS)
#define SEG_MO(F) ((F).SEG + 6 * SEG_ELEMS)

__device__ __forceinline__ float bf2f(unsigned short b) { return __builtin_bit_cast(float, (unsigned)b << 16); }
__device__ __forceinline__ float wave_sum(float v) {
#pragma unroll
    for (int o = 1; o < 64; o <<= 1) v += __shfl_xor(v, o);
    return v;
}
__device__ __forceinline__ void p0_transpose_item(const float* W, int K, int ldw, int N, bf16* WT, LAS float* scr, int item, int lane) {
    const int nblk = N / 32, kb = item / nblk, nb = item % nblk, k0 = 64 * kb, n0 = 32 * nb;
    float wv[32];
#pragma unroll
    for (int i = 0; i < 32; ++i) wv[i] = W[(size_t)(k0 + 2 * i + (lane >> 5)) * ldw + n0 + (lane & 31)];
#pragma unroll
    for (int i = 0; i < 32; i += 8) asm volatile("" : "+v"(wv[i]), "+v"(wv[i + 1]), "+v"(wv[i + 2]), "+v"(wv[i + 3]), "+v"(wv[i + 4]), "+v"(wv[i + 5]), "+v"(wv[i + 6]), "+v"(wv[i + 7]));
#pragma unroll
    for (int i = 0; i < 32; ++i) scr[(2 * i + (lane >> 5)) * 33 + (lane & 31)] = wv[i];
    LDS_WAIT(); asm volatile("" ::: "memory");
    const int c = lane & 7;
#pragma unroll
    for (int j = 0; j < 4; ++j) { const int n = (lane >> 3) + 8 * j; const LAS float* s = scr + (8 * c) * 33 + n;
        v4u o; o.x = pk2(s[0 * 33], s[1 * 33]); o.y = pk2(s[2 * 33], s[3 * 33]); o.z = pk2(s[4 * 33], s[5 * 33]); o.w = pk2(s[6 * 33], s[7 * 33]);
        *(GAS v4u*)(WT + (size_t)(n0 + n) * K + k0 + 8 * c) = o; }
    LDS_WAIT(); asm volatile("" ::: "memory");
}
__device__ __forceinline__ void load_row(const float* xrow, int lane, f32x4 (&v)[4]) {
    const GAS f32x4* xr = (const GAS f32x4*)xrow + lane;
#pragma unroll
    for (int j = 0; j < 4; ++j) v[j] = xr[64 * j];
}
__device__ __forceinline__ void load_row_nt(const float* xrow, int lane, f32x4 (&v)[4]) {
    const GAS f32x4* xr = (const GAS f32x4*)xrow + lane;
#pragma unroll
    for (int j = 0; j < 4; ++j) v[j] = __builtin_nontemporal_load(xr + 64 * j);
}
template <bool GATES>
__device__ __forceinline__ void rms_row_to_bf16(Frame& F, const f32x4 (&vin)[4], const float* gain, bf16* orow, int m) {
    const GAS f32x4* gr = (const GAS f32x4*)gain + F.lane;
    f32x4 v[4]; float s = 0.f;
#pragma unroll
    for (int j = 0; j < 4; ++j) { v[j] = vin[j]; s += (v[j].x * v[j].x + v[j].y * v[j].y) + (v[j].z * v[j].z + v[j].w * v[j].w); }
#pragma unroll
    for (int j = 0; j < 4; ++j) v[j] = v[j] * gr[64 * j];
    float g8[8];
    if (GATES) {
#pragma unroll
        for (int c = 0; c < 8; ++c) g8[c] = 0.f;
#pragma unroll
        for (int j = 0; j < 4; ++j)
#pragma unroll
            for (int i = 0; i < 4; ++i) { const int k = 256 * j + 4 * F.lane + i; const LAS f32x4* wr = (const LAS f32x4*)(F.lds + RING_OFF + 131072 - 32768) + 2 * k; const f32x4 w0 = wr[0], w1 = wr[1]; const float xv = v[j][i];
                g8[0] += xv * w0.x; g8[1] += xv * w0.y; g8[2] += xv * w0.z; g8[3] += xv * w0.w; g8[4] += xv * w1.x; g8[5] += xv * w1.y; g8[6] += xv * w1.z; g8[7] += xv * w1.w; }
    }
    const float rstd = 1.f / sqrtf(wave_sum(s) * (1.f / D) + RMS_EPS);
    GAS unsigned long long* o8 = (GAS unsigned long long*)orow + F.lane;
#pragma unroll
    for (int j = 0; j < 4; ++j) o8[64 * j] = (unsigned long long)pk2(v[j].x * rstd, v[j].y * rstd) | ((unsigned long long)pk2(v[j].z * rstd, v[j].w * rstd) << 32);
    if (GATES) {
#pragma unroll
        for (int c = 0; c < 8; ++c) g8[c] = wave_sum(g8[c]) * rstd;
        if (F.lane < 8) { float z = 0.f;
#pragma unroll
            for (int c = 0; c < 8; ++c) z = (F.lane == c) ? g8[c] : z;
            if (F.lane < 4) { F.IG[(size_t)m * 4 + F.lane] = z + F.b_ig[F.lane]; }
            else { const int h = F.lane - 4; z += F.b_fg[h]; F.LF[(size_t)m * 4 + h] = fminf(z, 0.f) - log1pf(expf(-fabsf(z))); } }
    }
}
__device__ __forceinline__ const float* xrow_of(Frame& F, int m) { return (m < MP) ? F.xp + (size_t)m * D : F.xs + (size_t)(m - MP) * D; }

constexpr int PS_SPLIT = 2048;
constexpr int P1_GEMM_WGS = 228;
__device__ __forceinline__ void page_sums(Frame& F, int u0, int u1, int w, int NW) {
    for (int u = u0 + w; u < u1; u += NW) {
        f32x4 a0 = {0.f, 0.f, 0.f, 0.f}, a1 = {0.f, 0.f, 0.f, 0.f};
        const int page = F.page_table[u];
        const GAS f32x4* base = (const GAS f32x4*)(F.cache_k + (size_t)page * PAGE * AW) + 2 * F.lane;
#pragma unroll 16
        for (int r = 0; r < PAGE; ++r) { a0 += __builtin_nontemporal_load(base + (size_t)r * (AW / 4)); a1 += __builtin_nontemporal_load(base + (size_t)r * (AW / 4) + 1); }
        GAS f32x4* o = (GAS f32x4*)(F.KSUMS + (size_t)u * AW) + 2 * F.lane; o[0] = a0; o[1] = a1;
    }
}
__device__ __forceinline__ void late_transposes(Frame& F, int w, int NW) {
    LAS float* scr = (LAS float*)(F.lds + RING_OFF + F.wave * 16384);
    constexpr int I_O = (D / 64) * (D / 32), I_UP = (D / 64) * (FF / 32), I_DN = (FF / 64) * (D / 32);
    for (int it = w; it < I_O + I_UP + I_DN; it += NW) {
        int r = it;
        if (r < I_O) { p0_transpose_item(F.w_out, D, D, D, F.Wout_t, scr, r, F.lane); continue; } r -= I_O;
        if (r < I_UP) { p0_transpose_item(F.w_up, D, FF, FF, F.Wup_t, scr, r, F.lane); continue; } r -= I_UP;
        p0_transpose_item(F.w_down, FF, D, D, F.Wdn_t, scr, r, F.lane);
    }
}
__device__ __forceinline__ void p0_prologue(Frame& F) {
    LAS float* scr = (LAS float*)(F.lds + RING_OFF + F.wave * 16384);
    const int gw = F.vcu * NWAVES + F.wave, NGW = F.G * NWAVES;
    constexpr int I_IN = (D / 64) * (NPG / 32);
    for (int it = gw; it < I_IN; it += NGW) p0_transpose_item(F.w_in, D, NPROJ, NPG, F.Win_t, scr, it, F.lane);
    __syncthreads();
    for (int i = F.tid; i < D * 2; i += NWAVES * 64) ((LAS f32x4*)(F.lds + RING_OFF + 131072 - 32768))[i] = *(const f32x4*)(F.w_in + (size_t)(i >> 1) * NPROJ + NPG + 4 * (i & 1));
    __syncthreads();
    {
        f32x4 r0[4], r1[4], r2[4];
        if (gw < M) load_row(xrow_of(F, gw), F.lane, r0);
        { const int m1 = (gw + NGW < M) ? gw + NGW : gw; load_row(xrow_of(F, m1 < M ? m1 : 0), F.lane, r1); }
        for (int m = gw; m < M; m += NGW) {
            const int m2 = (m + 2 * NGW < M) ? m + 2 * NGW : m; load_row(xrow_of(F, m2), F.lane, r2);
            rms_row_to_bf16<true>(F, r0, F.norm_mix, F.XN + (size_t)m * D, m);
#pragma unroll
            for (int j = 0; j < 4; ++j) { r0[j] = r1[j]; r1[j] = r2[j]; }
        }
    }
    page_sums(F, 0, PS_SPLIT, gw, NGW);
}

__device__ __forceinline__ int t5_bucket_small(int n) {
    if (n < 16) return n;
    int b = 16 + (int)(logf((float)n * (1.0f / 16.0f)) / 2.0794415416798357f * 16.0f);
    return b < 31 ? b : 31;
}

__device__ __forceinline__ void final_norm_rows(Frame& F) {
    const int gw = F.vcu * NWAVES + F.wave, NGW = F.G * NWAVES;
    f32x4 cur[4], nxt[4], nx2[4];
    if (gw < M) load_row_nt(F.X1 + (size_t)gw * D, F.lane, cur);
    { const int m1 = (gw + NGW < M) ? gw + NGW : (gw < M ? gw : 0); load_row_nt(F.X1 + (size_t)m1 * D, F.lane, nxt); }
    for (int m = gw; m < M; m += NGW) {
        const int m2 = (m + 2 * NGW < M) ? m + 2 * NGW : m; load_row_nt(F.X1 + (size_t)m2 * D, F.lane, nx2);
        const f32x4* gr = (const f32x4*)F.norm_final + F.lane;
        float s = 0.f;
#pragma unroll
        for (int j = 0; j < 4; ++j) s += (cur[j].x * cur[j].x + cur[j].y * cur[j].y) + (cur[j].z * cur[j].z + cur[j].w * cur[j].w);
        const float rstd = 1.f / sqrtf(wave_sum(s) * (1.f / D) + RMS_EPS);
        f32x4* o = (f32x4*)(F.out + ((m < MP) ? O_YP + (size_t)m * D : O_YS + (size_t)(m - MP) * D)) + F.lane;
#pragma unroll
        for (int j = 0; j < 4; ++j) __builtin_nontemporal_store(cur[j] * rstd * gr[64 * j], o + 64 * j);
#pragma unroll
        for (int j = 0; j < 4; ++j) { cur[j] = nxt[j]; nxt[j] = nx2[j]; }
    }
}

typedef float f32x16 __attribute__((ext_vector_type(16)));
typedef short s16x4 __attribute__((ext_vector_type(4)));
typedef short v4i16_t __attribute__((ext_vector_type(4)));
__device__ __forceinline__ f32x16 mfma32(bf16x8 a, bf16x8 b, f32x16 c) { return __builtin_amdgcn_mfma_f32_32x32x16_bf16(a, b, c, 0, 0, 0); }
__device__ __forceinline__ int crow(int r, int hi) { return (r & 3) + 8 * (r >> 2) + 4 * hi; }
__device__ __forceinline__ s16x4 vtr(const LAS unsigned char* p) { return __builtin_bit_cast(s16x4, __builtin_amdgcn_ds_read_tr16_b64_v4i16((LAS v4i16_t*)p)); }
__device__ __forceinline__ bf16x8 tfrag(const LAS unsigned char* tile, int T, int s, int ct, int lane) {
    const int i = lane & 15, hi = lane >> 5;
    const LAS unsigned char* p = tile + ct * (T * 64) + (16 * s + 4 * hi + (i >> 2)) * 64 + ((lane >> 4) & 1) * 32 + (i & 3) * 8;
    const s16x4 lo = vtr(p), hh = vtr(p + 512);
    return (bf16x8){lo[0], lo[1], lo[2], lo[3], hh[0], hh[1], hh[2], hh[3]};
}
__device__ __forceinline__ bf16x8 rfrag(const LAS unsigned char* tile, int T, int rt, int s, int lane) {
    return *(const LAS bf16x8*)(tile + (2 * s + (lane >> 5)) * (T * 16) + (32 * rt + (lane & 31)) * 16);
}
__device__ __forceinline__ float half_swap_add(float v) { return v + __shfl_xor(v, 32); }

constexpr int MLC = 256, NCH = SEQ / MLC  , NSEQ = NBATCH * MH  ;
constexpr size_t WS_DCT = 452 * MiB;
constexpr size_t WS_CT = 468 * MiB;
constexpr size_t WS_MLS = 476 * MiB;
constexpr size_t MLS_DN = 0, MLS_NC = 32768, MLS_SC = 65536, MLS_MC = 66048;
constexpr size_t WS_END2 = 477 * MiB;
constexpr int ML_TAB_OFF = LDSCTL_OFF + 2048;
constexpr int ML_MISC = 1280, ML_WSC = 1296;

__device__ __forceinline__ void ml_scalars(Frame& F, int row0, int h, float m0, LAS float* tab) {
    if (F.wave == 0) {
        const int l = F.lane; float lf[4], ig[4], b[4], u[4], pm[4];
#pragma unroll
        for (int i = 0; i < 4; ++i) { lf[i] = F.LF[(size_t)(row0 + 4 * l + i) * 4 + h]; ig[i] = F.IG[(size_t)(row0 + 4 * l + i) * 4 + h]; }
        b[0] = lf[0]; b[1] = b[0] + lf[1]; b[2] = b[1] + lf[2]; b[3] = b[2] + lf[3];
        float x = b[3];
#pragma unroll
        for (int o = 1; o < 64; o <<= 1) { const float y = __shfl_up(x, o); if (l >= o) x += y; }
        const float excl = x - b[3];
#pragma unroll
        for (int i = 0; i < 4; ++i) { b[i] += excl; u[i] = ig[i] - b[i]; }
        pm[0] = u[0]; pm[1] = fmaxf(pm[0], u[1]); pm[2] = fmaxf(pm[1], u[2]); pm[3] = fmaxf(pm[2], u[3]);
        float xm = pm[3];
#pragma unroll
        for (int o = 1; o < 64; o <<= 1) { const float y = __shfl_up(xm, o); if (l >= o) xm = fmaxf(xm, y); }
        float em = __shfl_up(xm, 1); if (l == 0) em = -INFINITY;
        em = fmaxf(em, m0);
#pragma unroll
        for (int i = 0; i < 4; ++i) { tab[4 * l + i] = b[i]; tab[256 + 4 * l + i] = u[i]; tab[512 + 4 * l + i] = fmaxf(em, pm[i]); }
        if (l == 63) { tab[ML_MISC] = xm; tab[ML_MISC + 1] = b[3]; }
    }
}
template <bool SCALE>
__device__ __forceinline__ void stage_T128(Frame& F, const bf16* src, LAS unsigned char* tile, const LAS float* utab, float Mloc) {
    v4u w[8];
#pragma unroll
    for (int i = 0; i < 8; ++i) { const int piece = F.tid + 512 * i, token = piece >> 4, ch = piece & 15; w[i] = *(const v4u*)(src + (size_t)token * 512 + 8 * ch); }
    asm volatile("" : "+v"(w[0]), "+v"(w[1]), "+v"(w[2]), "+v"(w[3]), "+v"(w[4]), "+v"(w[5]), "+v"(w[6]), "+v"(w[7]));
#pragma unroll
    for (int i = 0; i < 8; ++i) {
        const int piece = F.tid + 512 * i, token = piece >> 4, ch = piece & 15;
        v4u x = w[i];
        if (SCALE) { const float g = __expf(utab[token] - Mloc); unsigned ww[4] = {x.x, x.y, x.z, x.w};
#pragma unroll
            for (int k = 0; k < 4; ++k) ww[k] = pk2(__builtin_bit_cast(float, ww[k] << 16) * g, __builtin_bit_cast(float, ww[k] & 0xffff0000u) * g);
            x.x = ww[0]; x.y = ww[1]; x.z = ww[2]; x.w = ww[3]; }
        *(LAS v4u*)(tile + (ch >> 2) * (MLC * 64) + token * 64 + (ch & 3) * 16) = x;
    }
}
__device__ __forceinline__ void stage_R128(Frame& F, const bf16* src, LAS unsigned char* tile) {
    v4u w[8];
#pragma unroll
    for (int i = 0; i < 8; ++i) { const int piece = F.tid + 512 * i, token = piece >> 4, ch = piece & 15; w[i] = *(const v4u*)(src + (size_t)token * 512 + 8 * ch); }
    asm volatile("" : "+v"(w[0]), "+v"(w[1]), "+v"(w[2]), "+v"(w[3]), "+v"(w[4]), "+v"(w[5]), "+v"(w[6]), "+v"(w[7]));
#pragma unroll
    for (int i = 0; i < 8; ++i) { const int piece = F.tid + 512 * i, token = piece >> 4, ch = piece & 15; *(LAS v4u*)(tile + ch * (MLC * 16) + token * 16) = w[i]; }
}
__device__ __forceinline__ void mlstm_stepA(Frame& F, int unit) {
    const int seq = unit >> 4, c = unit & 15, b = seq >> 2, h = seq & 3, row0 = b * SEQ + c * MLC;
    LAS float* tab = (LAS float*)(F.lds + ML_TAB_OFF);
    LAS unsigned char* KT = F.lds + RING_OFF; LAS unsigned char* VT = F.lds + RING_OFF + 65536;
    float* mls = (float*)((unsigned char*)F.ws + WS_MLS);
    v4u kw[8], vw[8];
    { const bf16* ksrc = SEG_MK(F) + (size_t)row0 * MW + h * MD; const bf16* vsrc = SEG_MV(F) + (size_t)row0 * MW + h * MD;
#pragma unroll
      for (int i = 0; i < 8; ++i) { const int piece = F.tid + 512 * i, token = piece >> 4, ch = piece & 15; kw[i] = *(const v4u*)(ksrc + (size_t)token * 512 + 8 * ch); vw[i] = *(const v4u*)(vsrc + (size_t)token * 512 + 8 * ch); } }
    ml_scalars(F, row0, h, -INFINITY, tab);
    asm volatile("" : "+v"(kw[0]), "+v"(kw[1]), "+v"(kw[2]), "+v"(kw[3]), "+v"(kw[4]), "+v"(kw[5]), "+v"(kw[6]), "+v"(kw[7]));
    asm volatile("" : "+v"(vw[0]), "+v"(vw[1]), "+v"(vw[2]), "+v"(vw[3]), "+v"(vw[4]), "+v"(vw[5]), "+v"(vw[6]), "+v"(vw[7]));
    __syncthreads();
    const float Mloc = tab[ML_MISC];
#pragma unroll
    for (int i = 0; i < 8; ++i) {
        const int piece = F.tid + 512 * i, token = piece >> 4, ch = piece & 15;
        const float g = __expf(tab[256 + token] - Mloc); unsigned ww[4] = {kw[i].x, kw[i].y, kw[i].z, kw[i].w};
#pragma unroll
        for (int k = 0; k < 4; ++k) ww[k] = pk2(__builtin_bit_cast(float, ww[k] << 16) * g, __builtin_bit_cast(float, ww[k] & 0xffff0000u) * g);
        v4u x; x.x = ww[0]; x.y = ww[1]; x.z = ww[2]; x.w = ww[3];
        const int off = (ch >> 2) * (MLC * 64) + token * 64 + (ch & 3) * 16;
        *(LAS v4u*)(KT + off) = x; *(LAS v4u*)(VT + off) = vw[i];
    }
    __syncthreads();
    const int et = F.wave >> 1, dt0 = 2 * (F.wave & 1);
    f32x16 acc0 = {}, acc1 = {};
#pragma unroll 4
    for (int s = 0; s < 16; ++s) {
        const bf16x8 a = tfrag(VT, MLC, s, et, F.lane), b0 = tfrag(KT, MLC, s, dt0, F.lane), b1 = tfrag(KT, MLC, s, dt0 + 1, F.lane);
        acc0 = mfma32(a, b0, acc0); acc1 = mfma32(a, b1, acc1);
    }
    float* dct = (float*)((unsigned char*)F.ws + WS_DCT) + ((size_t)(seq * NCH + c)) * MD * MD;
    const int hi = F.lane >> 5, cl = F.lane & 31;
#pragma unroll
    for (int r = 0; r < 16; ++r) { const int e = 32 * et + crow(r, hi); dct[(size_t)e * MD + 32 * dt0 + cl] = acc0[r]; dct[(size_t)e * MD + 32 * (dt0 + 1) + cl] = acc1[r]; }
    { const int d = F.tid & 127, qd = F.tid >> 7; float s = 0.f;
      const LAS unsigned short* kp = (const LAS unsigned short*)(KT + (d >> 5) * (MLC * 64) + (d & 31) * 2);
#pragma unroll 8
      for (int j = 0; j < 64; ++j) s += bf2f(kp[(size_t)(64 * qd + j) * 32]);
      tab[768 + F.tid] = s; }
    __syncthreads();
    if (F.tid < 128) mls[MLS_DN + (size_t)(seq * NCH + c) * MD + F.tid] = (tab[768 + F.tid] + tab[768 + 128 + F.tid]) + (tab[768 + 256 + F.tid] + tab[768 + 384 + F.tid]);
    if (F.tid == 0) { mls[MLS_SC + (seq * NCH + c) * 2] = Mloc; mls[MLS_SC + (seq * NCH + c) * 2 + 1] = tab[ML_MISC + 1]; }
    __syncthreads();
}
__device__ __forceinline__ void mlstm_stepB(Frame& F, int unit) {
    const int seq = unit >> 4, sl = unit & 15, d = F.tid & 127, el = F.tid >> 7, e0 = 8 * sl + el, e1 = e0 + 4;
    float* mls = (float*)((unsigned char*)F.ws + WS_MLS);
    const float* dctb = (const float*)((unsigned char*)F.ws + WS_DCT) + (size_t)seq * NCH * MD * MD;
    bf16* ctb = (bf16*)((unsigned char*)F.ws + WS_CT) + (size_t)seq * NCH * MD * MD;
    float x0[NCH], x1[NCH], dn[NCH];
#pragma unroll
    for (int c = 0; c < NCH; ++c) { x0[c] = dctb[(size_t)c * MD * MD + (size_t)e0 * MD + d]; x1[c] = dctb[(size_t)c * MD * MD + (size_t)e1 * MD + d]; dn[c] = mls[MLS_DN + (size_t)(seq * NCH + c) * MD + d]; }
    float C0 = 0.f, C1 = 0.f, nv = 0.f, m = 0.f;
    const bool nwriter = (sl == 0) && (el == 0);
#pragma unroll
    for (int c = 0; c < NCH; ++c) {
        ctb[(size_t)c * MD * MD + (size_t)e0 * MD + d] = (bf16)f2bf(C0); ctb[(size_t)c * MD * MD + (size_t)e1 * MD + d] = (bf16)f2bf(C1);
        if (nwriter) { mls[MLS_NC + (size_t)(seq * NCH + c) * MD + d] = nv; if (d == 0) mls[MLS_MC + seq * NCH + c] = m; }
        const float Mloc = mls[MLS_SC + (seq * NCH + c) * 2], bL = mls[MLS_SC + (seq * NCH + c) * 2 + 1];
        const float Mt = fmaxf(m, Mloc), fa = __expf(m - Mt), fb = __expf(Mloc - Mt);
        C0 = fa * C0 + fb * x0[c]; C1 = fa * C1 + fb * x1[c]; nv = fa * nv + fb * dn[c];
        m = bL + Mt;
    }
    F.out[O_CP + (size_t)seq * MD * MD + (size_t)d * MD + e0] = C0; F.out[O_CP + (size_t)seq * MD * MD + (size_t)d * MD + e1] = C1;
    if (nwriter) { F.out[O_NP + (size_t)seq * MD + d] = nv; if (d == 0) F.out[O_MP + seq] = m; }
}
__device__ __forceinline__ void mlstm_stepC(Frame& F, int unit) {
    const int seq = unit >> 4, c = unit & 15, b = seq >> 2, h = seq & 3, row0 = b * SEQ + c * MLC;
    LAS float* tab = (LAS float*)(F.lds + ML_TAB_OFF);
    LAS unsigned char* KR = F.lds + RING_OFF; LAS unsigned char* VT = F.lds + RING_OFF + 65536;
    const float* mls = (const float*)((unsigned char*)F.ws + WS_MLS);
    const float m0 = mls[MLS_MC + seq * NCH + c];
    v4u kw[8], vw[8];
    { const bf16* ksrc = SEG_MK(F) + (size_t)row0 * MW + h * MD; const bf16* vsrc = SEG_MV(F) + (size_t)row0 * MW + h * MD;
#pragma unroll
      for (int i = 0; i < 8; ++i) { const int piece = F.tid + 512 * i, token = piece >> 4, ch = piece & 15; kw[i] = *(const v4u*)(ksrc + (size_t)token * 512 + 8 * ch); vw[i] = *(const v4u*)(vsrc + (size_t)token * 512 + 8 * ch); } }
    ml_scalars(F, row0, h, m0, tab);
    if (F.tid < 128) tab[768 + F.tid] = mls[MLS_NC + (size_t)(seq * NCH + c) * MD + F.tid];
    asm volatile("" : "+v"(kw[0]), "+v"(kw[1]), "+v"(kw[2]), "+v"(kw[3]), "+v"(kw[4]), "+v"(kw[5]), "+v"(kw[6]), "+v"(kw[7]));
    asm volatile("" : "+v"(vw[0]), "+v"(vw[1]), "+v"(vw[2]), "+v"(vw[3]), "+v"(vw[4]), "+v"(vw[5]), "+v"(vw[6]), "+v"(vw[7]));
#pragma unroll
    for (int i = 0; i < 8; ++i) { const int piece = F.tid + 512 * i, token = piece >> 4, ch = piece & 15;
        *(LAS v4u*)(KR + ch * (MLC * 16) + token * 16) = kw[i];
        *(LAS v4u*)(VT + (ch >> 2) * (MLC * 64) + token * 64 + (ch & 3) * 16) = vw[i]; }
    __syncthreads();
    const int w = F.wave, lane = F.lane, tl = lane & 31, hi = lane >> 5, t0 = 32 * w, t = t0 + tl;
    bf16x8 qf[8];
    { const bf16* qp = SEG_MQ(F) + (size_t)(row0 + t) * MW + h * MD + 8 * hi;
#pragma unroll
      for (int s = 0; s < 8; ++s) qf[s] = *(const bf16x8*)(qp + 16 * s); }
    float qn = 0.f;
#pragma unroll
    for (int s = 0; s < 8; ++s)
#pragma unroll
        for (int i = 0; i < 8; ++i) qn += bf2f((unsigned short)qf[s][i]) * tab[768 + 16 * s + 8 * hi + i];
    qn = half_swap_add(qn);
    const float Mt = tab[512 + t], wt = __expf(m0 - Mt);
    f32x16 acc[4];
    const bf16* ct = (const bf16*)((unsigned char*)F.ws + WS_CT) + (size_t)(seq * NCH + c) * MD * MD;
#pragma unroll
    for (int et = 0; et < 4; ++et) { acc[et] = (f32x16){};
#pragma unroll
        for (int s = 0; s < 8; ++s) { const bf16x8 cf = *(const bf16x8*)(ct + (size_t)(32 * et + tl) * MD + 16 * s + 8 * hi); acc[et] = mfma32(qf[s], cf, acc[et]); } }
    LAS float* wsc = tab + ML_WSC + 64 * w;
    if (hi == 0) wsc[tl] = wt;
    asm volatile("s_waitcnt lgkmcnt(0)" ::: "memory");
#pragma unroll
    for (int r = 0; r < 16; ++r) { const float ws_ = wsc[crow(r, hi)];
#pragma unroll
        for (int et = 0; et < 4; ++et) acc[et][r] *= ws_; }
    float rs = 0.f;
    for (int jt = 0; jt <= w; ++jt) {
        f32x16 st = {};
#pragma unroll
        for (int s = 0; s < 8; ++s) st = mfma32(rfrag(KR, MLC, jt, s, lane), qf[s], st);
#pragma unroll
        for (int r = 0; r < 16; ++r) { const int j = 32 * jt + crow(r, hi); const float v = st[r] * __expf(tab[256 + j] - Mt); st[r] = (j <= t) ? v : 0.f; rs += st[r]; }
        bf16x8 pa0, pa1;
#pragma unroll
        for (int i = 0; i < 4; ++i) { const unsigned p0 = pk2(st[2 * i], st[2 * i + 1]), p1 = pk2(st[8 + 2 * i], st[8 + 2 * i + 1]);
            pa0[2 * i] = (short)(p0 & 0xffff); pa0[2 * i + 1] = (short)(p0 >> 16); pa1[2 * i] = (short)(p1 & 0xffff); pa1[2 * i + 1] = (short)(p1 >> 16); }
#pragma unroll
        for (int et = 0; et < 4; ++et) { acc[et] = mfma32(pa0, tfrag(VT, MLC, 2 * jt, et, lane), acc[et]); acc[et] = mfma32(pa1, tfrag(VT, MLC, 2 * jt + 1, et, lane), acc[et]); }
    }
    rs = half_swap_add(rs);
    const float den = wt * qn + rs, mt = tab[t] + Mt, sc = 1.f / fmaxf(fabsf(den), __expf(-mt));
    asm volatile("s_waitcnt lgkmcnt(0)" ::: "memory");
    if (hi == 0) wsc[32 + tl] = sc;
    asm volatile("s_waitcnt lgkmcnt(0)" ::: "memory");
    __syncthreads();
    LAS float* hl = (LAS float*)(F.lds + RING_OFF) + w * 4096;
#pragma unroll
    for (int r = 0; r < 16; ++r) { const int tr = crow(r, hi); const float s_ = wsc[32 + tr];
#pragma unroll
        for (int et = 0; et < 4; ++et) hl[tr * 128 + 32 * et + tl] = acc[et][r] * s_; }
    asm volatile("s_waitcnt lgkmcnt(0)" ::: "memory");
    {
        const float g0 = F.ml_norm[h * MD + 2 * lane], g1 = F.ml_norm[h * MD + 2 * lane + 1];
#pragma unroll
        for (int hb = 0; hb < 2; ++hb) {
            unsigned mo[16];
#pragma unroll
            for (int i = 0; i < 16; ++i) mo[i] = *(const unsigned*)(SEG_MO(F) + (size_t)(row0 + 32 * w + 16 * hb + i) * MW + h * MD + 2 * lane);
#pragma unroll
            for (int i = 0; i < 16; ++i) { const size_t row = (size_t)(row0 + 32 * w + 16 * hb + i);
                typedef float f32x2_l __attribute__((ext_vector_type(2))); const f32x2_l hv = *(const LAS f32x2_l*)(hl + (16 * hb + i) * 128 + 2 * lane);
                const float rstd = 1.f / sqrtf(wave_sum(hv.x * hv.x + hv.y * hv.y) * (1.f / MD) + RMS_EPS);
                const float z0 = __builtin_bit_cast(float, mo[i] << 16), z1 = __builtin_bit_cast(float, mo[i] & 0xffff0000u);
                *(unsigned*)(F.MIX + row * D + AW + h * MD + 2 * lane) = pk2(hv.x * rstd * g0 / (1.f + __expf(-z0)), hv.y * rstd * g1 / (1.f + __expf(-z1))); }
        }
    }
    __syncthreads();
}

__device__ __forceinline__ void mlstm_sample_full(Frame& F, int seq) {
    const int sb = seq >> 2, h = seq & 3, e = F.tid & 127, dq = F.tid >> 7, row0 = MP + sb * DS;
    LAS float* red = (LAS float*)(F.lds + RING_OFF);
    float C[32], nn[32];
    const float* C0 = F.state_C + (size_t)seq * MD * MD;
#pragma unroll
    for (int i = 0; i < 32; ++i) { C[i] = C0[(size_t)(32 * dq + i) * MD + e]; nn[i] = F.state_n[(size_t)seq * MD + 32 * dq + i]; }
    float mm = F.state_m[seq];
    LAS unsigned* inb = (LAS unsigned*)(red + 2048);
    LAS float* gts = red + 2048 + 1536;
    __syncthreads();
    for (int i = F.tid; i < DS * 3 * 64; i += NWAVES * 64) { const int t = i / 192, r = i % 192, which = r >> 6, wd = r & 63;
        inb[i] = *((const unsigned*)(F.SEG + (size_t)(3 + which) * SEG_ELEMS + (size_t)(row0 + t) * MW + h * MD) + wd); }
    if (F.tid < DS * 2) { const int t = F.tid >> 1; gts[F.tid] = (F.tid & 1) ? F.LF[(size_t)(row0 + t) * 4 + h] : F.IG[(size_t)(row0 + t) * 4 + h]; }
    __syncthreads();
    for (int t = 0; t < DS; ++t) {
        const LAS v4u* qp = (const LAS v4u*)(inb + t * 192) + 4 * dq; const LAS v4u* kp = (const LAS v4u*)(inb + t * 192 + 64) + 4 * dq;
        const unsigned vw = inb[t * 192 + 128 + (e >> 1)]; const float v = __builtin_bit_cast(float, (e & 1) ? (vw & 0xffff0000u) : (vw << 16));
        const float ig = gts[2 * t], lf = gts[2 * t + 1];
        const float mn = fmaxf(lf + mm, ig), fs = __expf(lf + mm - mn), is = __expf(ig - mn);
        float num = 0.f, den = 0.f;
#pragma unroll
        for (int c = 0; c < 4; ++c) { const v4u qw = qp[c], kw = kp[c]; const unsigned qq[4] = {qw.x, qw.y, qw.z, qw.w}, kk[4] = {kw.x, kw.y, kw.z, kw.w};
#pragma unroll
            for (int j = 0; j < 8; ++j) { const int i = 8 * c + j;
                const float qv = __builtin_bit_cast(float, (j & 1) ? (qq[j >> 1] & 0xffff0000u) : (qq[j >> 1] << 16)), kv = __builtin_bit_cast(float, (j & 1) ? (kk[j >> 1] & 0xffff0000u) : (kk[j >> 1] << 16));
                C[i] = fs * C[i] + is * kv * v; nn[i] = fs * nn[i] + is * kv; num += qv * C[i]; den += qv * nn[i]; } }
        mm = mn;
        red[dq * 128 + e] = num; red[512 + dq * 128 + e] = den;
        __syncthreads();
        if (dq == 0) { const float nu = (red[e] + red[128 + e]) + (red[256 + e] + red[384 + e]), de = (red[512 + e] + red[640 + e]) + (red[768 + e] + red[896 + e]);
            red[1024 + t * 128 + e] = nu / fmaxf(fabsf(de), __expf(-mn)); }
        __syncthreads();
    }
    { const int t = F.wave; const size_t row = (size_t)(row0 + t);
      const float h0 = red[1024 + t * 128 + 2 * F.lane], h1 = red[1024 + t * 128 + 2 * F.lane + 1];
      const float rstd = 1.f / sqrtf(wave_sum(h0 * h0 + h1 * h1) * (1.f / MD) + RMS_EPS);
      const unsigned mo = *(const unsigned*)(SEG_MO(F) + row * MW + h * MD + 2 * F.lane);
      const float z0 = __builtin_bit_cast(float, mo << 16), z1 = __builtin_bit_cast(float, mo & 0xffff0000u);
      const float g0 = F.ml_norm[h * MD + 2 * F.lane], g1 = F.ml_norm[h * MD + 2 * F.lane + 1];
      *(unsigned*)(F.MIX + row * D + AW + h * MD + 2 * F.lane) = pk2(h0 * rstd * g0 / (1.f + __expf(-z0)), h1 * rstd * g1 / (1.f + __expf(-z1))); }
    float* Co = F.out + O_CS + (size_t)seq * MD * MD;
#pragma unroll
    for (int i = 0; i < 32; ++i) Co[(size_t)(32 * dq + i) * MD + e] = C[i];
    if (e == 0) {
#pragma unroll
        for (int i = 0; i < 32; ++i) F.out[O_NS + (size_t)seq * MD + 32 * dq + i] = nn[i];
        if (dq == 0) F.out[O_MS + seq] = mm;
    }
    __syncthreads();
}

constexpr size_t WS_LIST = 480 * MiB;
constexpr size_t WS_CNT = 484 * MiB;
constexpr size_t WS_PARTO = 485 * MiB;
constexpr size_t WS_PARTS = 534 * MiB;
constexpr size_t WS_END3 = 538 * MiB;
constexpr size_t WS_QG = 560 * MiB;
constexpr size_t WS_END_QG = 682 * MiB;
__host__ __device__ constexpr int past_item_index(int bh, int n, int o) { return bh * 120 + 15 * n - (n * (n - 1)) / 2 + (o - n - 1); }
constexpr int AT_WSC = 192;
constexpr int AT_LUT = 768;

__device__ __forceinline__ void build_lut(Frame& F, const LAS int* bucket, int h, LAS float* lut) {
    if (F.tid < 128) lut[F.tid] = F.rel_bias[bucket[F.tid] * AH + h];
    if (F.tid == 128) lut[128] = F.rel_bias[31 * AH + h];
}
__device__ __forceinline__ void stage_kv64(Frame& F, const bf16* ksrc, const bf16* vsrc, LAS unsigned char* KR, LAS unsigned char* VT) {
    v4u kk[4], vv[4];
#pragma unroll
    for (int i = 0; i < 4; ++i) { const int piece = F.tid + 512 * i, key = piece >> 3, ch = piece & 7;
        kk[i] = *(const v4u*)(ksrc + (size_t)key * AW + 8 * ch); vv[i] = *(const v4u*)(vsrc + (size_t)key * AW + 8 * ch); }
    asm volatile("" : "+v"(kk[0]), "+v"(kk[1]), "+v"(kk[2]), "+v"(kk[3]), "+v"(vv[0]), "+v"(vv[1]), "+v"(vv[2]), "+v"(vv[3]));
#pragma unroll
    for (int i = 0; i < 4; ++i) { const int piece = F.tid + 512 * i, key = piece >> 3, ch = piece & 7;
        *(LAS v4u*)(KR + ch * (256 * 16) + key * 16) = kk[i];
        *(LAS v4u*)(VT + (ch >> 2) * (256 * 64) + key * 64 + (ch & 3) * 16) = vv[i]; }
}
__device__ __forceinline__ void attn_select2(Frame& F, int ua, int ub) {
    const int half = F.tid >> 8, qt = F.tid & 255, unit = half ? ub : ua;
    const bool act = unit >= 0;
    const int bh = act ? unit / 15 : 0, o = act ? unit % 15 + 1 : 1, b = bh >> 3, h = bh & 7;
    LAS float* ks = (LAS float*)(F.lds + RING_OFF + half * 8192);
    LAS int* cnt = (LAS int*)(F.lds + RING_OFF + half * 8192 + 4096);
    __syncthreads();
    const int m = b * SEQ + o * 256 + qt;
    v4u qw[8];
    { const v4u* qp = (const v4u*)(SEG_AQ(F) + (size_t)m * AW + h * AD);
#pragma unroll
      for (int c = 0; c < 8; ++c) qw[c] = act ? qp[c] : (v4u){0u, 0u, 0u, 0u}; }
    float kv[4];
#pragma unroll
    for (int i = 0; i < 4; ++i) { const int idx = qt + 256 * i; kv[i] = (act && idx < o * 64) ? F.KSUM[((size_t)(b * NBLK_P + (idx >> 6))) * AW + h * AD + (idx & 63)] : 0.f; }
#pragma unroll
    for (int i = 0; i < 4; ++i) { const int idx = qt + 256 * i; if (idx < 15 * 64) ks[idx] = kv[i]; }
    if (qt < 16) cnt[qt] = 0;
    __syncthreads();
    if (act) {
        float q[64];
#pragma unroll
        for (int c = 0; c < 8; ++c) { const v4u w = qw[c];
            q[8 * c + 0] = __builtin_bit_cast(float, w.x << 16); q[8 * c + 1] = __builtin_bit_cast(float, w.x & 0xffff0000u);
            q[8 * c + 2] = __builtin_bit_cast(float, w.y << 16); q[8 * c + 3] = __builtin_bit_cast(float, w.y & 0xffff0000u);
            q[8 * c + 4] = __builtin_bit_cast(float, w.z << 16); q[8 * c + 5] = __builtin_bit_cast(float, w.z & 0xffff0000u);
            q[8 * c + 6] = __builtin_bit_cast(float, w.w << 16); q[8 * c + 7] = __builtin_bit_cast(float, w.w & 0xffff0000u); }
        float s0 = -INFINITY, s1 = -INFINITY, s2 = -INFINITY; int i0 = -1, i1 = -1, i2 = -1;
        for (int n = 0; n < o; ++n) {
            float s = 0.f;
#pragma unroll
            for (int d = 0; d < 64; ++d) s += q[d] * ks[n * 64 + d];
            if (s > s0) { s2 = s1; i2 = i1; s1 = s0; i1 = i0; s0 = s; i0 = n; }
            else if (s > s1) { s2 = s1; i2 = i1; s1 = s; i1 = n; }
            else if (s > s2) { s2 = s; i2 = n; }
        }
        unsigned short* list = (unsigned short*)(F.ws + WS_LIST);
#pragma unroll
        for (int j = 0; j < 3; ++j) {
            const int n = (j == 0) ? i0 : (j == 1 ? i1 : i2);
            if (n >= 0) { const int slot = __hip_atomic_fetch_add(&cnt[n], 1, __ATOMIC_RELAXED, __HIP_MEMORY_SCOPE_WORKGROUP);
                const size_t e = (size_t)past_item_index(bh, n, o) * 256 + slot;
                list[e] = (unsigned short)(qt | (j << 8));
                v4u* qg = (v4u*)((bf16*)(F.ws + WS_QG) + e * 64);
#pragma unroll
                for (int c = 0; c < 8; ++c) qg[c] = qw[c]; }
        }
    }
    __syncthreads();
    if (act && qt < o) ((int*)(F.ws + WS_CNT))[past_item_index(bh, qt, o)] = cnt[qt];
}
struct AttnOut { f32x16 o0, o1; float mx, l; };
__device__ __forceinline__ float max3f(float a, float b, float c) { float r; asm("v_max3_f32 %0, %1, %2, %3" : "=v"(r) : "v"(a), "v"(b), "v"(c)); return r; }
__device__ __forceinline__ void pack_p(const f32x16& p, bf16x8& pa0, bf16x8& pa1) {
#pragma unroll
    for (int i = 0; i < 4; ++i) { const unsigned p0 = pk2(p[2 * i], p[2 * i + 1]), p1 = pk2(p[8 + 2 * i], p[8 + 2 * i + 1]);
        pa0[2 * i] = (short)(p0 & 0xffff); pa0[2 * i + 1] = (short)(p0 >> 16); pa1[2 * i] = (short)(p1 & 0xffff); pa1[2 * i + 1] = (short)(p1 >> 16); }
}
template <bool CAUSAL>
__device__ __forceinline__ f32x16 score_tile(const LAS unsigned char* KR, const bf16x8 (&qf)[4], int lane, int kt, int tq, bool lutp, const LAS float* lut, float b31) {
    const int hi = lane >> 5;
    f32x16 a = {};
#pragma unroll
    for (int s = 0; s < 4; ++s) a = mfma32(rfrag(KR, 256, kt, s, lane), qf[s], a);
    if (lutp) {
#pragma unroll
        for (int r = 0; r < 16; ++r) { const int key = 32 * kt + crow(r, hi); int dist = tq - key; dist = dist < 0 ? 0 : (dist > 128 ? 128 : dist); a[r] += lut[dist]; if (CAUSAL && key > tq) a[r] = -INFINITY; }
    } else {
#pragma unroll
        for (int r = 0; r < 16; ++r) a[r] += b31;
    }
    return a;
}
template <bool CAUSAL>
__device__ __forceinline__ AttnOut wave_attend(const LAS unsigned char* KR, const LAS unsigned char* VT, const bf16x8 (&qf)[4], int lane, int nkt  ,
                                               int tq  , bool use_lut  , int lut_from_kt  , const LAS float* lut, float b31, int kt0 = 0  ) {
    AttnOut R; R.o0 = (f32x16){}; R.o1 = (f32x16){}; R.mx = -1e30f; R.l = 0.f;
    for (int kt = kt0; kt < nkt; kt += 2) {
        const bool two = (kt + 1 < nkt);
        f32x16 a0 = score_tile<CAUSAL>(KR, qf, lane, kt, tq, use_lut && kt >= lut_from_kt, lut, b31);
        f32x16 a1 = a0;
        if (two) a1 = score_tile<CAUSAL>(KR, qf, lane, kt + 1, tq, use_lut && kt + 1 >= lut_from_kt, lut, b31);
        float cm0 = max3f(a0[0], a0[1], a1[0]), cm1 = max3f(a0[2], a0[3], a1[1]);
        cm0 = max3f(cm0, a1[2], a1[3]);
#pragma unroll
        for (int r = 4; r < 16; r += 4) { cm0 = max3f(cm0, a0[r], a0[r + 1]); cm1 = max3f(cm1, a0[r + 2], a0[r + 3]); cm0 = max3f(cm0, a1[r], a1[r + 1]); cm1 = max3f(cm1, a1[r + 2], a1[r + 3]); }
        float cm = max3f(cm0, cm1, cm1);
        cm = fmaxf(cm, __shfl_xor(cm, 32));
        constexpr float L2E = 1.4426950408889634f;
        const float mn = fmaxf(R.mx, cm), f = __builtin_amdgcn_exp2f((R.mx - mn) * L2E), mnl = mn * L2E;
        R.mx = mn; R.l *= f;
#pragma unroll
        for (int r = 0; r < 16; ++r) { R.o0[r] *= f; R.o1[r] *= f; }
        float ls = 0.f;
#pragma unroll
        for (int r = 0; r < 16; ++r) { a0[r] = __builtin_amdgcn_exp2f(fmaf(a0[r], L2E, -mnl)); ls += a0[r]; }
        bf16x8 pa0, pa1;
        pack_p(a0, pa0, pa1);
        R.o0 = mfma32(tfrag(VT, 256, 2 * kt, 0, lane), pa0, R.o0); R.o1 = mfma32(tfrag(VT, 256, 2 * kt, 1, lane), pa0, R.o1);
        R.o0 = mfma32(tfrag(VT, 256, 2 * kt + 1, 0, lane), pa1, R.o0); R.o1 = mfma32(tfrag(VT, 256, 2 * kt + 1, 1, lane), pa1, R.o1);
        if (two) {
#pragma unroll
            for (int r = 0; r < 16; ++r) { a1[r] = __builtin_amdgcn_exp2f(fmaf(a1[r], L2E, -mnl)); ls += a1[r]; }
            pack_p(a1, pa0, pa1);
            R.o0 = mfma32(tfrag(VT, 256, 2 * kt + 2, 0, lane), pa0, R.o0); R.o1 = mfma32(tfrag(VT, 256, 2 * kt + 2, 1, lane), pa0, R.o1);
            R.o0 = mfma32(tfrag(VT, 256, 2 * kt + 3, 0, lane), pa1, R.o0); R.o1 = mfma32(tfrag(VT, 256, 2 * kt + 3, 1, lane), pa1, R.o1);
        }
        R.l += ls;
    }
    R.l += __shfl_xor(R.l, 32);
    return R;
}
constexpr int PAST_NITEMS = 32 * 120;
__device__ __forceinline__ void past_item_decode(int it, int& bh, int& n, int& o) { bh = it / 120; int pr = it % 120; n = 0; while (pr >= 15 - n) { pr -= 15 - n; ++n; } o = n + 1 + pr; }
__device__ __forceinline__ void attn_past_items(Frame& F, const LAS int* bucket) {
    LAS unsigned char* KR = F.lds + RING_OFF; LAS unsigned char* VT = F.lds + RING_OFF + 32768;
    LAS int* S = (LAS int*)(F.lds + RING_OFF + 65536);
    LAS int* C = S + 4096;
    LAS int* wsum = C + 4096;
    const int lane = F.lane, tl = lane & 31, hi = lane >> 5;
    const int* cntg = (const int*)(F.ws + WS_CNT);
    __syncthreads();
    {
        int cc[8] = {0, 0, 0, 0, 0, 0, 0, 0};
        if (8 * F.tid < PAST_NITEMS) { const int4 a = *(const int4*)(cntg + 8 * F.tid), bq = *(const int4*)(cntg + 8 * F.tid + 4); cc[0] = a.x; cc[1] = a.y; cc[2] = a.z; cc[3] = a.w; cc[4] = bq.x; cc[5] = bq.y; cc[6] = bq.z; cc[7] = bq.w; }
        int g[8], tot = 0;
#pragma unroll
        for (int k = 0; k < 8; ++k) { g[k] = (cc[k] + 31) >> 5; tot += g[k]; }
        int x = tot;
#pragma unroll
        for (int o = 1; o < 64; o <<= 1) { const int y = __shfl_up(x, o); if (lane >= o) x += y; }
        if (lane == 63) wsum[F.wave] = x;
        __syncthreads();
        int base = x - tot;
#pragma unroll
        for (int w = 0; w < 8; ++w) if (w < F.wave) base += wsum[w];
#pragma unroll
        for (int k = 0; k < 8; ++k) { const int it = 8 * F.tid + k; if (it < PAST_NITEMS) { S[it] = base; C[it] = cc[k]; } base += g[k]; }
        if (F.tid == 511) S[PAST_NITEMS] = base;
        __syncthreads();
    }
    const int T = S[PAST_NITEMS];
    const int lo = (int)(((long long)T * blockIdx.x) / F.G), hiG = (int)(((long long)T * (blockIdx.x + 1)) / F.G);
    int it = 0;
    { int a = 0, b = PAST_NITEMS; while (b - a > 1) { const int m = (a + b) >> 1; if (S[m] <= lo) a = m; else b = m; } it = a; }
    while (lo < hiG && it < PAST_NITEMS && S[it] < hiG) {
        if (S[it + 1] == S[it] || S[it + 1] <= lo) { ++it; continue; }
        int bh, n, o0; past_item_decode(it, bh, n, o0);
        const int b = bh >> 3, h = bh & 7;
        const int run_end_item = it + (15 - o0) + 1;
        const int ra = S[it] > lo ? S[it] : lo;
        int rbx = S[run_end_item < PAST_NITEMS ? run_end_item : PAST_NITEMS]; const int rb = rbx < hiG ? rbx : hiG;
        int wi = it;
        int gamma = ra + F.wave;
        int p_dst = -1, p_tl = 0, p_o = 0; bf16x8 pq[4] = {};
        int r_dst = -1, r_tl = 0, r_o = 0; bf16x8 rq[4] = {};
#define PAST_FETCH(G_, DST_, TL_, O_, Q_) do { while (S[wi + 1] <= (G_)) ++wi; const int o_ = o0 + (wi - it); const int c_ = C[wi]; \
            const int qi_ = 32 * ((G_) - S[wi]) + tl; const bool v_ = qi_ < c_; const size_t e_ = (size_t)wi * 256 + (v_ ? qi_ : 0); \
            const unsigned ent_ = ((const unsigned short*)(F.ws + WS_LIST))[e_]; \
            const bf16* qp_ = (const bf16*)(F.ws + WS_QG) + e_ * 64 + 8 * hi; \
            _Pragma("unroll") for (int s_ = 0; s_ < 4; ++s_) (Q_)[s_] = *(const bf16x8*)(qp_ + 16 * s_); \
            (TL_) = ent_ & 255; (O_) = o_; (DST_) = v_ ? (((b * SEQ + o_ * 256 + (int)(ent_ & 255)) * AH + h) * 3 + (int)(ent_ >> 8)) : -1; } while (0)
        if (gamma < rb) PAST_FETCH(gamma, p_dst, p_tl, p_o, pq);
        if (gamma + 8 < rb) PAST_FETCH(gamma + 8, r_dst, r_tl, r_o, rq);
        __syncthreads();
        const LAS float* lut = LUT8(F) + h * 132;
        stage_kv64(F, SEG_AK(F) + (size_t)(b * SEQ + n * 256) * AW + h * AD, SEG_AV(F) + (size_t)(b * SEQ + n * 256) * AW + h * AD, KR, VT);
        __syncthreads();
#if (PROBE_MASK >> 22) & 1
        stage_kv64(F, SEG_AK(F) + (size_t)(b * SEQ + n * 256) * AW + h * AD, SEG_AV(F) + (size_t)(b * SEQ + n * 256) * AW + h * AD, KR, VT);
        __syncthreads();
#endif
        const float b31 = lut[128];
        while (gamma < rb) {
            const int dst = p_dst, t_local = p_tl; const bool adj = (p_o == n + 1);
            bf16x8 qf[4] = {pq[0], pq[1], pq[2], pq[3]};
            p_dst = r_dst; p_tl = r_tl; p_o = r_o; pq[0] = rq[0]; pq[1] = rq[1]; pq[2] = rq[2]; pq[3] = rq[3];
            if (gamma + 16 < rb) PAST_FETCH(gamma + 16, r_dst, r_tl, r_o, rq);
#if PROBE_T == 140 || PROBE_T == 340
            const unsigned long long tq0_ = __builtin_amdgcn_s_memrealtime();
#endif
            AttnOut R = wave_attend<false>(KR, VT, qf, lane, 8, 256 + t_local, adj, 4, lut, b31);
#if PROBE_T == 140 || PROBE_T == 340
            { asm volatile("" :: "v"(R.l), "v"(R.o0[0]), "v"(R.o1[15])); const unsigned dt_ = (unsigned)(__builtin_amdgcn_s_memrealtime() - tq0_);
              if (lane == 0) { if (PROBE_T == 340) __hip_atomic_fetch_max((unsigned*)(F.ctl + 20001), 1000000u - dt_, __ATOMIC_RELAXED, __HIP_MEMORY_SCOPE_AGENT); else __hip_atomic_fetch_max((unsigned*)(F.ctl + 20000), dt_, __ATOMIC_RELAXED, __HIP_MEMORY_SCOPE_AGENT); } }
#endif
#if (PROBE_MASK >> 21) & 1
            asm volatile("" ::: "memory"); R = wave_attend<false>(KR, VT, qf, lane, 8, 256 + t_local, adj, 4, lut, b31);
#endif
            if (dst >= 0) {
                if (hi == 0) { float* ps = (float*)(F.ws + WS_PARTS) + (size_t)dst * 2; ps[0] = R.mx; ps[1] = R.l; }
                const float rl = 1.f / R.l;
                bf16* po = (bf16*)(F.ws + WS_PARTO) + (size_t)dst * 64 + 4 * hi;
#pragma unroll
                for (int g = 0; g < 4; ++g) {
                    *(unsigned long long*)(po + 8 * g) = (unsigned long long)pk2(R.o0[4 * g] * rl, R.o0[4 * g + 1] * rl) | ((unsigned long long)pk2(R.o0[4 * g + 2] * rl, R.o0[4 * g + 3] * rl) << 32);
                    *(unsigned long long*)(po + 32 + 8 * g) = (unsigned long long)pk2(R.o1[4 * g] * rl, R.o1[4 * g + 1] * rl) | ((unsigned long long)pk2(R.o1[4 * g + 2] * rl, R.o1[4 * g + 3] * rl) << 32);
                }
            }
            gamma += 8;
        }
#undef PAST_FETCH
        it = run_end_item;
    }
    __syncthreads();
}
struct OwnLoads { bf16x8 qf[4]; float pm[3], pl[3]; unsigned long long pw0[3][4], pw1[3][4]; };
__device__ __forceinline__ void own_group_load(Frame& F, int b, int h, int o, int grp, OwnLoads& L) {
    const int lane = F.lane, tl = lane & 31, hi = lane >> 5;
    const int row = b * SEQ + o * 256 + 32 * grp + tl;
    { const bf16* qp = SEG_AQ(F) + (size_t)row * AW + h * AD + 8 * hi;
#pragma unroll
      for (int s = 0; s < 4; ++s) L.qf[s] = *(const bf16x8*)(qp + 16 * s); }
    const int np = o < 3 ? o : 3;
    const float* ps = (const float*)(F.ws + WS_PARTS) + (size_t)(row * AH + h) * 6;
    const bf16* po = (const bf16*)(F.ws + WS_PARTO) + (size_t)(row * AH + h) * 3 * 64 + 4 * hi;
#pragma unroll
    for (int j = 0; j < 3; ++j) {
        if (j < np) { L.pm[j] = ps[2 * j]; L.pl[j] = ps[2 * j + 1];
#pragma unroll
            for (int g = 0; g < 4; ++g) { L.pw0[j][g] = *(const unsigned long long*)(po + j * 64 + 8 * g); L.pw1[j][g] = *(const unsigned long long*)(po + j * 64 + 32 + 8 * g); } }
        else { L.pm[j] = -INFINITY; L.pl[j] = 0.f;
#pragma unroll
            for (int g = 0; g < 4; ++g) { L.pw0[j][g] = 0ull; L.pw1[j][g] = 0ull; } }
    }
}
__device__ __forceinline__ void own_group_compute(Frame& F, const LAS unsigned char* KR, const LAS unsigned char* VT, const LAS float* lut, int b, int h, int o, int grp, const OwnLoads& L) {
    const int lane = F.lane, tl = lane & 31, hi = lane >> 5;
    const int t_local = 32 * grp + tl, row = b * SEQ + o * 256 + t_local, np = o < 3 ? o : 3;
    AttnOut R = wave_attend<true>(KR, VT, L.qf, lane, grp + 1, t_local, true, 0, lut, 0.f);
    float mt = R.mx;
#pragma unroll
    for (int j = 0; j < 3; ++j) mt = fmaxf(mt, L.pm[j]);
    const float e_own = __expf(R.mx - mt); float aj[3], Ls = e_own * R.l;
#pragma unroll
    for (int j = 0; j < 3; ++j) { aj[j] = (j < np) ? __expf(L.pm[j] - mt) * L.pl[j] : 0.f; Ls += aj[j]; }
    const float rL = 1.f / Ls, a_own = e_own * rL;
#pragma unroll
    for (int j = 0; j < 3; ++j) aj[j] *= rL;
    bf16* mp = F.MIX + (size_t)row * D + h * AD + 4 * hi;
#pragma unroll
    for (int g = 0; g < 4; ++g) {
        float v0[4], v1[4];
#pragma unroll
        for (int i = 0; i < 4; ++i) { v0[i] = R.o0[4 * g + i] * a_own; v1[i] = R.o1[4 * g + i] * a_own; }
#pragma unroll
        for (int j = 0; j < 3; ++j) {
#pragma unroll
            for (int i = 0; i < 4; ++i) { v0[i] += aj[j] * bf2f((unsigned short)(L.pw0[j][g] >> (16 * i))); v1[i] += aj[j] * bf2f((unsigned short)(L.pw1[j][g] >> (16 * i))); }
        }
        *(unsigned long long*)(mp + 8 * g) = (unsigned long long)pk2(v0[0], v0[1]) | ((unsigned long long)pk2(v0[2], v0[3]) << 32);
        *(unsigned long long*)(mp + 32 + 8 * g) = (unsigned long long)pk2(v1[0], v1[1]) | ((unsigned long long)pk2(v1[2], v1[3]) << 32);
    }
}
__device__ __forceinline__ void attn_own_pair(Frame& F, const LAS int* bucket, int ua, int ub) {
    const int bha = ua >> 4, oa = ua & 15, ba = bha >> 3, ha = bha & 7, bhb = ub >> 4, ob = ub & 15, bb = bhb >> 3, hb = bhb & 7;
    LAS unsigned char* KA = F.lds + RING_OFF; LAS unsigned char* VA = KA + 32768; LAS unsigned char* KB = KA + 65536; LAS unsigned char* VB = KA + 98304;
    const LAS float* lutA = LUT8(F) + ha * 132; const LAS float* lutB = LUT8(F) + hb * 132;
    __syncthreads();
    OwnLoads LA; own_group_load(F, ba, ha, oa, F.wave, LA);
    {
        const bf16* ka = SEG_AK(F) + (size_t)(ba * SEQ + oa * 256) * AW + ha * AD; const bf16* va = SEG_AV(F) + (size_t)(ba * SEQ + oa * 256) * AW + ha * AD;
        const bf16* kb = SEG_AK(F) + (size_t)(bb * SEQ + ob * 256) * AW + hb * AD; const bf16* vb = SEG_AV(F) + (size_t)(bb * SEQ + ob * 256) * AW + hb * AD;
        v4u x[16];
#pragma unroll
        for (int i = 0; i < 4; ++i) { const int piece = F.tid + 512 * i, key = piece >> 3, ch = piece & 7; const size_t off = (size_t)key * AW + 8 * ch;
            x[4 * i] = *(const v4u*)(ka + off); x[4 * i + 1] = *(const v4u*)(va + off); x[4 * i + 2] = *(const v4u*)(kb + off); x[4 * i + 3] = *(const v4u*)(vb + off); }
        asm volatile("" : "+v"(x[0]), "+v"(x[1]), "+v"(x[2]), "+v"(x[3]), "+v"(x[4]), "+v"(x[5]), "+v"(x[6]), "+v"(x[7]));
        asm volatile("" : "+v"(x[8]), "+v"(x[9]), "+v"(x[10]), "+v"(x[11]), "+v"(x[12]), "+v"(x[13]), "+v"(x[14]), "+v"(x[15]));
#pragma unroll
        for (int i = 0; i < 4; ++i) { const int piece = F.tid + 512 * i, key = piece >> 3, ch = piece & 7;
            const int ko = ch * (256 * 16) + key * 16, vo = (ch >> 2) * (256 * 64) + key * 64 + (ch & 3) * 16;
            *(LAS v4u*)(KA + ko) = x[4 * i]; *(LAS v4u*)(VA + vo) = x[4 * i + 1]; *(LAS v4u*)(KB + ko) = x[4 * i + 2]; *(LAS v4u*)(VB + vo) = x[4 * i + 3]; }
    }
    __syncthreads();
    OwnLoads LB; own_group_load(F, bb, hb, ob, 7 - F.wave, LB);
    own_group_compute(F, KA, VA, lutA, ba, ha, oa, F.wave, LA);
    own_group_compute(F, KB, VB, lutB, bb, hb, ob, 7 - F.wave, LB);
}
constexpr size_t WS_SELS = 538 * MiB;
constexpr size_t WS_PARTOS = 539 * MiB;
constexpr size_t WS_PARTSS = 540 * MiB;
constexpr size_t WS_KSUMP = 541 * MiB;
constexpr size_t WS_SITEMS = 545 * MiB;
constexpr size_t WS_END4 = 546 * MiB;
constexpr int CW_SITEMS = 8192;
__device__ __forceinline__ void sample_select(Frame& F) {
    LAS unsigned* um = (LAS unsigned*)(F.lds + RING_OFF);
    const int lane = F.lane, n = lane & 31, st = 2 * F.wave + (lane >> 5);
    for (int pr = blockIdx.x; pr < DB * AH; pr += F.G) {
        const int sb = pr >> 3, h = pr & 7;
        __syncthreads();
        if (F.tid == 0) um[0] = 0u;
        __syncthreads();
        if (F.wave < 4) {
            const int m = MP + sb * DS + st;
            v4u qw[8]; f32x4 ka[16], kb[16];
            { const v4u* qp = (const v4u*)(SEG_AQ(F) + (size_t)m * AW + h * AD);
#pragma unroll
              for (int c = 0; c < 8; ++c) qw[c] = qp[c]; }
            { const f32x4* k0 = (const f32x4*)((const float*)(F.ws + WS_KSUMP) + ((size_t)(sb * NPAGES + 2 * n)) * AW + h * AD); const f32x4* k1 = k0 + AW / 4;
#pragma unroll
              for (int c = 0; c < 16; ++c) { ka[c] = k0[c]; kb[c] = k1[c]; } }
            float s = 0.f;
#pragma unroll
            for (int c = 0; c < 8; ++c) { const unsigned ww[4] = {qw[c].x, qw[c].y, qw[c].z, qw[c].w};
                const f32x4 a0 = ka[2 * c] + kb[2 * c], a1 = ka[2 * c + 1] + kb[2 * c + 1];
                s += __builtin_bit_cast(float, ww[0] << 16) * a0.x + __builtin_bit_cast(float, ww[0] & 0xffff0000u) * a0.y + __builtin_bit_cast(float, ww[1] << 16) * a0.z + __builtin_bit_cast(float, ww[1] & 0xffff0000u) * a0.w
                   + __builtin_bit_cast(float, ww[2] << 16) * a1.x + __builtin_bit_cast(float, ww[2] & 0xffff0000u) * a1.y + __builtin_bit_cast(float, ww[3] << 16) * a1.z + __builtin_bit_cast(float, ww[3] & 0xffff0000u) * a1.w; }
            int sel[3]; unsigned mask = 0u;
#pragma unroll
            for (int j = 0; j < 3; ++j) {
                float v = s; int bn = n;
#pragma unroll
                for (int o = 1; o < 32; o <<= 1) { const float ov = __shfl_xor(v, o); const int on = __shfl_xor(bn, o); if (ov > v || (ov == v && on < bn)) { v = ov; bn = on; } }
                sel[j] = bn; mask |= 1u << bn;
                if (bn == n) s = -INFINITY;
            }
            if (n == 0) { int* so = (int*)(F.ws + WS_SELS) + (size_t)((sb * DS + st) * AH + h) * 3; so[0] = sel[0]; so[1] = sel[1]; so[2] = sel[2];
                __hip_atomic_fetch_or(um, mask, __ATOMIC_RELAXED, __HIP_MEMORY_SCOPE_WORKGROUP); }
        }
        __syncthreads();
        if (F.wave == 0) {
            const unsigned mask = um[0];
            unsigned base = 0u;
            if (lane == 0) base = __hip_atomic_fetch_add((unsigned*)(F.ctl + CW_SITEMS), (unsigned)__popc(mask), __ATOMIC_RELAXED, __HIP_MEMORY_SCOPE_AGENT);
            base = __shfl(base, 0);
            if (lane < 32 && ((mask >> lane) & 1u)) ((int*)(F.ws + WS_SITEMS))[base + __popc(mask & ((1u << lane) - 1u))] = (sb << 8) | (h << 5) | lane;
        }
    }
    __syncthreads();
}
struct KvRegs { f32x4 a[11], b[11]; };
__device__ __forceinline__ void load_kv64_paged(Frame& F, int sb, int n, int h, KvRegs& R) {
    const int pg0 = F.page_table[sb * NPAGES + 2 * n], pg1 = F.page_table[sb * NPAGES + 2 * n + 1];
    const int lt = F.tid - 128;
#pragma unroll
    for (int i = 0; i < 11; ++i) {
        const int piece = lt + 384 * i;
        if (i < 10 || piece < 4096) {
            const int idx = piece & 2047, key = idx >> 3, ch = idx & 7;
            const float* base = (piece < 2048) ? F.cache_k : F.cache_v;
            const float* src = base + ((size_t)((key < PAGE) ? pg0 : pg1) * PAGE + (key & (PAGE - 1))) * AW + h * AD + 8 * ch;
            R.a[i] = __builtin_nontemporal_load((const f32x4*)src); R.b[i] = __builtin_nontemporal_load((const f32x4*)(src + 4));
        }
    }
}
__device__ __forceinline__ void store_kv64_tiles(Frame& F, const KvRegs& R, LAS unsigned char* KR, LAS unsigned char* VT) {
    const int lt = F.tid - 128;
#pragma unroll
    for (int i = 0; i < 11; ++i) {
        const int piece = lt + 384 * i;
        if (i < 10 || piece < 4096) {
            const int idx = piece & 2047, key = idx >> 3, ch = idx & 7;
            const f32x4 x0 = R.a[i], x1 = R.b[i];
            v4u w; w.x = pk2(x0.x, x0.y); w.y = pk2(x0.z, x0.w); w.z = pk2(x1.x, x1.y); w.w = pk2(x1.z, x1.w);
            LAS unsigned char* dst = (piece < 2048) ? KR + ch * (256 * 16) + key * 16 : VT + (ch >> 2) * (256 * 64) + key * 64 + (ch & 3) * 16;
            *(LAS v4u*)dst = w;
        }
    }
}
__device__ __forceinline__ void sample_past_items(Frame& F, const LAS int* bucket) {
    LAS float* tab = (LAS float*)(F.lds + ML_TAB_OFF);
    const int lane = F.lane, tl = lane & 31, hi = lane >> 5;
    const int L = (int)__hip_atomic_load((unsigned*)(F.ctl + CW_SITEMS), __ATOMIC_RELAXED, __HIP_MEMORY_SCOPE_AGENT);
    const int* items = (const int*)(F.ws + WS_SITEMS);
    const int* sels = (const int*)(F.ws + WS_SELS);
    int idx = blockIdx.x, cur = 0;
#define ITEM_AT(k) items[idx + (k) * F.G]
#define HAS(k) (idx + (k) * F.G < L)
#define LOADER_STEP(RX) do { if (HAS(1)) { \
            LAS unsigned char* kb_ = F.lds + RING_OFF + (cur ^ 1) * 65536; store_kv64_tiles(F, RX, kb_, kb_ + 32768); \
            if (HAS(3)) { const int i3_ = ITEM_AT(3); load_kv64_paged(F, i3_ >> 8, i3_ & 31, (i3_ >> 5) & 7, RX); } } \
        __syncthreads(); cur ^= 1; idx += F.G; } while (0)
    __syncthreads();
    if (F.wave >= 2) {
        KvRegs RA, RB;
        if (HAS(0)) {
            const int it = ITEM_AT(0);
            load_kv64_paged(F, it >> 8, it & 31, (it >> 5) & 7, RA); store_kv64_tiles(F, RA, F.lds + RING_OFF, F.lds + RING_OFF + 32768);
            if (HAS(1)) { const int i1 = ITEM_AT(1); load_kv64_paged(F, i1 >> 8, i1 & 31, (i1 >> 5) & 7, RA); }
            if (HAS(2)) { const int i2 = ITEM_AT(2); load_kv64_paged(F, i2 >> 8, i2 & 31, (i2 >> 5) & 7, RB); }
        }
        __syncthreads();
        while (idx < L) { LOADER_STEP(RA); if (idx >= L) break; LOADER_STEP(RB); }
    } else {
        int pj = -1, pst = 0; bf16x8 pq[4] = {};
#define SAMPLE_ITEM_QUERY(IT, J, ST, QF) do { const int n_ = (IT) & 31, h_ = ((IT) >> 5) & 7, sb_ = (IT) >> 8; int j_ = -1; \
        if (tl < 8) { const int* sp = sels + (size_t)((sb_ * DS + tl) * AH + h_) * 3; j_ = (sp[0] == n_) ? 0 : ((sp[1] == n_) ? 1 : ((sp[2] == n_) ? 2 : -1)); } \
        const unsigned long long bal_ = __ballot(j_ >= 0); (J) = j_; (ST) = (j_ >= 0) ? tl : ((int)(__ffsll((unsigned long long)bal_) - 1) & 7); \
        const bf16* qp_ = SEG_AQ(F) + (size_t)(MP + sb_ * DS + (ST)) * AW + h_ * AD + 8 * hi; \
        _Pragma("unroll") for (int s_ = 0; s_ < 4; ++s_) (QF)[s_] = *(const bf16x8*)(qp_ + 16 * s_); } while (0)
        LAS float* hand = tab + ML_WSC;
        volatile LAS int* flag = (volatile LAS int*)(tab + ML_WSC + 1160);
        if (HAS(0)) { const int it = ITEM_AT(0); SAMPLE_ITEM_QUERY(it, pj, pst, pq); }
        if (F.tid == 0) flag[0] = 0;
        __syncthreads();
        int seq = 0;
        for (; idx < L; idx += F.G) {
            const int it = ITEM_AT(0), n = it & 31, h = (it >> 5) & 7, sb = it >> 8;
            const LAS unsigned char* KR = F.lds + RING_OFF + cur * 65536; const LAS unsigned char* VT = KR + 32768; const LAS float* lut = LUT8(F) + h * 132;
            const int j = pj, st = pst; const bool valid = j >= 0;
            bf16x8 qf[4] = {pq[0], pq[1], pq[2], pq[3]};
            if (HAS(1)) { const int i1 = ITEM_AT(1); SAMPLE_ITEM_QUERY(i1, pj, pst, pq); }
            ++seq;
            AttnOut O = wave_attend<false>(KR, VT, qf, lane, 4 + 4 * F.wave, 256 + st, n == NBLK_S - 1, 4, lut, lut[128], 4 * F.wave);
            LAS float* hp = hand + (seq & 1) * 576 + ((lane >> 5) * 8 + (tl & 7)) * 36;
            if (F.wave == 1) {
                if (tl < 8) { hp[0] = O.mx; hp[1] = O.l;
#pragma unroll
                    for (int r = 0; r < 16; ++r) { hp[2 + r] = O.o0[r]; hp[18 + r] = O.o1[r]; } }
                asm volatile("s_waitcnt lgkmcnt(0)" ::: "memory");
                if (lane == 0) flag[0] = seq;
            } else {
                while (flag[0] < seq) __builtin_amdgcn_s_sleep(1);
                asm volatile("" ::: "memory");
                if (valid) {
                    const float m1 = hp[0], l1 = hp[1], mt = fmaxf(O.mx, m1), f0 = __expf(O.mx - mt), f1 = __expf(m1 - mt), lt_ = O.l * f0 + l1 * f1;
                    const size_t dst = (size_t)((sb * DS + st) * AH + h) * 3 + j;
                    if (hi == 0) { float* ps = (float*)(F.ws + WS_PARTSS) + dst * 2; ps[0] = mt; ps[1] = lt_; }
                    const float rl = 1.f / lt_, g0 = f0 * rl, g1 = f1 * rl;
                    bf16* po = (bf16*)(F.ws + WS_PARTOS) + dst * 64 + 4 * hi;
#pragma unroll
                    for (int g = 0; g < 4; ++g) {
                        float a[4], b[4];
#pragma unroll
                        for (int i = 0; i < 4; ++i) { a[i] = O.o0[4 * g + i] * g0 + hp[2 + 4 * g + i] * g1; b[i] = O.o1[4 * g + i] * g0 + hp[18 + 4 * g + i] * g1; }
                        *(unsigned long long*)(po + 8 * g) = (unsigned long long)pk2(a[0], a[1]) | ((unsigned long long)pk2(a[2], a[3]) << 32);
                        *(unsigned long long*)(po + 32 + 8 * g) = (unsigned long long)pk2(b[0], b[1]) | ((unsigned long long)pk2(b[2], b[3]) << 32);
                    }
                }
            }
            __syncthreads();
            cur ^= 1;
        }
#undef SAMPLE_ITEM_QUERY
    }
#undef LOADER_STEP
#undef ITEM_AT
#undef HAS
    __syncthreads();
}
__device__ __forceinline__ void sample_own_merge(Frame& F, const LAS int* bucket) {
    const int gw = blockIdx.x * NWAVES + F.wave, NGW = F.G * NWAVES, d = F.lane;
    for (int idx = gw; idx < MS * AH; idx += NGW) {
        const int r = idx >> 3, h = idx & 7, sb = r >> 3, st = r & 7, m = MP + r;
        const float q = bf2f(SEG_AQ(F)[(size_t)m * AW + h * AD + d]);
        float s[8], vv[8];
#pragma unroll
        for (int p = 0; p < 8; ++p) { const size_t off = ((size_t)(MP + sb * DS + p)) * AW + h * AD + d; s[p] = q * bf2f(SEG_AK(F)[off]); vv[p] = bf2f(SEG_AV(F)[off]); }
#pragma unroll
        for (int p = 0; p < 8; ++p) { s[p] = wave_sum(s[p]); s[p] = (p <= st) ? s[p] + LUT8(F)[h * 132 + ((st - p) & 7)] : -INFINITY; }
        float mx = s[0];
#pragma unroll
        for (int p = 1; p < 8; ++p) mx = fmaxf(mx, s[p]);
        float l = 0.f, o = 0.f;
#pragma unroll
        for (int p = 0; p < 8; ++p) { const float pw = __expf(s[p] - mx); l += pw; o += pw * vv[p]; }
        const float* ps = (const float*)(F.ws + WS_PARTSS) + (size_t)idx * 6;
        float mt = mx; float pm[3], pl[3];
#pragma unroll
        for (int j = 0; j < 3; ++j) { pm[j] = ps[2 * j]; pl[j] = ps[2 * j + 1]; mt = fmaxf(mt, pm[j]); }
        const float e_own = __expf(mx - mt); float aj[3], L = e_own * l;
#pragma unroll
        for (int j = 0; j < 3; ++j) { aj[j] = __expf(pm[j] - mt) * pl[j]; L += aj[j]; }
        const float rL = 1.f / L;
        const bf16* po = (const bf16*)(F.ws + WS_PARTOS) + (size_t)idx * 3 * 64 + d;
        F.MIX[(size_t)m * D + h * AD + d] = (bf16)f2bf(rL * (o * e_own + aj[0] * bf2f(po[0]) + aj[1] * bf2f(po[64]) + aj[2] * bf2f(po[128])));
    }
}

template <int BATCH, class Epi>
__device__ __forceinline__ void skinny_gemm(Frame& F, const bf16* A, int lda, const bf16* Wt, int ldw, int ntile, int K, const Epi& E) {
    const int lane = F.lane, r = lane & 31, hi = lane >> 5, kw = K / 8;
    LAS float* red = (LAS float*)(F.lds + RING_OFF);
    for (int u = blockIdx.x; u < 8 * ntile; u += F.G) {
        const int rg = u & 7, ct = u >> 3, k0 = F.wave * kw;
        const bf16* ap = A + (size_t)(32 * rg + r) * lda + k0 + 8 * hi;
        const bf16* bp = Wt + (size_t)(32 * ct + r) * ldw + k0 + 8 * hi;
        f32x16 acc = {};
        for (int s = 0; s < kw / 16; s += BATCH) {
            bf16x8 af[BATCH], bfr[BATCH];
#pragma unroll
            for (int i = 0; i < BATCH; ++i) { af[i] = *(const bf16x8*)(ap + 16 * (s + i)); bfr[i] = *(const bf16x8*)(bp + 16 * (s + i)); }
#pragma unroll
            for (int i = 0; i < BATCH; ++i) acc = mfma32(af[i], bfr[i], acc);
        }
        __syncthreads();
#pragma unroll
        for (int i = 0; i < 16; ++i) red[(F.wave * 16 + i) * 64 + lane] = acc[i];
        __syncthreads();
#pragma unroll
        for (int q = 0; q < 2; ++q) {
            const int e = F.tid + 512 * q; float s = 0.f;
#pragma unroll
            for (int w = 0; w < 8; ++w) s += red[w * 1024 + e];
            const int reg = e >> 6, ln = e & 63;
            E(s, 32 * rg + crow(reg, ln >> 5), 32 * ct + (ln & 31));
        }
    }
    __syncthreads();
}
struct SkResid { const float* xs; float* x1; __device__ __forceinline__ void operator()(float s, int row, int col) const { x1[(size_t)(MP + row) * D + col] = xs[(size_t)row * D + col] + s; } };
struct SkAccum { float* x1; __device__ __forceinline__ void operator()(float s, int row, int col) const { float* p = x1 + (size_t)(MP + row) * D + col; *p = *p + s; } };
struct SkRelu2U { bf16* U; __device__ __forceinline__ void operator()(float s, int row, int col) const { const float a = fmaxf(s, 0.f); U[(size_t)(MP + row) * FF + col] = (bf16)f2bf(a * a); } };

__device__ __forceinline__ void skinny_up4(Frame& F) {
    const int lane = F.lane, r = lane & 31, hi = lane >> 5, kw = D / 8;
    LAS float* red = (LAS float*)(F.lds + RING_OFF);
    const bf16* A = F.XN + (size_t)MP * D;
    for (int u = blockIdx.x; u < 8 * (FF / 128); u += F.G) {
        const int rg = u & 7, c4 = u >> 3, k0 = F.wave * kw;
        const bf16* ap = A + (size_t)(32 * rg + r) * D + k0 + 8 * hi;
        bf16x8 af[8];
#pragma unroll
        for (int i = 0; i < 8; ++i) af[i] = *(const bf16x8*)(ap + 16 * i);
        f32x16 acc[4];
#pragma unroll
        for (int t = 0; t < 4; ++t) {
            const bf16* bp = F.Wup_t + (size_t)(32 * (4 * c4 + t) + r) * D + k0 + 8 * hi;
            bf16x8 bfr[8];
#pragma unroll
            for (int i = 0; i < 8; ++i) bfr[i] = *(const bf16x8*)(bp + 16 * i);
            acc[t] = (f32x16){};
#pragma unroll
            for (int i = 0; i < 8; ++i) acc[t] = mfma32(af[i], bfr[i], acc[t]);
        }
        __syncthreads();
#pragma unroll
        for (int t = 0; t < 4; ++t)
#pragma unroll
            for (int i = 0; i < 16; ++i) red[((t * 8 + F.wave) * 16 + i) * 64 + lane] = acc[t][i];
        __syncthreads();
#pragma unroll
        for (int q = 0; q < 8; ++q) {
            const int e4 = F.tid + 512 * q, t = e4 >> 10, e = e4 & 1023; float s = 0.f;
#pragma unroll
            for (int w = 0; w < 8; ++w) s += red[(t * 8 + w) * 1024 + e];
            const int reg = e >> 6, ln = e & 63; const float a = fmaxf(s, 0.f);
            F.U[(size_t)(MP + 32 * rg + crow(reg, ln >> 5)) * FF + 32 * (4 * c4 + t) + (ln & 31)] = (bf16)f2bf(a * a);
        }
    }
    __syncthreads();
}

__device__ __forceinline__ void sample_ffn_norm(Frame& F) {
    for (int u = blockIdx.x; u < 8 * (FF / 128); u += F.G) {
        const int rg = u & 7;
#pragma unroll
        for (int i = 0; i < 4; ++i) {
            const int r = 32 * rg + 4 * F.wave + i;
            f32x4 v[4]; load_row(F.X1 + (size_t)(MP + r) * D, F.lane, v);
            rms_row_to_bf16<false>(F, v, F.norm_ffn, F.XN + (size_t)(MP + r) * D, MP + r);
        }
    }
    asm volatile("s_waitcnt vmcnt(0)" ::: "memory");
    __syncthreads();
}

#ifndef MK_ONE_LAUNCH
#define MK_ONE_LAUNCH 1
#endif
constexpr int N_PHASES = 11;
struct Args { const void* in[19]; float* out; unsigned char* ws; int ph_lo, ph_hi; };
static_assert(sizeof(Args) == 19 * 8 + 8 + 8 + 8, "Args has no padding bytes");
__global__ void __launch_bounds__(NWAVES * 64, 2) hymba_fwd(Args args) {
    extern __shared__ __attribute__((aligned(16))) unsigned char lds[];
    Frame F;
    F.lds = (LAS unsigned char*)lds;
    F.MISC = (volatile LAS unsigned*)(F.lds + MISC_OFF);
    F.tid = threadIdx.x; F.lane = F.tid & 63; F.wave = __builtin_amdgcn_readfirstlane(F.tid >> 6);
    F.G = gridDim.x; { const int bx = blockIdx.x; F.vcu = (F.G % 8 == 0) ? (bx % 8) * (F.G / 8) + bx / 8 : bx; }
    unsigned char* ws = args.ws; F.ws = ws;
    F.ctl = (gu32*)(ws + WS_CTL);
    F.xp = (const float*)args.in[0]; F.xs = (const float*)args.in[1]; F.cache_k = (const float*)args.in[2]; F.cache_v = (const float*)args.in[3];
    F.state_C = (const float*)args.in[4]; F.state_n = (const float*)args.in[5]; F.state_m = (const float*)args.in[6]; F.page_table = (const int*)args.in[7];
    F.rel_bias = (const float*)args.in[8]; F.norm_mix = (const float*)args.in[9]; F.w_in = (const float*)args.in[10]; F.b_ig = (const float*)args.in[11];
    F.b_fg = (const float*)args.in[12]; F.ml_norm = (const float*)args.in[13]; F.w_out = (const float*)args.in[14]; F.norm_ffn = (const float*)args.in[15];
    F.w_up = (const float*)args.in[16]; F.w_down = (const float*)args.in[17]; F.norm_final = (const float*)args.in[18];
    F.out = args.out;
    F.Win_t = (bf16*)(ws + WS_WIN); F.Wout_t = (bf16*)(ws + WS_WOUT); F.Wup_t = (bf16*)(ws + WS_WUP); F.Wdn_t = (bf16*)(ws + WS_WDN);
    F.XN = (bf16*)(ws + WS_XN); F.SEG = (bf16*)(ws + WS_SEG); F.MIX = (bf16*)(ws + WS_MIX); F.U = (bf16*)(ws + WS_U);
    F.KSUM = (float*)(ws + WS_KSUM); F.KSUMS = (float*)(ws + WS_KSUMP); F.IG = (float*)(ws + WS_GATE); F.LF = (float*)(ws + WS_GATE + 512 * 1024);
    F.H = (float*)(ws + WS_H); F.X1 = (float*)(ws + WS_X1);
    for (int u = F.tid; u < (LDS_BYTES - LDSCTL_OFF) / 4; u += NWAVES * 64) ((LAS unsigned*)(F.lds + LDSCTL_OFF))[u] = 0u;
    __syncthreads();
    LAS int* bucket = (LAS int*)(F.lds + LDSCTL_OFF + 1024);
    if (F.tid < 128) bucket[F.tid] = t5_bucket_small(F.tid);
    __syncthreads();
    { LAS float* l8 = (LAS float*)(F.lds + LUT8_OFF);
      for (int i = F.tid; i < AH * 129; i += NWAVES * 64) { const int h_ = i / 129, d_ = i % 129; l8[h_ * 132 + d_] = F.rel_bias[(d_ < 128 ? bucket[d_] : 31) * AH + h_]; }
    }
    __syncthreads();
    const int lo = args.ph_lo, hi = args.ph_hi;
    XcdBarrier bar; bar.bar = (unsigned*)(F.ctl + CW_BAR); bar.x = 0; bar.st = nullptr;
    if (hi - lo > 1) bar = xcd_barrier_post((unsigned*)(F.ctl + CW_BAR), F.MISC + 8);
#define IN(k) (lo <= (k) && (k) < hi)
#define SEAM(k) do { if (IN(k) && IN((k) + 1)) xcd_barrier(bar); } while (0)

#ifndef PROBE_MASK
#define PROBE_MASK 0
#endif
#define PB(b) ((PROBE_MASK >> (b)) & 1)
#ifndef PROBE_T
#define PROBE_T 0
#endif
#define CW_TPROBE 20000
#define TSTART(k) unsigned long long t0_ = 0; if (PROBE_T && (PROBE_T % 100) == (k)) t0_ = __builtin_amdgcn_s_memrealtime()
#define TEND(k, AFTERBAR) do { if (PROBE_T && (PROBE_T % 100) == (k) && ((PROBE_T >= 500) == (AFTERBAR)) && F.tid == 0) { const unsigned dt_ = (unsigned)(__builtin_amdgcn_s_memrealtime() - t0_); \
        if (PROBE_T / 100 == 3) __hip_atomic_fetch_max((unsigned*)(F.ctl + CW_TPROBE + 1), 1000000u - dt_, __ATOMIC_RELAXED, __HIP_MEMORY_SCOPE_AGENT); else __hip_atomic_fetch_max((unsigned*)(F.ctl + CW_TPROBE), dt_, __ATOMIC_RELAXED, __HIP_MEMORY_SCOPE_AGENT); } } while (0)
#define TSUB(id, BODY) do { TSTART(id); BODY; TEND(id, false); } while (0)
#define RUNPH(k, BODY) do { TSTART(k); if (IN(k)) { BODY; if ((PROBE_MASK >> (k)) & 1) { xcd_barrier(bar); BODY; } } TEND(k, false); SEAM(k); TEND(k, true); } while (0)
#define PH1 do { const int gwg = (F.G > P1_GEMM_WGS) ? P1_GEMM_WGS : F.G; \
        if ((int)blockIdx.x < gwg) { pg8::Gemm g{F.XN, F.Win_t, M, NPG, D}; pg8::StaticOrder S; S.init(M, NPG, gwg, (int)blockIdx.x); pg8::EpiInProj E{F.SEG, SEG_ELEMS, F.out, F.KSUM}; \
            pg8::gemm_phase<pg8::EpiInProj, pg8::StaticOrder, true, true>(F.lds + RING_OFF, g, S, E); } \
        if (F.G > gwg) { if ((int)blockIdx.x >= gwg) { page_sums(F, PS_SPLIT, DB * NPAGES, ((int)blockIdx.x - gwg) * NWAVES + F.wave, (F.G - gwg) * NWAVES); late_transposes(F, ((int)blockIdx.x - gwg) * NWAVES + F.wave, (F.G - gwg) * NWAVES); } } \
        else { page_sums(F, PS_SPLIT, DB * NPAGES, F.vcu * NWAVES + F.wave, F.G * NWAVES); late_transposes(F, F.vcu * NWAVES + F.wave, F.G * NWAVES); } } while (0)
#define PH2 do { for (int u = blockIdx.x; u < NSEQ * NCH; u += F.G) mlstm_stepA(F, u); for (int u = blockIdx.x; u < 32 * 15; u += 2 * F.G) attn_select2(F, u, (u + F.G < 32 * 15) ? u + F.G : -1); sample_select(F); \
        if (PB(11)) { for (int u = blockIdx.x; u < NSEQ * NCH; u += F.G) mlstm_stepA(F, u); } if (PB(13)) sample_select(F); } while (0)
#define PH3 do { TSUB(24, for (int u = blockIdx.x; u < NSEQ * 16; u += F.G) mlstm_stepB(F, u)); TSUB(25, attn_past_items(F, bucket)); TSUB(26, sample_past_items(F, bucket)); } while (0)
#define PH4 do { TSUB(20, for (int u = blockIdx.x; u < NSEQ * NCH; u += F.G) mlstm_stepC(F, u)); \
        TSUB(21, for (int u = blockIdx.x; u < 16 * 16; u += F.G) attn_own_pair(F, bucket, u, u + 256)); TSUB(22, for (int u = blockIdx.x; u < DB * MH; u += F.G) mlstm_sample_full(F, u)); \
        __syncthreads(); TSUB(23, sample_own_merge(F, bucket)); } while (0)
#define PH6G do { pg8::Gemm g{F.MIX, F.Wout_t, MP, D, D}; pg8::StaticOrder S; S.init(MP, D, F.G, (int)blockIdx.x); pg8::EpiResid E{F.xp, F.xs, F.X1, F.norm_ffn, F.XN, (float*)(F.ws + WS_SSQ)}; \
        pg8::gemm_phase<pg8::EpiResid, pg8::StaticOrder, true, true>(F.lds + RING_OFF, g, S, E); } while (0)
#define PH7 do { const int gw = F.vcu * NWAVES + F.wave, NGW = F.G * NWAVES; f32x4 cur_[4], nxt_[4]; if (gw < M) load_row(F.X1 + (size_t)gw * D, F.lane, cur_); \
        for (int m = gw; m < M; m += NGW) { const int mnx = (m + NGW < M) ? m + NGW : m; load_row(F.X1 + (size_t)mnx * D, F.lane, nxt_); rms_row_to_bf16<false>(F, cur_, F.norm_ffn, F.XN + (size_t)m * D, m); \
            _Pragma("unroll") for (int j = 0; j < 4; ++j) cur_[j] = nxt_[j]; } } while (0)
#define PH8 do { pg8::Gemm g{F.XN, F.Wup_t, MP, FF, D}; pg8::StaticOrder S; S.init(MP, FF, F.G, (int)blockIdx.x); pg8::EpiRelu2 E{F.U, (const float*)(F.ws + WS_SSQ)}; \
        pg8::gemm_phase<pg8::EpiRelu2, pg8::StaticOrder, true, true>(F.lds + RING_OFF, g, S, E); \
        sample_ffn_norm(F); TSUB(31, skinny_up4(F)); } while (0)

    RUNPH(0, p0_prologue(F));
    RUNPH(1, PH1);
    RUNPH(2, PH2);
    RUNPH(3, PH3);
    { TSTART(4); if (IN(4)) { PH4; } TEND(4, false); if (IN(4) && IN(6)) xcd_barrier(bar); TEND(4, true); }
    { TSTART(6); if (IN(6)) { PH6G; if ((PROBE_MASK >> 6) & 1) { xcd_barrier(bar); PH6G; }
        TSUB(30, skinny_gemm<8>(F, F.MIX + (size_t)MP * D, D, F.Wout_t, D, D / 32, D, SkResid{F.xs, F.X1})); } TEND(6, false); if (IN(6) && IN(8)) xcd_barrier(bar); TEND(6, true); }
    RUNPH(8, PH8);
    { TSTART(9); if (IN(9)) {
        pg8::Gemm g{F.U, F.Wdn_t, MP, D, FF}; pg8::StaticOrder S; S.init(MP, D, F.G, (int)blockIdx.x);
        pg8::EpiAccum E{F.X1};
        pg8::gemm_phase<pg8::EpiAccum, pg8::StaticOrder, true, true>(F.lds + RING_OFF, g, S, E);
        TSUB(32, skinny_gemm<16>(F, F.U + (size_t)MP * FF, FF, F.Wdn_t, FF, D / 32, FF, SkAccum{F.X1}));
    } TEND(9, false); SEAM(9); TEND(9, true); }
    RUNPH(10, final_norm_rows(F));
    if (PROBE_T && blockIdx.x == 0 && F.tid < 128) { unsigned tk = __hip_atomic_load((unsigned*)(F.ctl + CW_TPROBE + ((PROBE_T / 100 == 3) ? 1 : 0)), __ATOMIC_RELAXED, __HIP_MEMORY_SCOPE_AGENT); if (PROBE_T / 100 == 3) tk = 1000000u - tk; F.out[O_MS + F.tid] *= (1.0f + (float)tk * 1e-5f); }
#undef IN
#undef SEAM
}

extern "C" void kernel_launch(void* const* d_in, const int* in_sizes, int n_in, void* d_out, int out_size, void* d_ws, size_t ws_size, hipStream_t stream) {
    static int grid = 0;
    if (grid == 0) {
        if (n_in != 19 || (size_t)out_size != O_END || ws_size < WS_END_SSQ) { fprintf(stderr, "kernel_launch: unexpected shapes (n_in %d out %d ws %zu)\n", n_in, out_size, ws_size); grid = -1; return; }
        int dev = 0, cus = 0, per_cu = 0;
        if (hipGetDevice(&dev) != hipSuccess || hipDeviceGetAttribute(&cus, hipDeviceAttributeMultiprocessorCount, dev) != hipSuccess) { grid = -1; return; }
        if (hipFuncSetAttribute((const void*)hymba_fwd, hipFuncAttributeMaxDynamicSharedMemorySize, LDS_BYTES) != hipSuccess) { fprintf(stderr, "kernel_launch: hipFuncSetAttribute failed\n"); grid = -1; return; }
        if (hipOccupancyMaxActiveBlocksPerMultiprocessor(&per_cu, (const void*)hymba_fwd, NWAVES * 64, LDS_BYTES) != hipSuccess || per_cu < 1)
            fprintf(stderr, "kernel_launch: note: occupancy query reports %d workgroups per CU\n", per_cu);
        (void)hipGetLastError();
        grid = cus;
    }
    if (grid < 0) return;
    if (hipMemsetAsync((char*)d_ws + WS_CTL, 0, CTL_ZERO_BYTES, stream) != hipSuccess) { fprintf(stderr, "kernel_launch: memset failed\n"); return; }
    Args a{};
    for (int i = 0; i < 19; ++i) a.in[i] = d_in[i];
    a.out = (float*)d_out; a.ws = (unsigned char*)d_ws;
#if MK_ONE_LAUNCH
    a.ph_lo = 0; a.ph_hi = N_PHASES;
    hipLaunchKernelGGL(hymba_fwd, dim3(grid), dim3(NWAVES * 64), LDS_BYTES, stream, a);
#else
    for (int p = 0; p < N_PHASES; ++p) {
        a.ph_lo = p; a.ph_hi = p + 1;
        hipLaunchKernelGGL(hymba_fwd, dim3(grid), dim3(NWAVES * 64), LDS_BYTES, stream, a);
    }
#endif
    const hipError_t le = hipPeekAtLastError();
    if (le != hipSuccess) fprintf(stderr, "kernel_launch: launch failed: %s\n", hipGetErrorName(le));
}
```

```cpp
#include <hip/hip_runtime.h>
#include <cstdio>
#include <cstdint>
#include <cmath>
constexpr int D = 1024, SEQ = 4096, NBATCH = 4, MP = NBATCH * SEQ  , DB = 32, DS = 8, MS = DB * DS  , M = MP + MS  ;
constexpr int FF = 4096, NPROJ = 3592, NPG = 3584  ;
constexpr int AH = 8, AD = 64, AW = 512, MH = 4, MD = 128, MW = 512;
constexpr int PAST = 8192, PAGE = 128, NPAGES = PAST / PAGE  , MBLK = 256, NBLK_P = SEQ / MBLK  , NBLK_S = PAST / MBLK  ;
constexpr float RMS_EPS = 1e-6f;
constexpr size_t O_YP = 0, O_YS = 16777216, O_KP = 17039360, O_VP = 25427968, O_CP = 33816576, O_NP = 34078720, O_MP = 34080768,
                 O_KS = 34080784, O_VS = 34211856, O_CS = 34342928, O_NS = 36440080, O_MS = 36456464, O_END = 36456592;
namespace pg8 {
#define PG8_LAS __attribute__((address_space(3)))
typedef unsigned short bf16_t;
typedef short bf16x8 __attribute__((ext_vector_type(8)));
typedef float f32x4 __attribute__((ext_vector_type(4)));
typedef unsigned u32x4 __attribute__((ext_vector_type(4)));
constexpr int BM = 256, BK = 64, HALF = 128, HTB = HALF * BK * 2  , STAGE_BYTES = 8 * HTB, NXCD = 8, WGM = 8;

__host__ __device__ __forceinline__ int lds_byte(int r, int c) { const int st = (r >> 4) * 2 + (c >> 5), rr = r & 15, cc = c & 31, ob = rr * 64 + cc * 2; return st * 1024 + (ob ^ (((ob >> 9) & 1) << 5)); }
__host__ __device__ __forceinline__ void stage_rc(int b, int& R, int& C) { const int st = b / 1024, sb = b % 1024, swz = sb ^ (((sb >> 9) & 1) << 5); R = (st >> 1) * 16 + swz / 64; C = (st & 1) * 32 + (swz % 64) / 2; }
__host__ __device__ __forceinline__ int perm32(int rho) { const int n = rho >> 4, i = rho & 15; return 8 * (i >> 2) + 4 * n + (i & 3); }

struct Unit { int pm, pn; };
struct Gemm { const bf16_t* A; const bf16_t* Bt; int M, N, K; };

struct StaticOrder {
    int nM, nN, nwg, G, c;
    __host__ __device__ void init(int M, int N, int G_, int c_) { nM = M / BM; nN = N / BM; nwg = nM * nN; G = G_; c = c_; }
    __host__ __device__ bool next(int i, Unit& u) const {
        const long L = (long)i * G + c; if (L >= nwg) return false;
        int wgid = (int)L; { const int q = nwg / NXCD, r = nwg % NXCD, xcd = wgid % NXCD, off = wgid / NXCD; wgid = (xcd < r ? xcd * (q + 1) : r * (q + 1) + (xcd - r) * q) + off; }
        const int nig = WGM * nN, gid = wgid / nig, fm = gid * WGM, gsz = (nM - fm) < WGM ? (nM - fm) : WGM;
        u.pm = fm + ((wgid % nig) % gsz); u.pn = (wgid % nig) / gsz; return true;
    }
    __device__ __forceinline__ void a_ready(const Unit&) const {}
    __device__ __forceinline__ void done(const Unit&) const {}
};

__device__ __forceinline__ unsigned cvt_pk_bf16(float lo, float hi) { unsigned r; asm volatile("v_cvt_pk_bf16_f32 %0, %1, %2" : "=v"(r) : "v"(lo), "v"(hi)); return r; }
typedef float f32x2 __attribute__((ext_vector_type(2)));
typedef unsigned u32x4_t __attribute__((ext_vector_type(4)));
__device__ __forceinline__ u32x4_t pack8(f32x4 v0, f32x4 v1) { u32x4_t w; w.x = cvt_pk_bf16(v0[0], v0[1]); w.y = cvt_pk_bf16(v0[2], v0[3]); w.z = cvt_pk_bf16(v1[0], v1[1]); w.w = cvt_pk_bf16(v1[2], v1[3]); return w; }
struct EpiInProj {
    static constexpr bool PERM = true, AFTER_DRAIN = false;
    bf16_t* seg0; size_t seg_stride; float* out; float* ksum;
    __device__ __forceinline__ void operator()(const f32x4 (&acc)[2][2][4][2], const Unit& u, int wr, int wc, int fr, int fq) const {
        const int seg = u.pn >> 1;
        const float sc = (seg == 0) ? 0.125f : ((seg == 4) ? 0.08838834764831845f : 1.0f);
        bf16_t* base = seg0 + (size_t)seg * seg_stride;
        const int cs0 = (u.pn & 1) * 256 + wc * 32 + 8 * fq;
        const int row0 = u.pm * BM + wr * 64 + fr;
        const bool kv = (seg == 1) || (seg == 2);
        const bool prompt = u.pm < (MP / BM);
        float* fo = out + (prompt ? (seg == 1 ? O_KP : O_VP) : (seg == 1 ? O_KS : O_VS));
        const int frow0 = prompt ? row0 : row0 - MP;
        f32x4 cs[2][2];
#pragma unroll
        for (int bj = 0; bj < 2; ++bj)
#pragma unroll
            for (int n = 0; n < 2; ++n) cs[bj][n] = (f32x4){0.f, 0.f, 0.f, 0.f};
#pragma unroll
        for (int ai = 0; ai < 2; ++ai)
#pragma unroll
            for (int m = 0; m < 4; ++m) {
                bf16_t* rowp = base + (size_t)(row0 + ai * HALF + m * 16) * 512 + cs0;
#pragma unroll
                for (int bj = 0; bj < 2; ++bj) {
                    f32x4 v0 = acc[ai][bj][m][0], v1 = acc[ai][bj][m][1];
                    if (kv) { float* fp = fo + (size_t)(frow0 + ai * HALF + m * 16) * 512 + cs0 + bj * HALF; __builtin_nontemporal_store(v0, (f32x4*)fp); __builtin_nontemporal_store(v1, (f32x4*)(fp + 4)); }
                    if (seg == 1) { cs[bj][0] += v0; cs[bj][1] += v1; }
                    v0 = v0 * sc; v1 = v1 * sc;
                    *(u32x4_t*)(rowp + bj * HALF) = pack8(v0, v1);
                }
            }
        if (seg == 1 && prompt) {
#pragma unroll
            for (int bj = 0; bj < 2; ++bj)
#pragma unroll
                for (int n = 0; n < 2; ++n)
#pragma unroll
                    for (int j = 0; j < 4; ++j) {
                        float v = cs[bj][n][j];
                        v += __shfl_xor(v, 1); v += __shfl_xor(v, 2); v += __shfl_xor(v, 4); v += __shfl_xor(v, 8);
                        if (fr == 0) __hip_atomic_fetch_add(ksum + (size_t)u.pm * 512 + cs0 + bj * HALF + n * 4 + j, v, __ATOMIC_RELAXED, __HIP_MEMORY_SCOPE_AGENT);
                    }
        }
    }
};
struct EpiResid {
    static constexpr bool PERM = false, AFTER_DRAIN = false;
    const float* xp; const float* xs; float* x1; const float* gain; bf16_t* xn; float* ssq;
    __device__ __forceinline__ void operator()(const f32x4 (&acc)[2][2][4][2], const Unit& u, int wr, int wc, int fr, int fq) const {
        const int row0 = u.pm * BM + wr * 64 + fr, col0 = u.pn * BM + wc * 32 + 4 * fq;
        const float* src = (u.pm < (MP / BM)) ? xp + (size_t)row0 * D : xs + (size_t)(row0 - MP) * D;
        float* dst = x1 + (size_t)row0 * D; bf16_t* dxn = xn + (size_t)row0 * D;
        f32x4 gv[2][2];
#pragma unroll
        for (int bj = 0; bj < 2; ++bj)
#pragma unroll
            for (int n = 0; n < 2; ++n) gv[bj][n] = *(const f32x4*)(gain + col0 + bj * HALF + n * 16);
#pragma unroll
        for (int ai = 0; ai < 2; ++ai)
#pragma unroll
            for (int m = 0; m < 4; ++m) {
                const size_t off = (size_t)(ai * HALF + m * 16) * D + col0; float sq = 0.f;
#pragma unroll
                for (int bj = 0; bj < 2; ++bj)
#pragma unroll
                    for (int n = 0; n < 2; ++n) { const f32x4 xv = *(const f32x4*)(src + off + bj * HALF + n * 16) + acc[ai][bj][m][n]; *(f32x4*)(dst + off + bj * HALF + n * 16) = xv;
                        sq += (xv[0] * xv[0] + xv[1] * xv[1]) + (xv[2] * xv[2] + xv[3] * xv[3]);
                        const f32x4 y = xv * gv[bj][n]; unsigned long long w = (unsigned long long)cvt_pk_bf16(y[0], y[1]) | ((unsigned long long)cvt_pk_bf16(y[2], y[3]) << 32);
                        *(unsigned long long*)(dxn + off + bj * HALF + n * 16) = w; }
                sq += __shfl_xor(sq, 16); sq += __shfl_xor(sq, 32);
                if (fq == 0) ssq[(size_t)(row0 + ai * HALF + m * 16) * 16 + u.pn * 4 + wc] = sq;
            }
    }
};
struct EpiAccum {
    static constexpr bool PERM = false, AFTER_DRAIN = false;
    float* x1;
    __device__ __forceinline__ void operator()(const f32x4 (&acc)[2][2][4][2], const Unit& u, int wr, int wc, int fr, int fq) const {
        const int row0 = u.pm * BM + wr * 64 + fr, col0 = u.pn * BM + wc * 32 + 4 * fq;
        float* dst = x1 + (size_t)row0 * D;
#pragma unroll
        for (int ai = 0; ai < 2; ++ai)
#pragma unroll
            for (int m = 0; m < 4; ++m) {
                const size_t off = (size_t)(ai * HALF + m * 16) * D + col0;
#pragma unroll
                for (int bj = 0; bj < 2; ++bj)
#pragma unroll
                    for (int n = 0; n < 2; ++n) { float* p = dst + off + bj * HALF + n * 16; const f32x4 xv = *(const f32x4*)p; *(f32x4*)p = xv + acc[ai][bj][m][n]; }
            }
    }
};
struct EpiRelu2 {
    static constexpr bool PERM = true, AFTER_DRAIN = false;
    bf16_t* U; const float* ssq;
    __device__ __forceinline__ void operator()(const f32x4 (&acc)[2][2][4][2], const Unit& u, int wr, int wc, int fr, int fq) const {
        const int row0 = u.pm * BM + wr * 64 + fr, col0 = u.pn * BM + wc * 32 + 8 * fq;
#pragma unroll
        for (int ai = 0; ai < 2; ++ai)
#pragma unroll
            for (int m = 0; m < 4; ++m) {
                const int row = row0 + ai * HALF + m * 16;
                const f32x4* sp = (const f32x4*)(ssq + (size_t)row * 16); const f32x4 s0 = sp[0], s1 = sp[1], s2 = sp[2], s3 = sp[3];
                const float tot = ((s0[0] + s0[1]) + (s0[2] + s0[3])) + ((s1[0] + s1[1]) + (s1[2] + s1[3])) + ((s2[0] + s2[1]) + (s2[2] + s2[3])) + ((s3[0] + s3[1]) + (s3[2] + s3[3]));
                const float r2 = 1.f / (tot * (1.f / D) + RMS_EPS);
                bf16_t* rowp = U + (size_t)row * FF + col0;
#pragma unroll
                for (int bj = 0; bj < 2; ++bj) {
                    f32x4 v0 = acc[ai][bj][m][0], v1 = acc[ai][bj][m][1];
#pragma unroll
                    for (int j = 0; j < 4; ++j) { const float a = fmaxf(v0[j], 0.f), b = fmaxf(v1[j], 0.f); v0[j] = a * a * r2; v1[j] = b * b * r2; }
                    *(u32x4_t*)(rowp + bj * HALF) = pack8(v0, v1);
                }
            }
    }
};

template <class Epi, class Sched, bool ALIGN_EPI = false, bool SP2 = false>
__device__ __forceinline__ void gemm_phase(PG8_LAS unsigned char* lds, const Gemm g, const Sched& S, const Epi& E) {
    const int tid = threadIdx.x, wid = __builtin_amdgcn_readfirstlane(tid >> 6), lane = tid & 63, wr = wid >> 2, wc = wid & 3, fr = lane & 15, fq = lane >> 4;
    const int K = g.K, nt = K / BK;
    unsigned voffA[2], voffB[2];
#pragma unroll
    for (int i = 0; i < 2; ++i) { int R, C; stage_rc(tid * 16 + i * 8192, R, C); const int Rb = Epi::PERM ? ((R & ~31) + perm32(R & 31)) : R;
        voffA[i] = (unsigned)(R * K + C) * 2u; voffB[i] = (unsigned)(Rb * K + C) * 2u; }
    const size_t kstep = (size_t)(BK * 2);
    const size_t hstep = (size_t)HALF * K * 2;
    const size_t tstep = 2 * hstep;
    const unsigned ldsw = (unsigned)wid * 1024u;
    const int aoff = lds_byte(wr * 64 + fr, fq * 8), boff = lds_byte(wc * 32 + fr, fq * 8);
#define PG8_SA(b, h) (((b) * 2 + (h)) * HTB)
#define PG8_SB(b, h) ((4 + (b) * 2 + (h)) * HTB)
#define PG8_STAGE(bufoff, gbase, voff) do { _Pragma("unroll") for (int _i = 0; _i < 2; ++_i) \
        __builtin_amdgcn_global_load_lds((const unsigned*)((const char*)(gbase) + (voff)[_i]), (PG8_LAS unsigned*)(lds + (bufoff) + ldsw + _i * 8192), 16, 0, 0); } while (0)
#define PG8_LDA(dst, b, h) do { _Pragma("unroll") for (int m = 0; m < 4; ++m) _Pragma("unroll") for (int k = 0; k < 2; ++k) dst[m][k] = *(const PG8_LAS bf16x8*)(lds + PG8_SA(b, h) + aoff + m * 2048 + k * 1024); } while (0)
#define PG8_LDB(dst, b, h) do { _Pragma("unroll") for (int n = 0; n < 2; ++n) _Pragma("unroll") for (int k = 0; k < 2; ++k) dst[n][k] = *(const PG8_LAS bf16x8*)(lds + PG8_SB(b, h) + boff + n * 2048 + k * 1024); } while (0)
#define PG8_MMA(ai, bj, At, Bt) do { __builtin_amdgcn_s_setprio(1); _Pragma("unroll") for (int m = 0; m < 4; ++m) _Pragma("unroll") for (int n = 0; n < 2; ++n) _Pragma("unroll") for (int k = 0; k < 2; ++k) \
        acc[ai][bj][m][n] = __builtin_amdgcn_mfma_f32_16x16x32_bf16(Bt[n][k], At[m][k], acc[ai][bj][m][n], 0, 0, 0); __builtin_amdgcn_s_setprio(0); } while (0)
#define PG8_WAIT_V(n) asm volatile("s_waitcnt vmcnt(" #n ")" ::: "memory")
#define PG8_WAIT_L(n) asm volatile("s_waitcnt lgkmcnt(" #n ")" ::: "memory")
#define PG8_BAR __builtin_amdgcn_s_barrier()
#define PG8_SCHED __builtin_amdgcn_sched_barrier(0)
    Unit cur, nxt; int ui = 0;
    if (!S.next(0, cur)) return;
    f32x4 acc[2][2][4][2];
#pragma unroll
    for (int a = 0; a < 2; ++a)
#pragma unroll
        for (int b = 0; b < 2; ++b)
#pragma unroll
            for (int m = 0; m < 4; ++m)
#pragma unroll
                for (int n = 0; n < 2; ++n) acc[a][b][m][n] = (f32x4){0.f, 0.f, 0.f, 0.f};
    bf16x8 At[4][2], B0[2][2], B1[2][2];
    const char* cA = (const char*)g.A + (size_t)cur.pm * tstep; const char* cB = (const char*)g.Bt + (size_t)cur.pn * tstep;
    S.a_ready(cur);
    if constexpr (SP2) {
        PG8_STAGE(PG8_SB(0, 0), cB, voffB); PG8_STAGE(PG8_SB(0, 1), cB + hstep, voffB); PG8_STAGE(PG8_SA(0, 0), cA, voffA); PG8_STAGE(PG8_SA(0, 1), cA + hstep, voffA);
        if (wr == 1) PG8_BAR;
        PG8_WAIT_V(2); PG8_BAR;
        PG8_STAGE(PG8_SB(1, 0), cB + kstep, voffB); PG8_STAGE(PG8_SA(1, 0), cA + kstep, voffA); PG8_STAGE(PG8_SB(1, 1), cB + hstep + kstep, voffB);
        PG8_WAIT_V(6); PG8_BAR;
    } else {
        PG8_STAGE(PG8_SB(0, 0), cB, voffB); PG8_STAGE(PG8_SA(0, 0), cA, voffA); PG8_STAGE(PG8_SB(0, 1), cB + hstep, voffB); PG8_STAGE(PG8_SA(0, 1), cA + hstep, voffA);
        if (wr == 1) PG8_BAR;
        PG8_WAIT_V(4); PG8_BAR;
        PG8_STAGE(PG8_SB(1, 0), cB + kstep, voffB); PG8_STAGE(PG8_SA(1, 0), cA + kstep, voffA); PG8_STAGE(PG8_SB(1, 1), cB + hstep + kstep, voffB);
        PG8_WAIT_V(6); PG8_BAR;
    }
    for (;;) {
        const bool has_next = S.next(ui + 1, nxt);
        const char* nA = has_next ? (const char*)g.A + (size_t)nxt.pm * tstep : cA; const char* nB = has_next ? (const char*)g.Bt + (size_t)nxt.pn * tstep : cB;
        for (int t = 0; t < nt; t += 2) {
            const bool last = (t == nt - 2);
            const char* a1 = cA + (size_t)(t + 1) * kstep;
            const char* a2 = last ? nA : cA + (size_t)(t + 2) * kstep; const char* b2 = last ? nB : cB + (size_t)(t + 2) * kstep;
            const char* a3 = a2 + kstep; const char* b3 = b2 + kstep;
            if (last && has_next) S.a_ready(nxt);
            if constexpr (SP2) {
            PG8_LDB(B0, 0, 0); PG8_LDB(B1, 0, 1); PG8_SCHED; PG8_LDA(At, 0, 0); PG8_STAGE(PG8_SA(1, 1), a1 + hstep, voffA);
            PG8_WAIT_V(8); PG8_WAIT_L(0); PG8_BAR; PG8_MMA(0, 0, At, B0); PG8_MMA(0, 1, At, B1); PG8_BAR; PG8_SCHED;
            PG8_LDA(At, 0, 1); PG8_STAGE(PG8_SB(0, 0), b2, voffB); PG8_STAGE(PG8_SB(0, 1), b2 + hstep, voffB); PG8_STAGE(PG8_SA(0, 0), a2, voffA);
            PG8_WAIT_V(8); PG8_WAIT_L(0); PG8_BAR; PG8_MMA(1, 0, At, B0); PG8_MMA(1, 1, At, B1); PG8_BAR; PG8_SCHED;
            PG8_LDB(B0, 1, 0); PG8_LDB(B1, 1, 1); PG8_SCHED; PG8_LDA(At, 1, 0); PG8_STAGE(PG8_SA(0, 1), a2 + hstep, voffA);
            PG8_WAIT_V(8); PG8_WAIT_L(0); PG8_BAR; PG8_MMA(0, 0, At, B0); PG8_MMA(0, 1, At, B1); PG8_BAR; PG8_SCHED;
            PG8_LDA(At, 1, 1); PG8_STAGE(PG8_SB(1, 0), b3, voffB); PG8_STAGE(PG8_SB(1, 1), b3 + hstep, voffB); PG8_STAGE(PG8_SA(1, 0), a3, voffA);
            PG8_WAIT_V(8); PG8_WAIT_L(0); PG8_BAR; PG8_MMA(1, 0, At, B0); PG8_MMA(1, 1, At, B1); PG8_BAR; PG8_SCHED;
            } else {
            PG8_LDB(B0, 0, 0); PG8_SCHED; PG8_LDA(At, 0, 0); PG8_STAGE(PG8_SA(1, 1), a1 + hstep, voffA);
            PG8_WAIT_L(8); PG8_BAR; PG8_WAIT_L(0); PG8_MMA(0, 0, At, B0); PG8_BAR; PG8_SCHED;
            PG8_LDB(B1, 0, 1); PG8_STAGE(PG8_SB(0, 0), b2, voffB);
            PG8_BAR; PG8_WAIT_L(0); PG8_MMA(0, 1, At, B1); PG8_BAR;
            PG8_LDA(At, 0, 1); PG8_STAGE(PG8_SA(0, 0), a2, voffA);
            PG8_BAR; PG8_WAIT_L(0); PG8_MMA(1, 0, At, B0); PG8_BAR; PG8_SCHED;
            PG8_STAGE(PG8_SB(0, 1), b2 + hstep, voffB);
            PG8_WAIT_V(6); PG8_BAR; PG8_MMA(1, 1, At, B1); PG8_BAR;
            PG8_LDB(B0, 1, 0); PG8_SCHED; PG8_LDA(At, 1, 0); PG8_STAGE(PG8_SA(0, 1), a2 + hstep, voffA);
            PG8_WAIT_L(8); PG8_BAR; PG8_WAIT_L(0); PG8_MMA(0, 0, At, B0); PG8_BAR; PG8_SCHED;
            PG8_LDB(B1, 1, 1); PG8_STAGE(PG8_SB(1, 0), b3, voffB);
            PG8_BAR; PG8_WAIT_L(0); PG8_MMA(0, 1, At, B1); PG8_BAR;
            PG8_LDA(At, 1, 1); PG8_STAGE(PG8_SA(1, 0), a3, voffA);
            PG8_BAR; PG8_WAIT_L(0); PG8_MMA(1, 0, At, B0); PG8_BAR; PG8_SCHED;
            PG8_STAGE(PG8_SB(1, 1), b3 + hstep, voffB);
            PG8_WAIT_V(6); PG8_BAR; PG8_MMA(1, 1, At, B1); PG8_BAR;
            }
        }
        if constexpr (ALIGN_EPI) { if (wr == 0) PG8_BAR; }
        if constexpr (!Epi::AFTER_DRAIN) { E(acc, cur, wr, wc, fr, fq); S.done(cur); }
        if (!has_next) break;
#pragma unroll
        for (int a = 0; a < 2; ++a)
#pragma unroll
            for (int b = 0; b < 2; ++b)
#pragma unroll
                for (int m = 0; m < 4; ++m)
#pragma unroll
                    for (int n = 0; n < 2; ++n) acc[a][b][m][n] = (f32x4){0.f, 0.f, 0.f, 0.f};
        cur = nxt; cA = nA; cB = nB; ++ui;
        if constexpr (ALIGN_EPI) { if (wr == 1) PG8_BAR; }
    }
    PG8_WAIT_V(0);
    if constexpr (!ALIGN_EPI) { if (wr == 0) PG8_BAR; }
    PG8_BAR;
    if constexpr (Epi::AFTER_DRAIN) { E.fused(acc, cur, wr, wc, fr, fq, lds, wid, lane); S.done(cur); }
#undef PG8_SA
#undef PG8_SB
#undef PG8_STAGE
#undef PG8_LDA
#undef PG8_LDB
#undef PG8_MMA
#undef PG8_WAIT_V
#undef PG8_WAIT_L
#undef PG8_BAR
#undef PG8_SCHED
}
}

constexpr int NWAVES = 8;
constexpr size_t MiB = 1u << 20;
constexpr size_t WS_CTL = 0, CTL_ZERO_BYTES = 1 * MiB;
constexpr size_t WS_KSUM = 512 * 1024;
constexpr size_t WS_WIN = 2 * MiB, WS_WOUT = 10 * MiB, WS_WUP = 12 * MiB, WS_WDN = 20 * MiB;
constexpr size_t WS_GATE = 28 * MiB;
constexpr size_t WS_KSUMS = 29 * MiB;
constexpr size_t WS_XN = 32 * MiB;
constexpr size_t WS_SEG = 65 * MiB, SEG_BYTES = 17 * MiB;
constexpr size_t WS_H = 184 * MiB;
constexpr size_t WS_MIX = 217 * MiB;
constexpr size_t WS_X1 = 250 * MiB;
constexpr size_t WS_U = 320 * MiB;
constexpr size_t WS_END = 452 * MiB;
constexpr size_t WS_SSQ = 700 * MiB;
constexpr size_t WS_END_SSQ = 702 * MiB;
constexpr int CW_BAR = 4096;
constexpr int RING_OFF = 0, RING_BYTES = 131072;
constexpr int LDSCTL_OFF = RING_BYTES, MISC_OFF = LDSCTL_OFF + 320;
constexpr int LDS_BYTES = 151552;
constexpr int LUT8_OFF = LDSCTL_OFF + 13568;
#define GAS __attribute__((address_space(1)))
#define LAS __attribute__((address_space(3)))
typedef unsigned short bf16;
typedef unsigned v4u __attribute__((ext_vector_type(4)));
typedef float f32x4 __attribute__((ext_vector_type(4)));
typedef short bf16x8 __attribute__((ext_vector_type(8)));
typedef GAS unsigned gu32;
typedef GAS unsigned long long gu64;
#define RLX_AGENT __ATOMIC_RELAXED, __HIP_MEMORY_SCOPE_AGENT
#define LDS_WAIT() asm volatile("s_waitcnt lgkmcnt(0)" ::: "memory")
#define VM_WAIT() asm volatile("s_waitcnt vmcnt(0)" ::: "memory")
__device__ __forceinline__ unsigned long long rt() { return __builtin_amdgcn_s_memrealtime(); }
__device__ __forceinline__ unsigned pk2(float lo, float hi) { unsigned r; asm("v_cvt_pk_bf16_f32 %0, %1, %2" : "=v"(r) : "v"(lo), "v"(hi)); return r; }
__device__ __forceinline__ unsigned f2bf(float f) { return pk2(f, 0.f) & 0xffffu; }

#define XB_TMO      128
#define XB_XCNT(j)  (256  + 64 * (j))
#define XB_XSUB(j)  (1280 + 64 * (j))
#define XB_XGEN(j)  (2304 + 64 * (j))
#define XB_TOP      3328
#define XB_TOPGEN   3392
#define XCD_BAR_WORDS 3456
#define XB_SPIN_CAP (1u << 18)

__device__ __forceinline__ unsigned xb_ld(unsigned* p)              { return __hip_atomic_load(p, __ATOMIC_RELAXED, __HIP_MEMORY_SCOPE_AGENT); }
__device__ __forceinline__ unsigned xb_add(unsigned* p, unsigned v) { return __hip_atomic_fetch_add(p, v, __ATOMIC_RELAXED, __HIP_MEMORY_SCOPE_AGENT); }
__device__ __forceinline__ unsigned xb_xcc_id() { return (unsigned)__builtin_amdgcn_s_getreg((3 << 11) | 20) & 0xFu; }
#define XB_SPIN(cond, bar) do { unsigned _sp = 0; while (cond) { __builtin_amdgcn_s_sleep(1); \
    if ((++_sp & 255u) == 0u) { if (xb_ld(&(bar)[XB_TMO])) break; if (_sp > XB_SPIN_CAP) { atomicAdd(&(bar)[XB_TMO], 1u); break; } } } } while (0)

struct XcdBarrier {
    unsigned* bar; unsigned x;
    volatile LAS unsigned* st;
};

__device__ __forceinline__ XcdBarrier xcd_barrier_post(unsigned* bar, volatile LAS unsigned* st) {
    XcdBarrier b; b.bar = bar; b.x = xb_xcc_id(); b.st = st;
    if (threadIdx.x == 0) (void)xb_add(&bar[XB_XCNT(b.x)], 1u);
    return b;
}
__device__ __forceinline__ void xcd_barrier_complete(unsigned* bar, unsigned x, unsigned& nloc, unsigned& nx) {
    const unsigned G = gridDim.x * gridDim.y * gridDim.z;
    unsigned sum, cnt, mine, sp = 0u;
    for (;;) {
        sum = 0u; cnt = 0u; mine = 0u;
#pragma unroll
        for (unsigned j = 0; j < 16; ++j) { const unsigned c = xb_ld(&bar[XB_XCNT(j)]); sum += c; cnt += (c > 0u) ? 1u : 0u; mine = (j == x) ? c : mine; }
        if (sum == G) break;
        __builtin_amdgcn_s_sleep(1);
        if ((++sp & 255u) == 0u) { if (xb_ld(&bar[XB_TMO])) break; if (sp > XB_SPIN_CAP) { atomicAdd(&bar[XB_TMO], 1u); break; } }
    }
    nloc = mine > 0u ? mine : 1u; nx = cnt > 0u ? cnt : 1u;
}

__device__ __forceinline__ void xcd_barrier(const XcdBarrier& b) {
    asm volatile("s_waitcnt vmcnt(0)" ::: "memory");
    __syncthreads();
    if (threadIdx.x == 0) {
        unsigned* bar = b.bar;
        __builtin_amdgcn_s_waitcnt(0);
        unsigned nloc = b.st[0], nx = b.st[1];
        if (nloc == 0u) { xcd_barrier_complete(bar, b.x, nloc, nx); b.st[0] = nloc; b.st[1] = nx; }
        const unsigned old = xb_add(&bar[XB_XSUB(b.x)], 1u);
        const unsigned gen = old / nloc;
        if (old + 1u == (gen + 1u) * nloc) {
            __builtin_amdgcn_fence(__ATOMIC_RELEASE, "agent");
            asm volatile("s_waitcnt vmcnt(0)" ::: "memory");
            const unsigned og = xb_add(&bar[XB_TOP], 1u);
            const unsigned tg = og / nx;
            if (og + 1u == (tg + 1u) * nx) xb_add(&bar[XB_TOPGEN], 1u);
            else XB_SPIN(xb_ld(&bar[XB_TOPGEN]) == tg, bar);
            __builtin_amdgcn_fence(__ATOMIC_ACQUIRE, "agent");
            xb_add(&bar[XB_XGEN(b.x)], 1u);
            asm volatile("s_waitcnt vmcnt(0)" ::: "memory");
        } else {
            XB_SPIN(xb_ld(&bar[XB_XGEN(b.x)]) == gen, bar);
            __builtin_amdgcn_fence(__ATOMIC_ACQUIRE, "agent");
            asm volatile("s_waitcnt vmcnt(0)" ::: "memory");
        }
    }
    __syncthreads();
}

struct Frame {
    LAS unsigned char* lds;
    volatile LAS unsigned* MISC;
    gu32* ctl;
    int tid, lane, wave, vcu, G;
    const float *xp, *xs, *cache_k, *cache_v, *state_C, *state_n, *state_m; const int* page_table;
    const float *rel_bias, *norm_mix, *w_in, *b_ig, *b_fg, *ml_norm, *w_out, *norm_ffn, *w_up, *w_down, *norm_final;
    float* out; unsigned char* ws;
    bf16 *Win_t, *Wout_t, *Wup_t, *Wdn_t, *XN, *SEG, *MIX, *U;
    float *KSUM, *KSUMS, *IG, *LF, *H, *X1;
};
constexpr size_t SEG_ELEMS = SEG_BYTES / 2;
#define LUT8(F) ((const LAS float*)((F).lds + LUT8_OFF))
#define SEG_AQ(F) ((F).SEG + 0 * SEG_ELEMS)
#define SEG_AK(F) ((F).SEG + 1 * SEG_ELEMS)
#define SEG_AV(F) ((F).SEG + 2 * SEG_ELEMS)
#define SEG_MQ(F) ((F).SEG + 3 * SEG_ELEMS)
#define SEG_MK(F) ((F).SEG + 4 * SEG_ELEMS)
#define SEG_MV(F) ((F).SEG + 5 * SEG_ELEMS)
#define SEG_MO(F) ((F).SEG + 6 * SEG_ELEMS)

__device__ __forceinline__ float bf2f(unsigned short b) { return __builtin_bit_cast(float, (unsigned)b << 16); }
__device__ __forceinline__ float wave_sum(float v) {
#pragma unroll
    for (int o = 1; o < 64; o <<= 1) v += __shfl_xor(v, o);
    return v;
}
__device__ __forceinline__ void p0_transpose_item(const float* W, int K, int ldw, int N, bf16* WT, LAS float* scr, int item, int lane) {
    const int nblk = N / 32, kb = item / nblk, nb = item % nblk, k0 = 64 * kb, n0 = 32 * nb;
    float wv[32];
#pragma unroll
    for (int i = 0; i < 32; ++i) wv[i] = W[(size_t)(k0 + 2 * i + (lane >> 5)) * ldw + n0 + (lane & 31)];
#pragma unroll
    for (int i = 0; i < 32; i += 8) asm volatile("" : "+v"(wv[i]), "+v"(wv[i + 1]), "+v"(wv[i + 2]), "+v"(wv[i + 3]), "+v"(wv[i + 4]), "+v"(wv[i + 5]), "+v"(wv[i + 6]), "+v"(wv[i + 7]));
#pragma unroll
    for (int i = 0; i < 32; ++i) scr[(2 * i + (lane >> 5)) * 33 + (lane & 31)] = wv[i];
    LDS_WAIT(); asm volatile("" ::: "memory");
    const int c = lane & 7;
#pragma unroll
    for (int j = 0; j < 4; ++j) { const int n = (lane >> 3) + 8 * j; const LAS float* s = scr + (8 * c) * 33 + n;
        v4u o; o.x = pk2(s[0 * 33], s[1 * 33]); o.y = pk2(s[2 * 33], s[3 * 33]); o.z = pk2(s[4 * 33], s[5 * 33]); o.w = pk2(s[6 * 33], s[7 * 33]);
        *(GAS v4u*)(WT + (size_t)(n0 + n) * K + k0 + 8 * c) = o; }
    LDS_WAIT(); asm volatile("" ::: "memory");
}
__device__ __forceinline__ void load_row(const float* xrow, int lane, f32x4 (&v)[4]) {
    const GAS f32x4* xr = (const GAS f32x4*)xrow + lane;
#pragma unroll
    for (int j = 0; j < 4; ++j) v[j] = xr[64 * j];
}
__device__ __forceinline__ void load_row_nt(const float* xrow, int lane, f32x4 (&v)[4]) {
    const GAS f32x4* xr = (const GAS f32x4*)xrow + lane;
#pragma unroll
    for (int j = 0; j < 4; ++j) v[j] = __builtin_nontemporal_load(xr + 64 * j);
}
template <bool GATES>
__device__ __forceinline__ void rms_row_to_bf16(Frame& F, const f32x4 (&vin)[4], const float* gain, bf16* orow, int m) {
    const GAS f32x4* gr = (const GAS f32x4*)gain + F.lane;
    f32x4 v[4]; float s = 0.f;
#pragma unroll
    for (int j = 0; j < 4; ++j) { v[j] = vin[j]; s += (v[j].x * v[j].x + v[j].y * v[j].y) + (v[j].z * v[j].z + v[j].w * v[j].w); }
#pragma unroll
    for (int j = 0; j < 4; ++j) v[j] = v[j] * gr[64 * j];
    float g8[8];
    if (GATES) {
#pragma unroll
        for (int c = 0; c < 8; ++c) g8[c] = 0.f;
#pragma unroll
        for (int j = 0; j < 4; ++j)
#pragma unroll
            for (int i = 0; i < 4; ++i) { const int k = 256 * j + 4 * F.lane + i; const LAS f32x4* wr = (const LAS f32x4*)(F.lds + RING_OFF + 131072 - 32768) + 2 * k; const f32x4 w0 = wr[0], w1 = wr[1]; const float xv = v[j][i];
                g8[0] += xv * w0.x; g8[1] += xv * w0.y; g8[2] += xv * w0.z; g8[3] += xv * w0.w; g8[4] += xv * w1.x; g8[5] += xv * w1.y; g8[6] += xv * w1.z; g8[7] += xv * w1.w; }
    }
    const float rstd = 1.f / sqrtf(wave_sum(s) * (1.f / D) + RMS_EPS);
    GAS unsigned long long* o8 = (GAS unsigned long long*)orow + F.lane;
#pragma unroll
    for (int j = 0; j < 4; ++j) o8[64 * j] = (unsigned long long)pk2(v[j].x * rstd, v[j].y * rstd) | ((unsigned long long)pk2(v[j].z * rstd, v[j].w * rstd) << 32);
    if (GATES) {
#pragma unroll
        for (int c = 0; c < 8; ++c) g8[c] = wave_sum(g8[c]) * rstd;
        if (F.lane < 8) { float z = 0.f;
#pragma unroll
            for (int c = 0; c < 8; ++c) z = (F.lane == c) ? g8[c] : z;
            if (F.lane < 4) { F.IG[(size_t)m * 4 + F.lane] = z + F.b_ig[F.lane]; }
            else { const int h = F.lane - 4; z += F.b_fg[h]; F.LF[(size_t)m * 4 + h] = fminf(z, 0.f) - log1pf(expf(-fabsf(z))); } }
    }
}
__device__ __forceinline__ const float* xrow_of(Frame& F, int m) { return (m < MP) ? F.xp + (size_t)m * D : F.xs + (size_t)(m - MP) * D; }

constexpr int PS_SPLIT = 2048;
constexpr int P1_GEMM_WGS = 228;
__device__ __forceinline__ void page_sums(Frame& F, int u0, int u1, int w, int NW) {
    for (int u = u0 + w; u < u1; u += NW) {
        f32x4 a0 = {0.f, 0.f, 0.f, 0.f}, a1 = {0.f, 0.f, 0.f, 0.f};
        const int page = F.page_table[u];
        const GAS f32x4* base = (const GAS f32x4*)(F.cache_k + (size_t)page * PAGE * AW) + 2 * F.lane;
#pragma unroll 16
        for (int r = 0; r < PAGE; ++r) { a0 += __builtin_nontemporal_load(base + (size_t)r * (AW / 4)); a1 += __builtin_nontemporal_load(base + (size_t)r * (AW / 4) + 1); }
        GAS f32x4* o = (GAS f32x4*)(F.KSUMS + (size_t)u * AW) + 2 * F.lane; o[0] = a0; o[1] = a1;
    }
}
__device__ __forceinline__ void late_transposes(Frame& F, int w, int NW) {
    LAS float* scr = (LAS float*)(F.lds + RING_OFF + F.wave * 16384);
    constexpr int I_O = (D / 64) * (D / 32), I_UP = (D / 64) * (FF / 32), I_DN = (FF / 64) * (D / 32);
    for (int it = w; it < I_O + I_UP + I_DN; it += NW) {
        int r = it;
        if (r < I_O) { p0_transpose_item(F.w_out, D, D, D, F.Wout_t, scr, r, F.lane); continue; } r -= I_O;
        if (r < I_UP) { p0_transpose_item(F.w_up, D, FF, FF, F.Wup_t, scr, r, F.lane); continue; } r -= I_UP;
        p0_transpose_item(F.w_down, FF, D, D, F.Wdn_t, scr, r, F.lane);
    }
}
__device__ __forceinline__ void p0_prologue(Frame& F) {
    LAS float* scr = (LAS float*)(F.lds + RING_OFF + F.wave * 16384);
    const int gw = F.vcu * NWAVES + F.wave, NGW = F.G * NWAVES;
    constexpr int I_IN = (D / 64) * (NPG / 32);
    for (int it = gw; it < I_IN; it += NGW) p0_transpose_item(F.w_in, D, NPROJ, NPG, F.Win_t, scr, it, F.lane);
    __syncthreads();
    for (int i = F.tid; i < D * 2; i += NWAVES * 64) ((LAS f32x4*)(F.lds + RING_OFF + 131072 - 32768))[i] = *(const f32x4*)(F.w_in + (size_t)(i >> 1) * NPROJ + NPG + 4 * (i & 1));
    __syncthreads();
    {
        f32x4 r0[4], r1[4], r2[4];
        if (gw < M) load_row(xrow_of(F, gw), F.lane, r0);
        { const int m1 = (gw + NGW < M) ? gw + NGW : gw; load_row(xrow_of(F, m1 < M ? m1 : 0), F.lane, r1); }
        for (int m = gw; m < M; m += NGW) {
            const int m2 = (m + 2 * NGW < M) ? m + 2 * NGW : m; load_row(xrow_of(F, m2), F.lane, r2);
            rms_row_to_bf16<true>(F, r0, F.norm_mix, F.XN + (size_t)m * D, m);
#pragma unroll
            for (int j = 0; j < 4; ++j) { r0[j] = r1[j]; r1[j] = r2[j]; }
        }
    }
    page_sums(F, 0, PS_SPLIT, gw, NGW);
}

__device__ __forceinline__ int t5_bucket_small(int n) {
    if (n < 16) return n;
    int b = 16 + (int)(logf((float)n * (1.0f / 16.0f)) / 2.0794415416798357f * 16.0f);
    return b < 31 ? b : 31;
}

__device__ __forceinline__ void final_norm_rows(Frame& F) {
    const int gw = F.vcu * NWAVES + F.wave, NGW = F.G * NWAVES;
    f32x4 cur[4], nxt[4], nx2[4];
    if (gw < M) load_row_nt(F.X1 + (size_t)gw * D, F.lane, cur);
    { const int m1 = (gw + NGW < M) ? gw + NGW : (gw < M ? gw : 0); load_row_nt(F.X1 + (size_t)m1 * D, F.lane, nxt); }
    for (int m = gw; m < M; m += NGW) {
        const int m2 = (m + 2 * NGW < M) ? m + 2 * NGW : m; load_row_nt(F.X1 + (size_t)m2 * D, F.lane, nx2);
        const f32x4* gr = (const f32x4*)F.norm_final + F.lane;
        float s = 0.f;
#pragma unroll
        for (int j = 0; j < 4; ++j) s += (cur[j].x * cur[j].x + cur[j].y * cur[j].y) + (cur[j].z * cur[j].z + cur[j].w * cur[j].w);
        const float rstd = 1.f / sqrtf(wave_sum(s) * (1.f / D) + RMS_EPS);
        f32x4* o = (f32x4*)(F.out + ((m < MP) ? O_YP + (size_t)m * D : O_YS + (size_t)(m - MP) * D)) + F.lane;
#pragma unroll
        for (int j = 0; j < 4; ++j) __builtin_nontemporal_store(cur[j] * rstd * gr[64 * j], o + 64 * j);
#pragma unroll
        for (int j = 0; j < 4; ++j) { cur[j] = nxt[j]; nxt[j] = nx2[j]; }
    }
}

typedef float f32x16 __attribute__((ext_vector_type(16)));
typedef short s16x4 __attribute__((ext_vector_type(4)));
typedef short v4i16_t __attribute__((ext_vector_type(4)));
__device__ __forceinline__ f32x16 mfma32(bf16x8 a, bf16x8 b, f32x16 c) { return __builtin_amdgcn_mfma_f32_32x32x16_bf16(a, b, c, 0, 0, 0); }
__device__ __forceinline__ int crow(int r, int hi) { return (r & 3) + 8 * (r >> 2) + 4 * hi; }
__device__ __forceinline__ s16x4 vtr(const LAS unsigned char* p) { return __builtin_bit_cast(s16x4, __builtin_amdgcn_ds_read_tr16_b64_v4i16((LAS v4i16_t*)p)); }
__device__ __forceinline__ bf16x8 tfrag(const LAS unsigned char* tile, int T, int s, int ct, int lane) {
    const int i = lane & 15, hi = lane >> 5;
    const LAS unsigned char* p = tile + ct * (T * 64) + (16 * s + 4 * hi + (i >> 2)) * 64 + ((lane >> 4) & 1) * 32 + (i & 3) * 8;
    const s16x4 lo = vtr(p), hh = vtr(p + 512);
    return (bf16x8){lo[0], lo[1], lo[2], lo[3], hh[0], hh[1], hh[2], hh[3]};
}
__device__ __forceinline__ bf16x8 rfrag(const LAS unsigned char* tile, int T, int rt, int s, int lane) {
    return *(const LAS bf16x8*)(tile + (2 * s + (lane >> 5)) * (T * 16) + (32 * rt + (lane & 31)) * 16);
}
__device__ __forceinline__ float half_swap_add(float v) { return v + __shfl_xor(v, 32); }

constexpr int MLC = 256, NCH = SEQ / MLC  , NSEQ = NBATCH * MH  ;
constexpr size_t WS_DCT = 452 * MiB;
constexpr size_t WS_CT = 468 * MiB;
constexpr size_t WS_MLS = 476 * MiB;
constexpr size_t MLS_DN = 0, MLS_NC = 32768, MLS_SC = 65536, MLS_MC = 66048;
constexpr size_t WS_END2 = 477 * MiB;
constexpr int ML_TAB_OFF = LDSCTL_OFF + 2048;
constexpr int ML_MISC = 1280, ML_WSC = 1296;

__device__ __forceinline__ void ml_scalars(Frame& F, int row0, int h, float m0, LAS float* tab) {
    if (F.wave == 0) {
        const int l = F.lane; float lf[4], ig[4], b[4], u[4], pm[4];
#pragma unroll
        for (int i = 0; i < 4; ++i) { lf[i] = F.LF[(size_t)(row0 + 4 * l + i) * 4 + h]; ig[i] = F.IG[(size_t)(row0 + 4 * l + i) * 4 + h]; }
        b[0] = lf[0]; b[1] = b[0] + lf[1]; b[2] = b[1] + lf[2]; b[3] = b[2] + lf[3];
        float x = b[3];
#pragma unroll
        for (int o = 1; o < 64; o <<= 1) { const float y = __shfl_up(x, o); if (l >= o) x += y; }
        const float excl = x - b[3];
#pragma unroll
        for (int i = 0; i < 4; ++i) { b[i] += excl; u[i] = ig[i] - b[i]; }
        pm[0] = u[0]; pm[1] = fmaxf(pm[0], u[1]); pm[2] = fmaxf(pm[1], u[2]); pm[3] = fmaxf(pm[2], u[3]);
        float xm = pm[3];
#pragma unroll
        for (int o = 1; o < 64; o <<= 1) { const float y = __shfl_up(xm, o); if (l >= o) xm = fmaxf(xm, y); }
        float em = __shfl_up(xm, 1); if (l == 0) em = -INFINITY;
        em = fmaxf(em, m0);
#pragma unroll
        for (int i = 0; i < 4; ++i) { tab[4 * l + i] = b[i]; tab[256 + 4 * l + i] = u[i]; tab[512 + 4 * l + i] = fmaxf(em, pm[i]); }
        if (l == 63) { tab[ML_MISC] = xm; tab[ML_MISC + 1] = b[3]; }
    }
}
template <bool SCALE>
__device__ __forceinline__ void stage_T128(Frame& F, const bf16* src, LAS unsigned char* tile, const LAS float* utab, float Mloc) {
    v4u w[8];
#pragma unroll
    for (int i = 0; i < 8; ++i) { const int piece = F.tid + 512 * i, token = piece >> 4, ch = piece & 15; w[i] = *(const v4u*)(src + (size_t)token * 512 + 8 * ch); }
    asm volatile("" : "+v"(w[0]), "+v"(w[1]), "+v"(w[2]), "+v"(w[3]), "+v"(w[4]), "+v"(w[5]), "+v"(w[6]), "+v"(w[7]));
#pragma unroll
    for (int i = 0; i < 8; ++i) {
        const int piece = F.tid + 512 * i, token = piece >> 4, ch = piece & 15;
        v4u x = w[i];
        if (SCALE) { const float g = __expf(utab[token] - Mloc); unsigned ww[4] = {x.x, x.y, x.z, x.w};
#pragma unroll
            for (int k = 0; k < 4; ++k) ww[k] = pk2(__builtin_bit_cast(float, ww[k] << 16) * g, __builtin_bit_cast(float, ww[k] & 0xffff0000u) * g);
            x.x = ww[0]; x.y = ww[1]; x.z = ww[2]; x.w = ww[3]; }
        *(LAS v4u*)(tile + (ch >> 2) * (MLC * 64) + token * 64 + (ch & 3) * 16) = x;
    }
}
__device__ __forceinline__ void stage_R128(Frame& F, const bf16* src, LAS unsigned char* tile) {
    v4u w[8];
#pragma unroll
    for (int i = 0; i < 8; ++i) { const int piece = F.tid + 512 * i, token = piece >> 4, ch = piece & 15; w[i] = *(const v4u*)(src + (size_t)token * 512 + 8 * ch); }
    asm volatile("" : "+v"(w[0]), "+v"(w[1]), "+v"(w[2]), "+v"(w[3]), "+v"(w[4]), "+v"(w[5]), "+v"(w[6]), "+v"(w[7]));
#pragma unroll
    for (int i = 0; i < 8; ++i) { const int piece = F.tid + 512 * i, token = piece >> 4, ch = piece & 15; *(LAS v4u*)(tile + ch * (MLC * 16) + token * 16) = w[i]; }
}
__device__ __forceinline__ void mlstm_stepA(Frame& F, int unit) {
    const int seq = unit >> 4, c = unit & 15, b = seq >> 2, h = seq & 3, row0 = b * SEQ + c * MLC;
    LAS float* tab = (LAS float*)(F.lds + ML_TAB_OFF);
    LAS unsigned char* KT = F.lds + RING_OFF; LAS unsigned char* VT = F.lds + RING_OFF + 65536;
    float* mls = (float*)((unsigned char*)F.ws + WS_MLS);
    v4u kw[8], vw[8];
    { const bf16* ksrc = SEG_MK(F) + (size_t)row0 * MW + h * MD; const bf16* vsrc = SEG_MV(F) + (size_t)row0 * MW + h * MD;
#pragma unroll
      for (int i = 0; i < 8; ++i) { const int piece = F.tid + 512 * i, token = piece >> 4, ch = piece & 15; kw[i] = *(const v4u*)(ksrc + (size_t)token * 512 + 8 * ch); vw[i] = *(const v4u*)(vsrc + (size_t)token * 512 + 8 * ch); } }
    ml_scalars(F, row0, h, -INFINITY, tab);
    asm volatile("" : "+v"(kw[0]), "+v"(kw[1]), "+v"(kw[2]), "+v"(kw[3]), "+v"(kw[4]), "+v"(kw[5]), "+v"(kw[6]), "+v"(kw[7]));
    asm volatile("" : "+v"(vw[0]), "+v"(vw[1]), "+v"(vw[2]), "+v"(vw[3]), "+v"(vw[4]), "+v"(vw[5]), "+v"(vw[6]), "+v"(vw[7]));
    __syncthreads();
    const float Mloc = tab[ML_MISC];
#pragma unroll
    for (int i = 0; i < 8; ++i) {
        const int piece = F.tid + 512 * i, token = piece >> 4, ch = piece & 15;
        const float g = __expf(tab[256 + token] - Mloc); unsigned ww[4] = {kw[i].x, kw[i].y, kw[i].z, kw[i].w};
#pragma unroll
        for (int k = 0; k < 4; ++k) ww[k] = pk2(__builtin_bit_cast(float, ww[k] << 16) * g, __builtin_bit_cast(float, ww[k] & 0xffff0000u) * g);
        v4u x; x.x = ww[0]; x.y = ww[1]; x.z = ww[2]; x.w = ww[3];
        const int off = (ch >> 2) * (MLC * 64) + token * 64 + (ch & 3) * 16;
        *(LAS v4u*)(KT + off) = x; *(LAS v4u*)(VT + off) = vw[i];
    }
    __syncthreads();
    const int et = F.wave >> 1, dt0 = 2 * (F.wave & 1);
    f32x16 acc0 = {}, acc1 = {};
#pragma unroll 4
    for (int s = 0; s < 16; ++s) {
        const bf16x8 a = tfrag(VT, MLC, s, et, F.lane), b0 = tfrag(KT, MLC, s, dt0, F.lane), b1 = tfrag(KT, MLC, s, dt0 + 1, F.lane);
        acc0 = mfma32(a, b0, acc0); acc1 = mfma32(a, b1, acc1);
    }
    float* dct = (float*)((unsigned char*)F.ws + WS_DCT) + ((size_t)(seq * NCH + c)) * MD * MD;
    const int hi = F.lane >> 5, cl = F.lane & 31;
#pragma unroll
    for (int r = 0; r < 16; ++r) { const int e = 32 * et + crow(r, hi); dct[(size_t)e * MD + 32 * dt0 + cl] = acc0[r]; dct[(size_t)e * MD + 32 * (dt0 + 1) + cl] = acc1[r]; }
    { const int d = F.tid & 127, qd = F.tid >> 7; float s = 0.f;
      const LAS unsigned short* kp = (const LAS unsigned short*)(KT + (d >> 5) * (MLC * 64) + (d & 31) * 2);
#pragma unroll 8
      for (int j = 0; j < 64; ++j) s += bf2f(kp[(size_t)(64 * qd + j) * 32]);
      tab[768 + F.tid] = s; }
    __syncthreads();
    if (F.tid < 128) mls[MLS_DN + (size_t)(seq * NCH + c) * MD + F.tid] = (tab[768 + F.tid] + tab[768 + 128 + F.tid]) + (tab[768 + 256 + F.tid] + tab[768 + 384 + F.tid]);
    if (F.tid == 0) { mls[MLS_SC + (seq * NCH + c) * 2] = Mloc; mls[MLS_SC + (seq * NCH + c) * 2 + 1] = tab[ML_MISC + 1]; }
    __syncthreads();
}
__device__ __forceinline__ void mlstm_stepB(Frame& F, int unit) {
    const int seq = unit >> 4, sl = unit & 15, d = F.tid & 127, el = F.tid >> 7, e0 = 8 * sl + el, e1 = e0 + 4;
    float* mls = (float*)((unsigned char*)F.ws + WS_MLS);
    const float* dctb = (const float*)((unsigned char*)F.ws + WS_DCT) + (size_t)seq * NCH * MD * MD;
    bf16* ctb = (bf16*)((unsigned char*)F.ws + WS_CT) + (size_t)seq * NCH * MD * MD;
    float x0[NCH], x1[NCH], dn[NCH];
#pragma unroll
    for (int c = 0; c < NCH; ++c) { x0[c] = dctb[(size_t)c * MD * MD + (size_t)e0 * MD + d]; x1[c] = dctb[(size_t)c * MD * MD + (size_t)e1 * MD + d]; dn[c] = mls[MLS_DN + (size_t)(seq * NCH + c) * MD + d]; }
    float C0 = 0.f, C1 = 0.f, nv = 0.f, m = 0.f;
    const bool nwriter = (sl == 0) && (el == 0);
#pragma unroll
    for (int c = 0; c < NCH; ++c) {
        ctb[(size_t)c * MD * MD + (size_t)e0 * MD + d] = (bf16)f2bf(C0); ctb[(size_t)c * MD * MD + (size_t)e1 * MD + d] = (bf16)f2bf(C1);
        if (nwriter) { mls[MLS_NC + (size_t)(seq * NCH + c) * MD + d] = nv; if (d == 0) mls[MLS_MC + seq * NCH + c] = m; }
        const float Mloc = mls[MLS_SC + (seq * NCH + c) * 2], bL = mls[MLS_SC + (seq * NCH + c) * 2 + 1];
        const float Mt = fmaxf(m, Mloc), fa = __expf(m - Mt), fb = __expf(Mloc - Mt);
        C0 = fa * C0 + fb * x0[c]; C1 = fa * C1 + fb * x1[c]; nv = fa * nv + fb * dn[c];
        m = bL + Mt;
    }
    F.out[O_CP + (size_t)seq * MD * MD + (size_t)d * MD + e0] = C0; F.out[O_CP + (size_t)seq * MD * MD + (size_t)d * MD + e1] = C1;
    if (nwriter) { F.out[O_NP + (size_t)seq * MD + d] = nv; if (d == 0) F.out[O_MP + seq] = m; }
}
__device__ __forceinline__ void mlstm_stepC(Frame& F, int unit) {
    const int seq = unit >> 4, c = unit & 15, b = seq >> 2, h = seq & 3, row0 = b * SEQ + c * MLC;
    LAS float* tab = (LAS float*)(F.lds + ML_TAB_OFF);
    LAS unsigned char* KR = F.lds + RING_OFF; LAS unsigned char* VT = F.lds + RING_OFF + 65536;
    const float* mls = (const float*)((unsigned char*)F.ws + WS_MLS);
    const float m0 = mls[MLS_MC + seq * NCH + c];
    v4u kw[8], vw[8];
    { const bf16* ksrc = SEG_MK(F) + (size_t)row0 * MW + h * MD; const bf16* vsrc = SEG_MV(F) + (size_t)row0 * MW + h * MD;
#pragma unroll
      for (int i = 0; i < 8; ++i) { const int piece = F.tid + 512 * i, token = piece >> 4, ch = piece & 15; kw[i] = *(const v4u*)(ksrc + (size_t)token * 512 + 8 * ch); vw[i] = *(const v4u*)(vsrc + (size_t)token * 512 + 8 * ch); } }
    ml_scalars(F, row0, h, m0, tab);
    if (F.tid < 128) tab[768 + F.tid] = mls[MLS_NC + (size_t)(seq * NCH + c) * MD + F.tid];
    asm volatile("" : "+v"(kw[0]), "+v"(kw[1]), "+v"(kw[2]), "+v"(kw[3]), "+v"(kw[4]), "+v"(kw[5]), "+v"(kw[6]), "+v"(kw[7]));
    asm volatile("" : "+v"(vw[0]), "+v"(vw[1]), "+v"(vw[2]), "+v"(vw[3]), "+v"(vw[4]), "+v"(vw[5]), "+v"(vw[6]), "+v"(vw[7]));
#pragma unroll
    for (int i = 0; i < 8; ++i) { const int piece = F.tid + 512 * i, token = piece >> 4, ch = piece & 15;
        *(LAS v4u*)(KR + ch * (MLC * 16) + token * 16) = kw[i];
        *(LAS v4u*)(VT + (ch >> 2) * (MLC * 64) + token * 64 + (ch & 3) * 16) = vw[i]; }
    __syncthreads();
    const int w = F.wave, lane = F.lane, tl = lane & 31, hi = lane >> 5, t0 = 32 * w, t = t0 + tl;
    bf16x8 qf[8];
    { const bf16* qp = SEG_MQ(F) + (size_t)(row0 + t) * MW + h * MD + 8 * hi;
#pragma unroll
      for (int s = 0; s < 8; ++s) qf[s] = *(const bf16x8*)(qp + 16 * s); }
    float qn = 0.f;
#pragma unroll
    for (int s = 0; s < 8; ++s)
#pragma unroll
        for (int i = 0; i < 8; ++i) qn += bf2f((unsigned short)qf[s][i]) * tab[768 + 16 * s + 8 * hi + i];
    qn = half_swap_add(qn);
    const float Mt = tab[512 + t], wt = __expf(m0 - Mt);
    f32x16 acc[4];
    const bf16* ct = (const bf16*)((unsigned char*)F.ws + WS_CT) + (size_t)(seq * NCH + c) * MD * MD;
#pragma unroll
    for (int et = 0; et < 4; ++et) { acc[et] = (f32x16){};
#pragma unroll
        for (int s = 0; s < 8; ++s) { const bf16x8 cf = *(const bf16x8*)(ct + (size_t)(32 * et + tl) * MD + 16 * s + 8 * hi); acc[et] = mfma32(qf[s], cf, acc[et]); } }
    LAS float* wsc = tab + ML_WSC + 64 * w;
    if (hi == 0) wsc[tl] = wt;
    asm volatile("s_waitcnt lgkmcnt(0)" ::: "memory");
#pragma unroll
    for (int r = 0; r < 16; ++r) { const float ws_ = wsc[crow(r, hi)];
#pragma unroll
        for (int et = 0; et < 4; ++et) acc[et][r] *= ws_; }
    float rs = 0.f;
    for (int jt = 0; jt <= w; ++jt) {
        f32x16 st = {};
#pragma unroll
        for (int s = 0; s < 8; ++s) st = mfma32(rfrag(KR, MLC, jt, s, lane), qf[s], st);
#pragma unroll
        for (int r = 0; r < 16; ++r) { const int j = 32 * jt + crow(r, hi); const float v = st[r] * __expf(tab[256 + j] - Mt); st[r] = (j <= t) ? v : 0.f; rs += st[r]; }
        bf16x8 pa0, pa1;
#pragma unroll
        for (int i = 0; i < 4; ++i) { const unsigned p0 = pk2(st[2 * i], st[2 * i + 1]), p1 = pk2(st[8 + 2 * i], st[8 + 2 * i + 1]);
            pa0[2 * i] = (short)(p0 & 0xffff); pa0[2 * i + 1] = (short)(p0 >> 16); pa1[2 * i] = (short)(p1 & 0xffff); pa1[2 * i + 1] = (short)(p1 >> 16); }
#pragma unroll
        for (int et = 0; et < 4; ++et) { acc[et] = mfma32(pa0, tfrag(VT, MLC, 2 * jt, et, lane), acc[et]); acc[et] = mfma32(pa1, tfrag(VT, MLC, 2 * jt + 1, et, lane), acc[et]); }
    }
    rs = half_swap_add(rs);
    const float den = wt * qn + rs, mt = tab[t] + Mt, sc = 1.f / fmaxf(fabsf(den), __expf(-mt));
    asm volatile("s_waitcnt lgkmcnt(0)" ::: "memory");
    if (hi == 0) wsc[32 + tl] = sc;
    asm volatile("s_waitcnt lgkmcnt(0)" ::: "memory");
    __syncthreads();
    LAS float* hl = (LAS float*)(F.lds + RING_OFF) + w * 4096;
#pragma unroll
    for (int r = 0; r < 16; ++r) { const int tr = crow(r, hi); const float s_ = wsc[32 + tr];
#pragma unroll
        for (int et = 0; et < 4; ++et) hl[tr * 128 + 32 * et + tl] = acc[et][r] * s_; }
    asm volatile("s_waitcnt lgkmcnt(0)" ::: "memory");
    {
        const float g0 = F.ml_norm[h * MD + 2 * lane], g1 = F.ml_norm[h * MD + 2 * lane + 1];
#pragma unroll
        for (int hb = 0; hb < 2; ++hb) {
            unsigned mo[16];
#pragma unroll
            for (int i = 0; i < 16; ++i) mo[i] = *(const unsigned*)(SEG_MO(F) + (size_t)(row0 + 32 * w + 16 * hb + i) * MW + h * MD + 2 * lane);
#pragma unroll
            for (int i = 0; i < 16; ++i) { const size_t row = (size_t)(row0 + 32 * w + 16 * hb + i);
                typedef float f32x2_l __attribute__((ext_vector_type(2))); const f32x2_l hv = *(const LAS f32x2_l*)(hl + (16 * hb + i) * 128 + 2 * lane);
                const float rstd = 1.f / sqrtf(wave_sum(hv.x * hv.x + hv.y * hv.y) * (1.f / MD) + RMS_EPS);
                const float z0 = __builtin_bit_cast(float, mo[i] << 16), z1 = __builtin_bit_cast(float, mo[i] & 0xffff0000u);
                *(unsigned*)(F.MIX + row * D + AW + h * MD + 2 * lane) = pk2(hv.x * rstd * g0 / (1.f + __expf(-z0)), hv.y * rstd * g1 / (1.f + __expf(-z1))); }
        }
    }
    __syncthreads();
}

__device__ __forceinline__ void mlstm_sample_full(Frame& F, int seq) {
    const int sb = seq >> 2, h = seq & 3, e = F.tid & 127, dq = F.tid >> 7, row0 = MP + sb * DS;
    LAS float* red = (LAS float*)(F.lds + RING_OFF);
    float C[32], nn[32];
    const float* C0 = F.state_C + (size_t)seq * MD * MD;
#pragma unroll
    for (int i = 0; i < 32; ++i) { C[i] = C0[(size_t)(32 * dq + i) * MD + e]; nn[i] = F.state_n[(size_t)seq * MD + 32 * dq + i]; }
    float mm = F.state_m[seq];
    LAS unsigned* inb = (LAS unsigned*)(red + 2048);
    LAS float* gts = red + 2048 + 1536;
    __syncthreads();
    for (int i = F.tid; i < DS * 3 * 64; i += NWAVES * 64) { const int t = i / 192, r = i % 192, which = r >> 6, wd = r & 63;
        inb[i] = *((const unsigned*)(F.SEG + (size_t)(3 + which) * SEG_ELEMS + (size_t)(row0 + t) * MW + h * MD) + wd); }
    if (F.tid < DS * 2) { const int t = F.tid >> 1; gts[F.tid] = (F.tid & 1) ? F.LF[(size_t)(row0 + t) * 4 + h] : F.IG[(size_t)(row0 + t) * 4 + h]; }
    __syncthreads();
    for (int t = 0; t < DS; ++t) {
        const LAS v4u* qp = (const LAS v4u*)(inb + t * 192) + 4 * dq; const LAS v4u* kp = (const LAS v4u*)(inb + t * 192 + 64) + 4 * dq;
        const unsigned vw = inb[t * 192 + 128 + (e >> 1)]; const float v = __builtin_bit_cast(float, (e & 1) ? (vw & 0xffff0000u) : (vw << 16));
        const float ig = gts[2 * t], lf = gts[2 * t + 1];
        const float mn = fmaxf(lf + mm, ig), fs = __expf(lf + mm - mn), is = __expf(ig - mn);
        float num = 0.f, den = 0.f;
#pragma unroll
        for (int c = 0; c < 4; ++c) { const v4u qw = qp[c], kw = kp[c]; const unsigned qq[4] = {qw.x, qw.y, qw.z, qw.w}, kk[4] = {kw.x, kw.y, kw.z, kw.w};
#pragma unroll
            for (int j = 0; j < 8; ++j) { const int i = 8 * c + j;
                const float qv = __builtin_bit_cast(float, (j & 1) ? (qq[j >> 1] & 0xffff0000u) : (qq[j >> 1] << 16)), kv = __builtin_bit_cast(float, (j & 1) ? (kk[j >> 1] & 0xffff0000u) : (kk[j >> 1] << 16));
                C[i] = fs * C[i] + is * kv * v; nn[i] = fs * nn[i] + is * kv; num += qv * C[i]; den += qv * nn[i]; } }
        mm = mn;
        red[dq * 128 + e] = num; red[512 + dq * 128 + e] = den;
        __syncthreads();
        if (dq == 0) { const float nu = (red[e] + red[128 + e]) + (red[256 + e] + red[384 + e]), de = (red[512 + e] + red[640 + e]) + (red[768 + e] + red[896 + e]);
            red[1024 + t * 128 + e] = nu / fmaxf(fabsf(de), __expf(-mn)); }
        __syncthreads();
    }
    { const int t = F.wave; const size_t row = (size_t)(row0 + t);
      const float h0 = red[1024 + t * 128 + 2 * F.lane], h1 = red[1024 + t * 128 + 2 * F.lane + 1];
      const float rstd = 1.f / sqrtf(wave_sum(h0 * h0 + h1 * h1) * (1.f / MD) + RMS_EPS);
      const unsigned mo = *(const unsigned*)(SEG_MO(F) + row * MW + h * MD + 2 * F.lane);
      const float z0 = __builtin_bit_cast(float, mo << 16), z1 = __builtin_bit_cast(float, mo & 0xffff0000u);
      const float g0 = F.ml_norm[h * MD + 2 * F.lane], g1 = F.ml_norm[h * MD + 2 * F.lane + 1];
      *(unsigned*)(F.MIX + row * D + AW + h * MD + 2 * F.lane) = pk2(h0 * rstd * g0 / (1.f + __expf(-z0)), h1 * rstd * g1 / (1.f + __expf(-z1))); }
    float* Co = F.out + O_CS + (size_t)seq * MD * MD;
#pragma unroll
    for (int i = 0; i < 32; ++i) Co[(size_t)(32 * dq + i) * MD + e] = C[i];
    if (e == 0) {
#pragma unroll
        for (int i = 0; i < 32; ++i) F.out[O_NS + (size_t)seq * MD + 32 * dq + i] = nn[i];
        if (dq == 0) F.out[O_MS + seq] = mm;
    }
    __syncthreads();
}

constexpr size_t WS_LIST = 480 * MiB;
constexpr size_t WS_CNT = 484 * MiB;
constexpr size_t WS_PARTO = 485 * MiB;
constexpr size_t WS_PARTS = 534 * MiB;
constexpr size_t WS_END3 = 538 * MiB;
constexpr size_t WS_QG = 560 * MiB;
constexpr size_t WS_END_QG = 682 * MiB;
__host__ __device__ constexpr int past_item_index(int bh, int n, int o) { return bh * 120 + 15 * n - (n * (n - 1)) / 2 + (o - n - 1); }
constexpr int AT_WSC = 192;
constexpr int AT_LUT = 768;

__device__ __forceinline__ void build_lut(Frame& F, const LAS int* bucket, int h, LAS float* lut) {
    if (F.tid < 128) lut[F.tid] = F.rel_bias[bucket[F.tid] * AH + h];
    if (F.tid == 128) lut[128] = F.rel_bias[31 * AH + h];
}
__device__ __forceinline__ void stage_kv64(Frame& F, const bf16* ksrc, const bf16* vsrc, LAS unsigned char* KR, LAS unsigned char* VT) {
    v4u kk[4], vv[4];
#pragma unroll
    for (int i = 0; i < 4; ++i) { const int piece = F.tid + 512 * i, key = piece >> 3, ch = piece & 7;
        kk[i] = *(const v4u*)(ksrc + (size_t)key * AW + 8 * ch); vv[i] = *(const v4u*)(vsrc + (size_t)key * AW + 8 * ch); }
    asm volatile("" : "+v"(kk[0]), "+v"(kk[1]), "+v"(kk[2]), "+v"(kk[3]), "+v"(vv[0]), "+v"(vv[1]), "+v"(vv[2]), "+v"(vv[3]));
#pragma unroll
    for (int i = 0; i < 4; ++i) { const int piece = F.tid + 512 * i, key = piece >> 3, ch = piece & 7;
        *(LAS v4u*)(KR + ch * (256 * 16) + key * 16) = kk[i];
        *(LAS v4u*)(VT + (ch >> 2) * (256 * 64) + key * 64 + (ch & 3) * 16) = vv[i]; }
}
__device__ __forceinline__ void attn_select2(Frame& F, int ua, int ub) {
    const int half = F.tid >> 8, qt = F.tid & 255, unit = half ? ub : ua;
    const bool act = unit >= 0;
    const int bh = act ? unit / 15 : 0, o = act ? unit % 15 + 1 : 1, b = bh >> 3, h = bh & 7;
    LAS float* ks = (LAS float*)(F.lds + RING_OFF + half * 8192);
    LAS int* cnt = (LAS int*)(F.lds + RING_OFF + half * 8192 + 4096);
    __syncthreads();
    const int m = b * SEQ + o * 256 + qt;
    v4u qw[8];
    { const v4u* qp = (const v4u*)(SEG_AQ(F) + (size_t)m * AW + h * AD);
#pragma unroll
      for (int c = 0; c < 8; ++c) qw[c] = act ? qp[c] : (v4u){0u, 0u, 0u, 0u}; }
    float kv[4];
#pragma unroll
    for (int i = 0; i < 4; ++i) { const int idx = qt + 256 * i; kv[i] = (act && idx < o * 64) ? F.KSUM[((size_t)(b * NBLK_P + (idx >> 6))) * AW + h * AD + (idx & 63)] : 0.f; }
#pragma unroll
    for (int i = 0; i < 4; ++i) { const int idx = qt + 256 * i; if (idx < 15 * 64) ks[idx] = kv[i]; }
    if (qt < 16) cnt[qt] = 0;
    __syncthreads();
    if (act) {
        float q[64];
#pragma unroll
        for (int c = 0; c < 8; ++c) { const v4u w = qw[c];
            q[8 * c + 0] = __builtin_bit_cast(float, w.x << 16); q[8 * c + 1] = __builtin_bit_cast(float, w.x & 0xffff0000u);
            q[8 * c + 2] = __builtin_bit_cast(float, w.y << 16); q[8 * c + 3] = __builtin_bit_cast(float, w.y & 0xffff0000u);
            q[8 * c + 4] = __builtin_bit_cast(float, w.z << 16); q[8 * c + 5] = __builtin_bit_cast(float, w.z & 0xffff0000u);
            q[8 * c + 6] = __builtin_bit_cast(float, w.w << 16); q[8 * c + 7] = __builtin_bit_cast(float, w.w & 0xffff0000u); }
        float s0 = -INFINITY, s1 = -INFINITY, s2 = -INFINITY; int i0 = -1, i1 = -1, i2 = -1;
        for (int n = 0; n < o; ++n) {
            float s = 0.f;
#pragma unroll
            for (int d = 0; d < 64; ++d) s += q[d] * ks[n * 64 + d];
            if (s > s0) { s2 = s1; i2 = i1; s1 = s0; i1 = i0; s0 = s; i0 = n; }
            else if (s > s1) { s2 = s1; i2 = i1; s1 = s; i1 = n; }
            else if (s > s2) { s2 = s; i2 = n; }
        }
        unsigned short* list = (unsigned short*)(F.ws + WS_LIST);
#pragma unroll
        for (int j = 0; j < 3; ++j) {
            const int n = (j == 0) ? i0 : (j == 1 ? i1 : i2);
            if (n >= 0) { const int slot = __hip_atomic_fetch_add(&cnt[n], 1, __ATOMIC_RELAXED, __HIP_MEMORY_SCOPE_WORKGROUP);
                const size_t e = (size_t)past_item_index(bh, n, o) * 256 + slot;
                list[e] = (unsigned short)(qt | (j << 8));
                v4u* qg = (v4u*)((bf16*)(F.ws + WS_QG) + e * 64);
#pragma unroll
                for (int c = 0; c < 8; ++c) qg[c] = qw[c]; }
        }
    }
    __syncthreads();
    if (act && qt < o) ((int*)(F.ws + WS_CNT))[past_item_index(bh, qt, o)] = cnt[qt];
}
struct AttnOut { f32x16 o0, o1; float mx, l; };
__device__ __forceinline__ float max3f(float a, float b, float c) { float r; asm("v_max3_f32 %0, %1, %2, %3" : "=v"(r) : "v"(a), "v"(b), "v"(c)); return r; }
__device__ __forceinline__ void pack_p(const f32x16& p, bf16x8& pa0, bf16x8& pa1) {
#pragma unroll
    for (int i = 0; i < 4; ++i) { const unsigned p0 = pk2(p[2 * i], p[2 * i + 1]), p1 = pk2(p[8 + 2 * i], p[8 + 2 * i + 1]);
        pa0[2 * i] = (short)(p0 & 0xffff); pa0[2 * i + 1] = (short)(p0 >> 16); pa1[2 * i] = (short)(p1 & 0xffff); pa1[2 * i + 1] = (short)(p1 >> 16); }
}
template <bool CAUSAL>
__device__ __forceinline__ f32x16 score_tile(const LAS unsigned char* KR, const bf16x8 (&qf)[4], int lane, int kt, int tq, bool lutp, const LAS float* lut, float b31) {
    const int hi = lane >> 5;
    f32x16 a = {};
#pragma unroll
    for (int s = 0; s < 4; ++s) a = mfma32(rfrag(KR, 256, kt, s, lane), qf[s], a);
    if (lutp) {
#pragma unroll
        for (int r = 0; r < 16; ++r) { const int key = 32 * kt + crow(r, hi); int dist = tq - key; dist = dist < 0 ? 0 : (dist > 128 ? 128 : dist); a[r] += lut[dist]; if (CAUSAL && key > tq) a[r] = -INFINITY; }
    } else {
#pragma unroll
        for (int r = 0; r < 16; ++r) a[r] += b31;
    }
    return a;
}
template <bool CAUSAL>
__device__ __forceinline__ AttnOut wave_attend(const LAS unsigned char* KR, const LAS unsigned char* VT, const bf16x8 (&qf)[4], int lane, int nkt  ,
                                               int tq  , bool use_lut  , int lut_from_kt  , const LAS float* lut, float b31, int kt0 = 0  ) {
    AttnOut R; R.o0 = (f32x16){}; R.o1 = (f32x16){}; R.mx = -1e30f; R.l = 0.f;
    for (int kt = kt0; kt < nkt; kt += 2) {
        const bool two = (kt + 1 < nkt);
        f32x16 a0 = score_tile<CAUSAL>(KR, qf, lane, kt, tq, use_lut && kt >= lut_from_kt, lut, b31);
        f32x16 a1 = a0;
        if (two) a1 = score_tile<CAUSAL>(KR, qf, lane, kt + 1, tq, use_lut && kt + 1 >= lut_from_kt, lut, b31);
        float cm0 = max3f(a0[0], a0[1], a1[0]), cm1 = max3f(a0[2], a0[3], a1[1]);
        cm0 = max3f(cm0, a1[2], a1[3]);
#pragma unroll
        for (int r = 4; r < 16; r += 4) { cm0 = max3f(cm0, a0[r], a0[r + 1]); cm1 = max3f(cm1, a0[r + 2], a0[r + 3]); cm0 = max3f(cm0, a1[r], a1[r + 1]); cm1 = max3f(cm1, a1[r + 2], a1[r + 3]); }
        float cm = max3f(cm0, cm1, cm1);
        cm = fmaxf(cm, __shfl_xor(cm, 32));
        constexpr float L2E = 1.4426950408889634f;
        const float mn = fmaxf(R.mx, cm), f = __builtin_amdgcn_exp2f((R.mx - mn) * L2E), mnl = mn * L2E;
        R.mx = mn; R.l *= f;
#pragma unroll
        for (int r = 0; r < 16; ++r) { R.o0[r] *= f; R.o1[r] *= f; }
        float ls = 0.f;
#pragma unroll
        for (int r = 0; r < 16; ++r) { a0[r] = __builtin_amdgcn_exp2f(fmaf(a0[r], L2E, -mnl)); ls += a0[r]; }
        bf16x8 pa0, pa1;
        pack_p(a0, pa0, pa1);
        R.o0 = mfma32(tfrag(VT, 256, 2 * kt, 0, lane), pa0, R.o0); R.o1 = mfma32(tfrag(VT, 256, 2 * kt, 1, lane), pa0, R.o1);
        R.o0 = mfma32(tfrag(VT, 256, 2 * kt + 1, 0, lane), pa1, R.o0); R.o1 = mfma32(tfrag(VT, 256, 2 * kt + 1, 1, lane), pa1, R.o1);
        if (two) {
#pragma unroll
            for (int r = 0; r < 16; ++r) { a1[r] = __builtin_amdgcn_exp2f(fmaf(a1[r], L2E, -mnl)); ls += a1[r]; }
            pack_p(a1, pa0, pa1);
            R.o0 = mfma32(tfrag(VT, 256, 2 * kt + 2, 0, lane), pa0, R.o0); R.o1 = mfma32(tfrag(VT, 256, 2 * kt + 2, 1, lane), pa0, R.o1);
            R.o0 = mfma32(tfrag(VT, 256, 2 * kt + 3, 0, lane), pa1, R.o0); R.o1 = mfma32(tfrag(VT, 256, 2 * kt + 3, 1, lane), pa1, R.o1);
        }
        R.l += ls;
    }
    R.l += __shfl_xor(R.l, 32);
    return R;
}
constexpr int PAST_NITEMS = 32 * 120;
__device__ __forceinline__ void past_item_decode(int it, int& bh, int& n, int& o) { bh = it / 120; int pr = it % 120; n = 0; while (pr >= 15 - n) { pr -= 15 - n; ++n; } o = n + 1 + pr; }
__device__ __forceinline__ void attn_past_items(Frame& F, const LAS int* bucket) {
    LAS unsigned char* KR = F.lds + RING_OFF; LAS unsigned char* VT = F.lds + RING_OFF + 32768;
    LAS int* S = (LAS int*)(F.lds + RING_OFF + 65536);
    LAS int* C = S + 4096;
    LAS int* wsum = C + 4096;
    const int lane = F.lane, tl = lane & 31, hi = lane >> 5;
    const int* cntg = (const int*)(F.ws + WS_CNT);
    __syncthreads();
    {
        int cc[8] = {0, 0, 0, 0, 0, 0, 0, 0};
        if (8 * F.tid < PAST_NITEMS) { const int4 a = *(const int4*)(cntg + 8 * F.tid), bq = *(const int4*)(cntg + 8 * F.tid + 4); cc[0] = a.x; cc[1] = a.y; cc[2] = a.z; cc[3] = a.w; cc[4] = bq.x; cc[5] = bq.y; cc[6] = bq.z; cc[7] = bq.w; }
        int g[8], tot = 0;
#pragma unroll
        for (int k = 0; k < 8; ++k) { g[k] = (cc[k] + 31) >> 5; tot += g[k]; }
        int x = tot;
#pragma unroll
        for (int o = 1; o < 64; o <<= 1) { const int y = __shfl_up(x, o); if (lane >= o) x += y; }
        if (lane == 63) wsum[F.wave] = x;
        __syncthreads();
        int base = x - tot;
#pragma unroll
        for (int w = 0; w < 8; ++w) if (w < F.wave) base += wsum[w];
#pragma unroll
        for (int k = 0; k < 8; ++k) { const int it = 8 * F.tid + k; if (it < PAST_NITEMS) { S[it] = base; C[it] = cc[k]; } base += g[k]; }
        if (F.tid == 511) S[PAST_NITEMS] = base;
        __syncthreads();
    }
    const int T = S[PAST_NITEMS];
    const int lo = (int)(((long long)T * blockIdx.x) / F.G), hiG = (int)(((long long)T * (blockIdx.x + 1)) / F.G);
    int it = 0;
    { int a = 0, b = PAST_NITEMS; while (b - a > 1) { const int m = (a + b) >> 1; if (S[m] <= lo) a = m; else b = m; } it = a; }
    while (lo < hiG && it < PAST_NITEMS && S[it] < hiG) {
        if (S[it + 1] == S[it] || S[it + 1] <= lo) { ++it; continue; }
        int bh, n, o0; past_item_decode(it, bh, n, o0);
        const int b = bh >> 3, h = bh & 7;
        const int run_end_item = it + (15 - o0) + 1;
        const int ra = S[it] > lo ? S[it] : lo;
        int rbx = S[run_end_item < PAST_NITEMS ? run_end_item : PAST_NITEMS]; const int rb = rbx < hiG ? rbx : hiG;
        int wi = it;
        int gamma = ra + F.wave;
        int p_dst = -1, p_tl = 0, p_o = 0; bf16x8 pq[4] = {};
        int r_dst = -1, r_tl = 0, r_o = 0; bf16x8 rq[4] = {};
#define PAST_FETCH(G_, DST_, TL_, O_, Q_) do { while (S[wi + 1] <= (G_)) ++wi; const int o_ = o0 + (wi - it); const int c_ = C[wi]; \
            const int qi_ = 32 * ((G_) - S[wi]) + tl; const bool v_ = qi_ < c_; const size_t e_ = (size_t)wi * 256 + (v_ ? qi_ : 0); \
            const unsigned ent_ = ((const unsigned short*)(F.ws + WS_LIST))[e_]; \
            const bf16* qp_ = (const bf16*)(F.ws + WS_QG) + e_ * 64 + 8 * hi; \
            _Pragma("unroll") for (int s_ = 0; s_ < 4; ++s_) (Q_)[s_] = *(const bf16x8*)(qp_ + 16 * s_); \
            (TL_) = ent_ & 255; (O_) = o_; (DST_) = v_ ? (((b * SEQ + o_ * 256 + (int)(ent_ & 255)) * AH + h) * 3 + (int)(ent_ >> 8)) : -1; } while (0)
        if (gamma < rb) PAST_FETCH(gamma, p_dst, p_tl, p_o, pq);
        if (gamma + 8 < rb) PAST_FETCH(gamma + 8, r_dst, r_tl, r_o, rq);
        __syncthreads();
        const LAS float* lut = LUT8(F) + h * 132;
        stage_kv64(F, SEG_AK(F) + (size_t)(b * SEQ + n * 256) * AW + h * AD, SEG_AV(F) + (size_t)(b * SEQ + n * 256) * AW + h * AD, KR, VT);
        __syncthreads();
        const float b31 = lut[128];
        while (gamma < rb) {
            const int dst = p_dst, t_local = p_tl; const bool adj = (p_o == n + 1);
            bf16x8 qf[4] = {pq[0], pq[1], pq[2], pq[3]};
            p_dst = r_dst; p_tl = r_tl; p_o = r_o; pq[0] = rq[0]; pq[1] = rq[1]; pq[2] = rq[2]; pq[3] = rq[3];
            if (gamma + 16 < rb) PAST_FETCH(gamma + 16, r_dst, r_tl, r_o, rq);
            AttnOut R = wave_attend<false>(KR, VT, qf, lane, 8, 256 + t_local, adj, 4, lut, b31);
            if (dst >= 0) {
                if (hi == 0) { float* ps = (float*)(F.ws + WS_PARTS) + (size_t)dst * 2; ps[0] = R.mx; ps[1] = R.l; }
                const float rl = 1.f / R.l;
                bf16* po = (bf16*)(F.ws + WS_PARTO) + (size_t)dst * 64 + 4 * hi;
#pragma unroll
                for (int g = 0; g < 4; ++g) {
                    *(unsigned long long*)(po + 8 * g) = (unsigned long long)pk2(R.o0[4 * g] * rl, R.o0[4 * g + 1] * rl) | ((unsigned long long)pk2(R.o0[4 * g + 2] * rl, R.o0[4 * g + 3] * rl) << 32);
                    *(unsigned long long*)(po + 32 + 8 * g) = (unsigned long long)pk2(R.o1[4 * g] * rl, R.o1[4 * g + 1] * rl) | ((unsigned long long)pk2(R.o1[4 * g + 2] * rl, R.o1[4 * g + 3] * rl) << 32);
                }
            }
            gamma += 8;
        }
#undef PAST_FETCH
        it = run_end_item;
    }
    __syncthreads();
}
struct OwnLoads { bf16x8 qf[4]; float pm[3], pl[3]; unsigned long long pw0[3][4], pw1[3][4]; };
__device__ __forceinline__ void own_group_load(Frame& F, int b, int h, int o, int grp, OwnLoads& L) {
    const int lane = F.lane, tl = lane & 31, hi = lane >> 5;
    const int row = b * SEQ + o * 256 + 32 * grp + tl;
    { const bf16* qp = SEG_AQ(F) + (size_t)row * AW + h * AD + 8 * hi;
#pragma unroll
      for (int s = 0; s < 4; ++s) L.qf[s] = *(const bf16x8*)(qp + 16 * s); }
    const int np = o < 3 ? o : 3;
    const float* ps = (const float*)(F.ws + WS_PARTS) + (size_t)(row * AH + h) * 6;
    const bf16* po = (const bf16*)(F.ws + WS_PARTO) + (size_t)(row * AH + h) * 3 * 64 + 4 * hi;
#pragma unroll
    for (int j = 0; j < 3; ++j) {
        if (j < np) { L.pm[j] = ps[2 * j]; L.pl[j] = ps[2 * j + 1];
#pragma unroll
            for (int g = 0; g < 4; ++g) { L.pw0[j][g] = *(const unsigned long long*)(po + j * 64 + 8 * g); L.pw1[j][g] = *(const unsigned long long*)(po + j * 64 + 32 + 8 * g); } }
        else { L.pm[j] = -INFINITY; L.pl[j] = 0.f;
#pragma unroll
            for (int g = 0; g < 4; ++g) { L.pw0[j][g] = 0ull; L.pw1[j][g] = 0ull; } }
    }
}
__device__ __forceinline__ void own_group_compute(Frame& F, const LAS unsigned char* KR, const LAS unsigned char* VT, const LAS float* lut, int b, int h, int o, int grp, const OwnLoads& L) {
    const int lane = F.lane, tl = lane & 31, hi = lane >> 5;
    const int t_local = 32 * grp + tl, row = b * SEQ + o * 256 + t_local, np = o < 3 ? o : 3;
    AttnOut R = wave_attend<true>(KR, VT, L.qf, lane, grp + 1, t_local, true, 0, lut, 0.f);
    float mt = R.mx;
#pragma unroll
    for (int j = 0; j < 3; ++j) mt = fmaxf(mt, L.pm[j]);
    const float e_own = __expf(R.mx - mt); float aj[3], Ls = e_own * R.l;
#pragma unroll
    for (int j = 0; j < 3; ++j) { aj[j] = (j < np) ? __expf(L.pm[j] - mt) * L.pl[j] : 0.f; Ls += aj[j]; }
    const float rL = 1.f / Ls, a_own = e_own * rL;
#pragma unroll
    for (int j = 0; j < 3; ++j) aj[j] *= rL;
    bf16* mp = F.MIX + (size_t)row * D + h * AD + 4 * hi;
#pragma unroll
    for (int g = 0; g < 4; ++g) {
        float v0[4], v1[4];
#pragma unroll
        for (int i = 0; i < 4; ++i) { v0[i] = R.o0[4 * g + i] * a_own; v1[i] = R.o1[4 * g + i] * a_own; }
#pragma unroll
        for (int j = 0; j < 3; ++j) {
#pragma unroll
            for (int i = 0; i < 4; ++i) { v0[i] += aj[j] * bf2f((unsigned short)(L.pw0[j][g] >> (16 * i))); v1[i] += aj[j] * bf2f((unsigned short)(L.pw1[j][g] >> (16 * i))); }
        }
        *(unsigned long long*)(mp + 8 * g) = (unsigned long long)pk2(v0[0], v0[1]) | ((unsigned long long)pk2(v0[2], v0[3]) << 32);
        *(unsigned long long*)(mp + 32 + 8 * g) = (unsigned long long)pk2(v1[0], v1[1]) | ((unsigned long long)pk2(v1[2], v1[3]) << 32);
    }
}
__device__ __forceinline__ void attn_own_pair(Frame& F, const LAS int* bucket, int ua, int ub) {
    const int bha = ua >> 4, oa = ua & 15, ba = bha >> 3, ha = bha & 7, bhb = ub >> 4, ob = ub & 15, bb = bhb >> 3, hb = bhb & 7;
    LAS unsigned char* KA = F.lds + RING_OFF; LAS unsigned char* VA = KA + 32768; LAS unsigned char* KB = KA + 65536; LAS unsigned char* VB = KA + 98304;
    const LAS float* lutA = LUT8(F) + ha * 132; const LAS float* lutB = LUT8(F) + hb * 132;
    __syncthreads();
    OwnLoads LA; own_group_load(F, ba, ha, oa, F.wave, LA);
    {
        const bf16* ka = SEG_AK(F) + (size_t)(ba * SEQ + oa * 256) * AW + ha * AD; const bf16* va = SEG_AV(F) + (size_t)(ba * SEQ + oa * 256) * AW + ha * AD;
        const bf16* kb = SEG_AK(F) + (size_t)(bb * SEQ + ob * 256) * AW + hb * AD; const bf16* vb = SEG_AV(F) + (size_t)(bb * SEQ + ob * 256) * AW + hb * AD;
        v4u x[16];
#pragma unroll
        for (int i = 0; i < 4; ++i) { const int piece = F.tid + 512 * i, key = piece >> 3, ch = piece & 7; const size_t off = (size_t)key * AW + 8 * ch;
            x[4 * i] = *(const v4u*)(ka + off); x[4 * i + 1] = *(const v4u*)(va + off); x[4 * i + 2] = *(const v4u*)(kb + off); x[4 * i + 3] = *(const v4u*)(vb + off); }
        asm volatile("" : "+v"(x[0]), "+v"(x[1]), "+v"(x[2]), "+v"(x[3]), "+v"(x[4]), "+v"(x[5]), "+v"(x[6]), "+v"(x[7]));
        asm volatile("" : "+v"(x[8]), "+v"(x[9]), "+v"(x[10]), "+v"(x[11]), "+v"(x[12]), "+v"(x[13]), "+v"(x[14]), "+v"(x[15]));
#pragma unroll
        for (int i = 0; i < 4; ++i) { const int piece = F.tid + 512 * i, key = piece >> 3, ch = piece & 7;
            const int ko = ch * (256 * 16) + key * 16, vo = (ch >> 2) * (256 * 64) + key * 64 + (ch & 3) * 16;
            *(LAS v4u*)(KA + ko) = x[4 * i]; *(LAS v4u*)(VA + vo) = x[4 * i + 1]; *(LAS v4u*)(KB + ko) = x[4 * i + 2]; *(LAS v4u*)(VB + vo) = x[4 * i + 3]; }
    }
    __syncthreads();
    OwnLoads LB; own_group_load(F, bb, hb, ob, 7 - F.wave, LB);
    own_group_compute(F, KA, VA, lutA, ba, ha, oa, F.wave, LA);
    own_group_compute(F, KB, VB, lutB, bb, hb, ob, 7 - F.wave, LB);
}
constexpr size_t WS_SELS = 538 * MiB;
constexpr size_t WS_PARTOS = 539 * MiB;
constexpr size_t WS_PARTSS = 540 * MiB;
constexpr size_t WS_KSUMP = 541 * MiB;
constexpr size_t WS_SITEMS = 545 * MiB;
constexpr size_t WS_END4 = 546 * MiB;
constexpr int CW_SITEMS = 8192;
__device__ __forceinline__ void sample_select(Frame& F) {
    LAS unsigned* um = (LAS unsigned*)(F.lds + RING_OFF);
    const int lane = F.lane, n = lane & 31, st = 2 * F.wave + (lane >> 5);
    for (int pr = blockIdx.x; pr < DB * AH; pr += F.G) {
        const int sb = pr >> 3, h = pr & 7;
        __syncthreads();
        if (F.tid == 0) um[0] = 0u;
        __syncthreads();
        if (F.wave < 4) {
            const int m = MP + sb * DS + st;
            v4u qw[8]; f32x4 ka[16], kb[16];
            { const v4u* qp = (const v4u*)(SEG_AQ(F) + (size_t)m * AW + h * AD);
#pragma unroll
              for (int c = 0; c < 8; ++c) qw[c] = qp[c]; }
            { const f32x4* k0 = (const f32x4*)((const float*)(F.ws + WS_KSUMP) + ((size_t)(sb * NPAGES + 2 * n)) * AW + h * AD); const f32x4* k1 = k0 + AW / 4;
#pragma unroll
              for (int c = 0; c < 16; ++c) { ka[c] = k0[c]; kb[c] = k1[c]; } }
            float s = 0.f;
#pragma unroll
            for (int c = 0; c < 8; ++c) { const unsigned ww[4] = {qw[c].x, qw[c].y, qw[c].z, qw[c].w};
                const f32x4 a0 = ka[2 * c] + kb[2 * c], a1 = ka[2 * c + 1] + kb[2 * c + 1];
                s += __builtin_bit_cast(float, ww[0] << 16) * a0.x + __builtin_bit_cast(float, ww[0] & 0xffff0000u) * a0.y + __builtin_bit_cast(float, ww[1] << 16) * a0.z + __builtin_bit_cast(float, ww[1] & 0xffff0000u) * a0.w
                   + __builtin_bit_cast(float, ww[2] << 16) * a1.x + __builtin_bit_cast(float, ww[2] & 0xffff0000u) * a1.y + __builtin_bit_cast(float, ww[3] << 16) * a1.z + __builtin_bit_cast(float, ww[3] & 0xffff0000u) * a1.w; }
            int sel[3]; unsigned mask = 0u;
#pragma unroll
            for (int j = 0; j < 3; ++j) {
                float v = s; int bn = n;
#pragma unroll
                for (int o = 1; o < 32; o <<= 1) { const float ov = __shfl_xor(v, o); const int on = __shfl_xor(bn, o); if (ov > v || (ov == v && on < bn)) { v = ov; bn = on; } }
                sel[j] = bn; mask |= 1u << bn;
                if (bn == n) s = -INFINITY;
            }
            if (n == 0) { int* so = (int*)(F.ws + WS_SELS) + (size_t)((sb * DS + st) * AH + h) * 3; so[0] = sel[0]; so[1] = sel[1]; so[2] = sel[2];
                __hip_atomic_fetch_or(um, mask, __ATOMIC_RELAXED, __HIP_MEMORY_SCOPE_WORKGROUP); }
        }
        __syncthreads();
        if (F.wave == 0) {
            const unsigned mask = um[0];
            unsigned base = 0u;
            if (lane == 0) base = __hip_atomic_fetch_add((unsigned*)(F.ctl + CW_SITEMS), (unsigned)__popc(mask), __ATOMIC_RELAXED, __HIP_MEMORY_SCOPE_AGENT);
            base = __shfl(base, 0);
            if (lane < 32 && ((mask >> lane) & 1u)) ((int*)(F.ws + WS_SITEMS))[base + __popc(mask & ((1u << lane) - 1u))] = (sb << 8) | (h << 5) | lane;
        }
    }
    __syncthreads();
}
struct KvRegs { f32x4 a[11], b[11]; };
__device__ __forceinline__ void load_kv64_paged(Frame& F, int sb, int n, int h, KvRegs& R) {
    const int pg0 = F.page_table[sb * NPAGES + 2 * n], pg1 = F.page_table[sb * NPAGES + 2 * n + 1];
    const int lt = F.tid - 128;
#pragma unroll
    for (int i = 0; i < 11; ++i) {
        const int piece = lt + 384 * i;
        if (i < 10 || piece < 4096) {
            const int idx = piece & 2047, key = idx >> 3, ch = idx & 7;
            const float* base = (piece < 2048) ? F.cache_k : F.cache_v;
            const float* src = base + ((size_t)((key < PAGE) ? pg0 : pg1) * PAGE + (key & (PAGE - 1))) * AW + h * AD + 8 * ch;
            R.a[i] = __builtin_nontemporal_load((const f32x4*)src); R.b[i] = __builtin_nontemporal_load((const f32x4*)(src + 4));
        }
    }
}
__device__ __forceinline__ void store_kv64_tiles(Frame& F, const KvRegs& R, LAS unsigned char* KR, LAS unsigned char* VT) {
    const int lt = F.tid - 128;
#pragma unroll
    for (int i = 0; i < 11; ++i) {
        const int piece = lt + 384 * i;
        if (i < 10 || piece < 4096) {
            const int idx = piece & 2047, key = idx >> 3, ch = idx & 7;
            const f32x4 x0 = R.a[i], x1 = R.b[i];
            v4u w; w.x = pk2(x0.x, x0.y); w.y = pk2(x0.z, x0.w); w.z = pk2(x1.x, x1.y); w.w = pk2(x1.z, x1.w);
            LAS unsigned char* dst = (piece < 2048) ? KR + ch * (256 * 16) + key * 16 : VT + (ch >> 2) * (256 * 64) + key * 64 + (ch & 3) * 16;
            *(LAS v4u*)dst = w;
        }
    }
}
__device__ __forceinline__ void sample_past_items(Frame& F, const LAS int* bucket) {
    LAS float* tab = (LAS float*)(F.lds + ML_TAB_OFF);
    const int lane = F.lane, tl = lane & 31, hi = lane >> 5;
    const int L = (int)__hip_atomic_load((unsigned*)(F.ctl + CW_SITEMS), __ATOMIC_RELAXED, __HIP_MEMORY_SCOPE_AGENT);
    const int* items = (const int*)(F.ws + WS_SITEMS);
    const int* sels = (const int*)(F.ws + WS_SELS);
    int idx = blockIdx.x, cur = 0;
#define ITEM_AT(k) items[idx + (k) * F.G]
#define HAS(k) (idx + (k) * F.G < L)
#define LOADER_STEP(RX) do { if (HAS(1)) { \
            LAS unsigned char* kb_ = F.lds + RING_OFF + (cur ^ 1) * 65536; store_kv64_tiles(F, RX, kb_, kb_ + 32768); \
            if (HAS(3)) { const int i3_ = ITEM_AT(3); load_kv64_paged(F, i3_ >> 8, i3_ & 31, (i3_ >> 5) & 7, RX); } } \
        __syncthreads(); cur ^= 1; idx += F.G; } while (0)
    __syncthreads();
    if (F.wave >= 2) {
        KvRegs RA, RB;
        if (HAS(0)) {
            const int it = ITEM_AT(0);
            load_kv64_paged(F, it >> 8, it & 31, (it >> 5) & 7, RA); store_kv64_tiles(F, RA, F.lds + RING_OFF, F.lds + RING_OFF + 32768);
            if (HAS(1)) { const int i1 = ITEM_AT(1); load_kv64_paged(F, i1 >> 8, i1 & 31, (i1 >> 5) & 7, RA); }
            if (HAS(2)) { const int i2 = ITEM_AT(2); load_kv64_paged(F, i2 >> 8, i2 & 31, (i2 >> 5) & 7, RB); }
        }
        __syncthreads();
        while (idx < L) { LOADER_STEP(RA); if (idx >= L) break; LOADER_STEP(RB); }
    } else {
        int pj = -1, pst = 0; bf16x8 pq[4] = {};
#define SAMPLE_ITEM_QUERY(IT, J, ST, QF) do { const int n_ = (IT) & 31, h_ = ((IT) >> 5) & 7, sb_ = (IT) >> 8; int j_ = -1; \
        if (tl < 8) { const int* sp = sels + (size_t)((sb_ * DS + tl) * AH + h_) * 3; j_ = (sp[0] == n_) ? 0 : ((sp[1] == n_) ? 1 : ((sp[2] == n_) ? 2 : -1)); } \
        const unsigned long long bal_ = __ballot(j_ >= 0); (J) = j_; (ST) = (j_ >= 0) ? tl : ((int)(__ffsll((unsigned long long)bal_) - 1) & 7); \
        const bf16* qp_ = SEG_AQ(F) + (size_t)(MP + sb_ * DS + (ST)) * AW + h_ * AD + 8 * hi; \
        _Pragma("unroll") for (int s_ = 0; s_ < 4; ++s_) (QF)[s_] = *(const bf16x8*)(qp_ + 16 * s_); } while (0)
        LAS float* hand = tab + ML_WSC;
        volatile LAS int* flag = (volatile LAS int*)(tab + ML_WSC + 1160);
        if (HAS(0)) { const int it = ITEM_AT(0); SAMPLE_ITEM_QUERY(it, pj, pst, pq); }
        if (F.tid == 0) flag[0] = 0;
        __syncthreads();
        int seq = 0;
        for (; idx < L; idx += F.G) {
            const int it = ITEM_AT(0), n = it & 31, h = (it >> 5) & 7, sb = it >> 8;
            const LAS unsigned char* KR = F.lds + RING_OFF + cur * 65536; const LAS unsigned char* VT = KR + 32768; const LAS float* lut = LUT8(F) + h * 132;
            const int j = pj, st = pst; const bool valid = j >= 0;
            bf16x8 qf[4] = {pq[0], pq[1], pq[2], pq[3]};
            if (HAS(1)) { const int i1 = ITEM_AT(1); SAMPLE_ITEM_QUERY(i1, pj, pst, pq); }
            ++seq;
            AttnOut O = wave_attend<false>(KR, VT, qf, lane, 4 + 4 * F.wave, 256 + st, n == NBLK_S - 1, 4, lut, lut[128], 4 * F.wave);
            LAS float* hp = hand + (seq & 1) * 576 + ((lane >> 5) * 8 + (tl & 7)) * 36;
            if (F.wave == 1) {
                if (tl < 8) { hp[0] = O.mx; hp[1] = O.l;
#pragma unroll
                    for (int r = 0; r < 16; ++r) { hp[2 + r] = O.o0[r]; hp[18 + r] = O.o1[r]; } }
                asm volatile("s_waitcnt lgkmcnt(0)" ::: "memory");
                if (lane == 0) flag[0] = seq;
            } else {
                while (flag[0] < seq) __builtin_amdgcn_s_sleep(1);
                asm volatile("" ::: "memory");
                if (valid) {
                    const float m1 = hp[0], l1 = hp[1], mt = fmaxf(O.mx, m1), f0 = __expf(O.mx - mt), f1 = __expf(m1 - mt), lt_ = O.l * f0 + l1 * f1;
                    const size_t dst = (size_t)((sb * DS + st) * AH + h) * 3 + j;
                    if (hi == 0) { float* ps = (float*)(F.ws + WS_PARTSS) + dst * 2; ps[0] = mt; ps[1] = lt_; }
                    const float rl = 1.f / lt_, g0 = f0 * rl, g1 = f1 * rl;
                    bf16* po = (bf16*)(F.ws + WS_PARTOS) + dst * 64 + 4 * hi;
#pragma unroll
                    for (int g = 0; g < 4; ++g) {
                        float a[4], b[4];
#pragma unroll
                        for (int i = 0; i < 4; ++i) { a[i] = O.o0[4 * g + i] * g0 + hp[2 + 4 * g + i] * g1; b[i] = O.o1[4 * g + i] * g0 + hp[18 + 4 * g + i] * g1; }
                        *(unsigned long long*)(po + 8 * g) = (unsigned long long)pk2(a[0], a[1]) | ((unsigned long long)pk2(a[2], a[3]) << 32);
                        *(unsigned long long*)(po + 32 + 8 * g) = (unsigned long long)pk2(b[0], b[1]) | ((unsigned long long)pk2(b[2], b[3]) << 32);
                    }
                }
            }
            __syncthreads();
            cur ^= 1;
        }
#undef SAMPLE_ITEM_QUERY
    }
#undef LOADER_STEP
#undef ITEM_AT
#undef HAS
    __syncthreads();
}
__device__ __forceinline__ void sample_own_merge(Frame& F, const LAS int* bucket) {
    const int gw = blockIdx.x * NWAVES + F.wave, NGW = F.G * NWAVES, d = F.lane;
    for (int idx = gw; idx < MS * AH; idx += NGW) {
        const int r = idx >> 3, h = idx & 7, sb = r >> 3, st = r & 7, m = MP + r;
        const float q = bf2f(SEG_AQ(F)[(size_t)m * AW + h * AD + d]);
        float s[8], vv[8];
#pragma unroll
        for (int p = 0; p < 8; ++p) { const size_t off = ((size_t)(MP + sb * DS + p)) * AW + h * AD + d; s[p] = q * bf2f(SEG_AK(F)[off]); vv[p] = bf2f(SEG_AV(F)[off]); }
#pragma unroll
        for (int p = 0; p < 8; ++p) { s[p] = wave_sum(s[p]); s[p] = (p <= st) ? s[p] + LUT8(F)[h * 132 + ((st - p) & 7)] : -INFINITY; }
        float mx = s[0];
#pragma unroll
        for (int p = 1; p < 8; ++p) mx = fmaxf(mx, s[p]);
        float l = 0.f, o = 0.f;
#pragma unroll
        for (int p = 0; p < 8; ++p) { const float pw = __expf(s[p] - mx); l += pw; o += pw * vv[p]; }
        const float* ps = (const float*)(F.ws + WS_PARTSS) + (size_t)idx * 6;
        float mt = mx; float pm[3], pl[3];
#pragma unroll
        for (int j = 0; j < 3; ++j) { pm[j] = ps[2 * j]; pl[j] = ps[2 * j + 1]; mt = fmaxf(mt, pm[j]); }
        const float e_own = __expf(mx - mt); float aj[3], L = e_own * l;
#pragma unroll
        for (int j = 0; j < 3; ++j) { aj[j] = __expf(pm[j] - mt) * pl[j]; L += aj[j]; }
        const float rL = 1.f / L;
        const bf16* po = (const bf16*)(F.ws + WS_PARTOS) + (size_t)idx * 3 * 64 + d;
        F.MIX[(size_t)m * D + h * AD + d] = (bf16)f2bf(rL * (o * e_own + aj[0] * bf2f(po[0]) + aj[1] * bf2f(po[64]) + aj[2] * bf2f(po[128])));
    }
}

template <int BATCH, class Epi>
__device__ __forceinline__ void skinny_gemm(Frame& F, const bf16* A, int lda, const bf16* Wt, int ldw, int ntile, int K, const Epi& E) {
    const int lane = F.lane, r = lane & 31, hi = lane >> 5, kw = K / 8;
    LAS float* red = (LAS float*)(F.lds + RING_OFF);
    for (int u = blockIdx.x; u < 8 * ntile; u += F.G) {
        const int rg = u & 7, ct = u >> 3, k0 = F.wave * kw;
        const bf16* ap = A + (size_t)(32 * rg + r) * lda + k0 + 8 * hi;
        const bf16* bp = Wt + (size_t)(32 * ct + r) * ldw + k0 + 8 * hi;
        f32x16 acc = {};
        for (int s = 0; s < kw / 16; s += BATCH) {
            bf16x8 af[BATCH], bfr[BATCH];
#pragma unroll
            for (int i = 0; i < BATCH; ++i) { af[i] = *(const bf16x8*)(ap + 16 * (s + i)); bfr[i] = *(const bf16x8*)(bp + 16 * (s + i)); }
#pragma unroll
            for (int i = 0; i < BATCH; ++i) acc = mfma32(af[i], bfr[i], acc);
        }
        __syncthreads();
#pragma unroll
        for (int i = 0; i < 16; ++i) red[(F.wave * 16 + i) * 64 + lane] = acc[i];
        __syncthreads();
#pragma unroll
        for (int q = 0; q < 2; ++q) {
            const int e = F.tid + 512 * q; float s = 0.f;
#pragma unroll
            for (int w = 0; w < 8; ++w) s += red[w * 1024 + e];
            const int reg = e >> 6, ln = e & 63;
            E(s, 32 * rg + crow(reg, ln >> 5), 32 * ct + (ln & 31));
        }
    }
    __syncthreads();
}
struct SkResid { const float* xs; float* x1; __device__ __forceinline__ void operator()(float s, int row, int col) const { x1[(size_t)(MP + row) * D + col] = xs[(size_t)row * D + col] + s; } };
struct SkAccum { float* x1; __device__ __forceinline__ void operator()(float s, int row, int col) const { float* p = x1 + (size_t)(MP + row) * D + col; *p = *p + s; } };
struct SkRelu2U { bf16* U; __device__ __forceinline__ void operator()(float s, int row, int col) const { const float a = fmaxf(s, 0.f); U[(size_t)(MP + row) * FF + col] = (bf16)f2bf(a * a); } };

__device__ __forceinline__ void skinny_up4(Frame& F) {
    const int lane = F.lane, r = lane & 31, hi = lane >> 5, kw = D / 8;
    LAS float* red = (LAS float*)(F.lds + RING_OFF);
    const bf16* A = F.XN + (size_t)MP * D;
    for (int u = blockIdx.x; u < 8 * (FF / 128); u += F.G) {
        const int rg = u & 7, c4 = u >> 3, k0 = F.wave * kw;
        const bf16* ap = A + (size_t)(32 * rg + r) * D + k0 + 8 * hi;
        bf16x8 af[8];
#pragma unroll
        for (int i = 0; i < 8; ++i) af[i] = *(const bf16x8*)(ap + 16 * i);
        f32x16 acc[4];
#pragma unroll
        for (int t = 0; t < 4; ++t) {
            const bf16* bp = F.Wup_t + (size_t)(32 * (4 * c4 + t) + r) * D + k0 + 8 * hi;
            bf16x8 bfr[8];
#pragma unroll
            for (int i = 0; i < 8; ++i) bfr[i] = *(const bf16x8*)(bp + 16 * i);
            acc[t] = (f32x16){};
#pragma unroll
            for (int i = 0; i < 8; ++i) acc[t] = mfma32(af[i], bfr[i], acc[t]);
        }
        __syncthreads();
#pragma unroll
        for (int t = 0; t < 4; ++t)
#pragma unroll
            for (int i = 0; i < 16; ++i) red[((t * 8 + F.wave) * 16 + i) * 64 + lane] = acc[t][i];
        __syncthreads();
#pragma unroll
        for (int q = 0; q < 8; ++q) {
            const int e4 = F.tid + 512 * q, t = e4 >> 10, e = e4 & 1023; float s = 0.f;
#pragma unroll
            for (int w = 0; w < 8; ++w) s += red[(t * 8 + w) * 1024 + e];
            const int reg = e >> 6, ln = e & 63; const float a = fmaxf(s, 0.f);
            F.U[(size_t)(MP + 32 * rg + crow(reg, ln >> 5)) * FF + 32 * (4 * c4 + t) + (ln & 31)] = (bf16)f2bf(a * a);
        }
    }
    __syncthreads();
}

__device__ __forceinline__ void sample_ffn_norm(Frame& F) {
    for (int u = blockIdx.x; u < 8 * (FF / 128); u += F.G) {
        const int rg = u & 7;
#pragma unroll
        for (int i = 0; i < 4; ++i) {
            const int r = 32 * rg + 4 * F.wave + i;
            f32x4 v[4]; load_row(F.X1 + (size_t)(MP + r) * D, F.lane, v);
            rms_row_to_bf16<false>(F, v, F.norm_ffn, F.XN + (size_t)(MP + r) * D, MP + r);
        }
    }
    asm volatile("s_waitcnt vmcnt(0)" ::: "memory");
    __syncthreads();
}

#ifndef MK_ONE_LAUNCH
#define MK_ONE_LAUNCH 1
#endif
constexpr int N_PHASES = 11;
struct Args { const void* in[19]; float* out; unsigned char* ws; int ph_lo, ph_hi; };
static_assert(sizeof(Args) == 19 * 8 + 8 + 8 + 8, "Args has no padding bytes");
__global__ void __launch_bounds__(NWAVES * 64, 2) hymba_fwd(Args args) {
    extern __shared__ __attribute__((aligned(16))) unsigned char lds[];
    Frame F;
    F.lds = (LAS unsigned char*)lds;
    F.MISC = (volatile LAS unsigned*)(F.lds + MISC_OFF);
    F.tid = threadIdx.x; F.lane = F.tid & 63; F.wave = __builtin_amdgcn_readfirstlane(F.tid >> 6);
    F.G = gridDim.x; { const int bx = blockIdx.x; F.vcu = (F.G % 8 == 0) ? (bx % 8) * (F.G / 8) + bx / 8 : bx; }
    unsigned char* ws = args.ws; F.ws = ws;
    F.ctl = (gu32*)(ws + WS_CTL);
    F.xp = (const float*)args.in[0]; F.xs = (const float*)args.in[1]; F.cache_k = (const float*)args.in[2]; F.cache_v = (const float*)args.in[3];
    F.state_C = (const float*)args.in[4]; F.state_n = (const float*)args.in[5]; F.state_m = (const float*)args.in[6]; F.page_table = (const int*)args.in[7];
    F.rel_bias = (const float*)args.in[8]; F.norm_mix = (const float*)args.in[9]; F.w_in = (const float*)args.in[10]; F.b_ig = (const float*)args.in[11];
    F.b_fg = (const float*)args.in[12]; F.ml_norm = (const float*)args.in[13]; F.w_out = (const float*)args.in[14]; F.norm_ffn = (const float*)args.in[15];
    F.w_up = (const float*)args.in[16]; F.w_down = (const float*)args.in[17]; F.norm_final = (const float*)args.in[18];
    F.out = args.out;
    F.Win_t = (bf16*)(ws + WS_WIN); F.Wout_t = (bf16*)(ws + WS_WOUT); F.Wup_t = (bf16*)(ws + WS_WUP); F.Wdn_t = (bf16*)(ws + WS_WDN);
    F.XN = (bf16*)(ws + WS_XN); F.SEG = (bf16*)(ws + WS_SEG); F.MIX = (bf16*)(ws + WS_MIX); F.U = (bf16*)(ws + WS_U);
    F.KSUM = (float*)(ws + WS_KSUM); F.KSUMS = (float*)(ws + WS_KSUMP); F.IG = (float*)(ws + WS_GATE); F.LF = (float*)(ws + WS_GATE + 512 * 1024);
    F.H = (float*)(ws + WS_H); F.X1 = (float*)(ws + WS_X1);
    for (int u = F.tid; u < (LDS_BYTES - LDSCTL_OFF) / 4; u += NWAVES * 64) ((LAS unsigned*)(F.lds + LDSCTL_OFF))[u] = 0u;
    __syncthreads();
    LAS int* bucket = (LAS int*)(F.lds + LDSCTL_OFF + 1024);
    if (F.tid < 128) bucket[F.tid] = t5_bucket_small(F.tid);
    __syncthreads();
    { LAS float* l8 = (LAS float*)(F.lds + LUT8_OFF);
      for (int i = F.tid; i < AH * 129; i += NWAVES * 64) { const int h_ = i / 129, d_ = i % 129; l8[h_ * 132 + d_] = F.rel_bias[(d_ < 128 ? bucket[d_] : 31) * AH + h_]; }
    }
    __syncthreads();
    const int lo = args.ph_lo, hi = args.ph_hi;
    XcdBarrier bar; bar.bar = (unsigned*)(F.ctl + CW_BAR); bar.x = 0; bar.st = nullptr;
    if (hi - lo > 1) bar = xcd_barrier_post((unsigned*)(F.ctl + CW_BAR), F.MISC + 8);
#define IN(k) (lo <= (k) && (k) < hi)
#define SEAM(k) do { if (IN(k) && IN((k) + 1)) xcd_barrier(bar); } while (0)

    if (IN(0)) { p0_prologue(F); } SEAM(0);
    if (IN(1)) {
        const int gwg = (F.G > P1_GEMM_WGS) ? P1_GEMM_WGS : F.G;
        if ((int)blockIdx.x < gwg) {
            pg8::Gemm g{F.XN, F.Win_t, M, NPG, D}; pg8::StaticOrder S; S.init(M, NPG, gwg, (int)blockIdx.x); pg8::EpiInProj E{F.SEG, SEG_ELEMS, F.out, F.KSUM};
            pg8::gemm_phase<pg8::EpiInProj, pg8::StaticOrder, true, true>(F.lds + RING_OFF, g, S, E);
        }
        if (F.G > gwg) { if ((int)blockIdx.x >= gwg) { page_sums(F, PS_SPLIT, DB * NPAGES, ((int)blockIdx.x - gwg) * NWAVES + F.wave, (F.G - gwg) * NWAVES); late_transposes(F, ((int)blockIdx.x - gwg) * NWAVES + F.wave, (F.G - gwg) * NWAVES); } }
        else { page_sums(F, PS_SPLIT, DB * NPAGES, F.vcu * NWAVES + F.wave, F.G * NWAVES); late_transposes(F, F.vcu * NWAVES + F.wave, F.G * NWAVES); }
    } SEAM(1);
    if (IN(2)) {
        for (int u = blockIdx.x; u < NSEQ * NCH; u += F.G) mlstm_stepA(F, u);
        for (int u = blockIdx.x; u < 32 * 15; u += 2 * F.G) attn_select2(F, u, (u + F.G < 32 * 15) ? u + F.G : -1);
        sample_select(F);
    } SEAM(2);
    if (IN(3)) {
        for (int u = blockIdx.x; u < NSEQ * 16; u += F.G) mlstm_stepB(F, u);
        attn_past_items(F, bucket);
        sample_past_items(F, bucket);
    } SEAM(3);
    if (IN(4)) {
        for (int u = blockIdx.x; u < NSEQ * NCH; u += F.G) mlstm_stepC(F, u);
        for (int u = blockIdx.x; u < 16 * 16; u += F.G) attn_own_pair(F, bucket, u, u + 256);
        for (int u = blockIdx.x; u < DB * MH; u += F.G) mlstm_sample_full(F, u);
        __syncthreads();
        sample_own_merge(F, bucket);
    }
    if (IN(4) && IN(6)) xcd_barrier(bar);
    if (IN(6)) {
        pg8::Gemm g{F.MIX, F.Wout_t, MP, D, D}; pg8::StaticOrder S; S.init(MP, D, F.G, (int)blockIdx.x); pg8::EpiResid E{F.xp, F.xs, F.X1, F.norm_ffn, F.XN, (float*)(F.ws + WS_SSQ)};
        pg8::gemm_phase<pg8::EpiResid, pg8::StaticOrder, true, true>(F.lds + RING_OFF, g, S, E);
        skinny_gemm<8>(F, F.MIX + (size_t)MP * D, D, F.Wout_t, D, D / 32, D, SkResid{F.xs, F.X1});
    }
    if (IN(6) && IN(8)) xcd_barrier(bar);
    if (IN(8)) {
        pg8::Gemm g{F.XN, F.Wup_t, MP, FF, D}; pg8::StaticOrder S; S.init(MP, FF, F.G, (int)blockIdx.x); pg8::EpiRelu2 E{F.U, (const float*)(F.ws + WS_SSQ)};
        pg8::gemm_phase<pg8::EpiRelu2, pg8::StaticOrder, true, true>(F.lds + RING_OFF, g, S, E);
        sample_ffn_norm(F); skinny_up4(F);
    } SEAM(8);
    if (IN(9)) {
        pg8::Gemm g{F.U, F.Wdn_t, MP, D, FF}; pg8::StaticOrder S; S.init(MP, D, F.G, (int)blockIdx.x);
        pg8::EpiAccum E{F.X1};
        pg8::gemm_phase<pg8::EpiAccum, pg8::StaticOrder, true, true>(F.lds + RING_OFF, g, S, E);
        skinny_gemm<16>(F, F.U + (size_t)MP * FF, FF, F.Wdn_t, FF, D / 32, FF, SkAccum{F.X1});
    } SEAM(9);
    if (IN(10)) { final_norm_rows(F); }
#undef IN
#undef SEAM
}

extern "C" void kernel_launch(void* const* d_in, const int* in_sizes, int n_in, void* d_out, int out_size, void* d_ws, size_t ws_size, hipStream_t stream) {
    static int grid = 0;
    if (grid == 0) {
        if (n_in != 19 || (size_t)out_size != O_END || ws_size < WS_END_SSQ) { fprintf(stderr, "kernel_launch: unexpected shapes (n_in %d out %d ws %zu)\n", n_in, out_size, ws_size); grid = -1; return; }
        int dev = 0, cus = 0, per_cu = 0;
        if (hipGetDevice(&dev) != hipSuccess || hipDeviceGetAttribute(&cus, hipDeviceAttributeMultiprocessorCount, dev) != hipSuccess) { grid = -1; return; }
        if (hipFuncSetAttribute((const void*)hymba_fwd, hipFuncAttributeMaxDynamicSharedMemorySize, LDS_BYTES) != hipSuccess) { fprintf(stderr, "kernel_launch: hipFuncSetAttribute failed\n"); grid = -1; return; }
        if (hipOccupancyMaxActiveBlocksPerMultiprocessor(&per_cu, (const void*)hymba_fwd, NWAVES * 64, LDS_BYTES) != hipSuccess || per_cu < 1)
            fprintf(stderr, "kernel_launch: note: occupancy query reports %d workgroups per CU\n", per_cu);
        (void)hipGetLastError();
        grid = cus;
    }
    if (grid < 0) return;
    if (hipMemsetAsync((char*)d_ws + WS_CTL, 0, CTL_ZERO_BYTES, stream) != hipSuccess) { fprintf(stderr, "kernel_launch: memset failed\n"); return; }
    Args a{};
    for (int i = 0; i < 19; ++i) a.in[i] = d_in[i];
    a.out = (float*)d_out; a.ws = (unsigned char*)d_ws;
#if MK_ONE_LAUNCH
    a.ph_lo = 0; a.ph_hi = N_PHASES;
    hipLaunchKernelGGL(hymba_fwd, dim3(grid), dim3(NWAVES * 64), LDS_BYTES, stream, a);
#else
    for (int p = 0; p < N_PHASES; ++p) {
        a.ph_lo = p; a.ph_hi = p + 1;
        hipLaunchKernelGGL(hymba_fwd, dim3(grid), dim3(NWAVES * 64), LDS_BYTES, stream, a);
    }
#endif
    const hipError_t le = hipPeekAtLastError();
    if (le != hipSuccess) fprintf(stderr, "kernel_launch: launch failed: %s\n", hipGetErrorName(le));
}
```

```cpp
#include <hip/hip_runtime.h>
#include <cstdio>
#include <cstdint>
#include <cmath>
constexpr int D = 1024, SEQ = 4096, NBATCH = 4, MP = NBATCH * SEQ  , DB = 32, DS = 8, MS = DB * DS  , M = MP + MS  ;
constexpr int FF = 4096, NPROJ = 3592, NPG = 3584  ;
constexpr int AH = 8, AD = 64, AW = 512, MH = 4, MD = 128, MW = 512;
constexpr int PAST = 8192, PAGE = 128, NPAGES = PAST / PAGE  , MBLK = 256, NBLK_P = SEQ / MBLK  , NBLK_S = PAST / MBLK  ;
constexpr float RMS_EPS = 1e-6f;
constexpr size_t O_YP = 0, O_YS = 16777216, O_KP = 17039360, O_VP = 25427968, O_CP = 33816576, O_NP = 34078720, O_MP = 34080768,
                 O_KS = 34080784, O_VS = 34211856, O_CS = 34342928, O_NS = 36440080, O_MS = 36456464, O_END = 36456592;
namespace pg8 {
#define PG8_LAS __attribute__((address_space(3)))
typedef unsigned short bf16_t;
typedef short bf16x8 __attribute__((ext_vector_type(8)));
typedef float f32x4 __attribute__((ext_vector_type(4)));
typedef unsigned u32x4 __attribute__((ext_vector_type(4)));
constexpr int BM = 256, BK = 64, HALF = 128, HTB = HALF * BK * 2  , STAGE_BYTES = 8 * HTB, NXCD = 8, WGM = 8;

__host__ __device__ __forceinline__ int lds_byte(int r, int c) { const int st = (r >> 4) * 2 + (c >> 5), rr = r & 15, cc = c & 31, ob = rr * 64 + cc * 2; return st * 1024 + (ob ^ (((ob >> 9) & 1) << 5)); }
__host__ __device__ __forceinline__ void stage_rc(int b, int& R, int& C) { const int st = b / 1024, sb = b % 1024, swz = sb ^ (((sb >> 9) & 1) << 5); R = (st >> 1) * 16 + swz / 64; C = (st & 1) * 32 + (swz % 64) / 2; }
__host__ __device__ __forceinline__ int perm32(int rho) { const int n = rho >> 4, i = rho & 15; return 8 * (i >> 2) + 4 * n + (i & 3); }

struct Unit { int pm, pn; };
struct Gemm { const bf16_t* A; const bf16_t* Bt; int M, N, K; };

struct StaticOrder {
    int nM, nN, nwg, G, c;
    __host__ __device__ void init(int M, int N, int G_, int c_) { nM = M / BM; nN = N / BM; nwg = nM * nN; G = G_; c = c_; }
    __host__ __device__ bool next(int i, Unit& u) const {
        const long L = (long)i * G + c; if (L >= nwg) return false;
        int wgid = (int)L; { const int q = nwg / NXCD, r = nwg % NXCD, xcd = wgid % NXCD, off = wgid / NXCD; wgid = (xcd < r ? xcd * (q + 1) : r * (q + 1) + (xcd - r) * q) + off; }
        const int nig = WGM * nN, gid = wgid / nig, fm = gid * WGM, gsz = (nM - fm) < WGM ? (nM - fm) : WGM;
        u.pm = fm + ((wgid % nig) % gsz); u.pn = (wgid % nig) / gsz; return true;
    }
    __device__ __forceinline__ void a_ready(const Unit&) const {}
    __device__ __forceinline__ void done(const Unit&) const {}
};

__device__ __forceinline__ unsigned cvt_pk_bf16(float lo, float hi) { unsigned r; asm volatile("v_cvt_pk_bf16_f32 %0, %1, %2" : "=v"(r) : "v"(lo), "v"(hi)); return r; }
typedef float f32x2 __attribute__((ext_vector_type(2)));
typedef unsigned u32x4_t __attribute__((ext_vector_type(4)));
__device__ __forceinline__ u32x4_t pack8(f32x4 v0, f32x4 v1) { u32x4_t w; w.x = cvt_pk_bf16(v0[0], v0[1]); w.y = cvt_pk_bf16(v0[2], v0[3]); w.z = cvt_pk_bf16(v1[0], v1[1]); w.w = cvt_pk_bf16(v1[2], v1[3]); return w; }
struct EpiInProj {
    static constexpr bool PERM = true, AFTER_DRAIN = false;
    bf16_t* seg0; size_t seg_stride; float* out; float* ksum;
    __device__ __forceinline__ void operator()(const f32x4 (&acc)[2][2][4][2], const Unit& u, int wr, int wc, int fr, int fq) const {
        const int seg = u.pn >> 1;
        const float sc = (seg == 0) ? 0.125f : ((seg == 4) ? 0.08838834764831845f : 1.0f);
        bf16_t* base = seg0 + (size_t)seg * seg_stride;
        const int cs0 = (u.pn & 1) * 256 + wc * 32 + 8 * fq;
        const int row0 = u.pm * BM + wr * 64 + fr;
        const bool kv = (seg == 1) || (seg == 2);
        const bool prompt = u.pm < (MP / BM);
        float* fo = out + (prompt ? (seg == 1 ? O_KP : O_VP) : (seg == 1 ? O_KS : O_VS));
        const int frow0 = prompt ? row0 : row0 - MP;
        f32x4 cs[2][2];
#pragma unroll
        for (int bj = 0; bj < 2; ++bj)
#pragma unroll
            for (int n = 0; n < 2; ++n) cs[bj][n] = (f32x4){0.f, 0.f, 0.f, 0.f};
#pragma unroll
        for (int ai = 0; ai < 2; ++ai)
#pragma unroll
            for (int m = 0; m < 4; ++m) {
                bf16_t* rowp = base + (size_t)(row0 + ai * HALF + m * 16) * 512 + cs0;
#pragma unroll
                for (int bj = 0; bj < 2; ++bj) {
                    f32x4 v0 = acc[ai][bj][m][0], v1 = acc[ai][bj][m][1];
                    if (kv) { float* fp = fo + (size_t)(frow0 + ai * HALF + m * 16) * 512 + cs0 + bj * HALF; __builtin_nontemporal_store(v0, (f32x4*)fp); __builtin_nontemporal_store(v1, (f32x4*)(fp + 4)); }
                    if (seg == 1) { cs[bj][0] += v0; cs[bj][1] += v1; }
                    v0 = v0 * sc; v1 = v1 * sc;
                    *(u32x4_t*)(rowp + bj * HALF) = pack8(v0, v1);
                }
            }
        if (seg == 1 && prompt) {
#pragma unroll
            for (int bj = 0; bj < 2; ++bj)
#pragma unroll
                for (int n = 0; n < 2; ++n)
#pragma unroll
                    for (int j = 0; j < 4; ++j) {
                        float v = cs[bj][n][j];
                        v += __shfl_xor(v, 1); v += __shfl_xor(v, 2); v += __shfl_xor(v, 4); v += __shfl_xor(v, 8);
                        if (fr == 0) __hip_atomic_fetch_add(ksum + (size_t)u.pm * 512 + cs0 + bj * HALF + n * 4 + j, v, __ATOMIC_RELAXED, __HIP_MEMORY_SCOPE_AGENT);
                    }
        }
    }
};
struct EpiResid {
    static constexpr bool PERM = false, AFTER_DRAIN = false;
    const float* xp; const float* xs; float* x1; const float* gain; bf16_t* xn; float* ssq;
    __device__ __forceinline__ void operator()(const f32x4 (&acc)[2][2][4][2], const Unit& u, int wr, int wc, int fr, int fq) const {
        const int row0 = u.pm * BM + wr * 64 + fr, col0 = u.pn * BM + wc * 32 + 4 * fq;
        const float* src = (u.pm < (MP / BM)) ? xp + (size_t)row0 * D : xs + (size_t)(row0 - MP) * D;
        float* dst = x1 + (size_t)row0 * D; bf16_t* dxn = xn + (size_t)row0 * D;
        f32x4 gv[2][2];
#pragma unroll
        for (int bj = 0; bj < 2; ++bj)
#pragma unroll
            for (int n = 0; n < 2; ++n) gv[bj][n] = *(const f32x4*)(gain + col0 + bj * HALF + n * 16);
#pragma unroll
        for (int ai = 0; ai < 2; ++ai)
#pragma unroll
            for (int m = 0; m < 4; ++m) {
                const size_t off = (size_t)(ai * HALF + m * 16) * D + col0; float sq = 0.f;
#pragma unroll
                for (int bj = 0; bj < 2; ++bj)
#pragma unroll
                    for (int n = 0; n < 2; ++n) { const f32x4 xv = *(const f32x4*)(src + off + bj * HALF + n * 16) + acc[ai][bj][m][n]; *(f32x4*)(dst + off + bj * HALF + n * 16) = xv;
                        sq += (xv[0] * xv[0] + xv[1] * xv[1]) + (xv[2] * xv[2] + xv[3] * xv[3]);
                        const f32x4 y = xv * gv[bj][n]; unsigned long long w = (unsigned long long)cvt_pk_bf16(y[0], y[1]) | ((unsigned long long)cvt_pk_bf16(y[2], y[3]) << 32);
                        *(unsigned long long*)(dxn + off + bj * HALF + n * 16) = w; }
                sq += __shfl_xor(sq, 16); sq += __shfl_xor(sq, 32);
                if (fq == 0) ssq[(size_t)(row0 + ai * HALF + m * 16) * 16 + u.pn * 4 + wc] = sq;
            }
    }
};
struct EpiAccum {
    static constexpr bool PERM = false, AFTER_DRAIN = false;
    float* x1;
    __device__ __forceinline__ void operator()(const f32x4 (&acc)[2][2][4][2], const Unit& u, int wr, int wc, int fr, int fq) const {
        const int row0 = u.pm * BM + wr * 64 + fr, col0 = u.pn * BM + wc * 32 + 4 * fq;
        float* dst = x1 + (size_t)row0 * D;
#pragma unroll
        for (int ai = 0; ai < 2; ++ai)
#pragma unroll
            for (int m = 0; m < 4; ++m) {
                const size_t off = (size_t)(ai * HALF + m * 16) * D + col0;
#pragma unroll
                for (int bj = 0; bj < 2; ++bj)
#pragma unroll
                    for (int n = 0; n < 2; ++n) { float* p = dst + off + bj * HALF + n * 16; const f32x4 xv = *(const f32x4*)p; *(f32x4*)p = xv + acc[ai][bj][m][n]; }
            }
    }
};
struct EpiRelu2 {
    static constexpr bool PERM = true, AFTER_DRAIN = false;
    bf16_t* U; const float* ssq;
    __device__ __forceinline__ void operator()(const f32x4 (&acc)[2][2][4][2], const Unit& u, int wr, int wc, int fr, int fq) const {
        const int row0 = u.pm * BM + wr * 64 + fr, col0 = u.pn * BM + wc * 32 + 8 * fq;
#pragma unroll
        for (int ai = 0; ai < 2; ++ai)
#pragma unroll
            for (int m = 0; m < 4; ++m) {
                const int row = row0 + ai * HALF + m * 16;
                const f32x4* sp = (const f32x4*)(ssq + (size_t)row * 16); const f32x4 s0 = sp[0], s1 = sp[1], s2 = sp[2], s3 = sp[3];
                const float tot = ((s0[0] + s0[1]) + (s0[2] + s0[3])) + ((s1[0] + s1[1]) + (s1[2] + s1[3])) + ((s2[0] + s2[1]) + (s2[2] + s2[3])) + ((s3[0] + s3[1]) + (s3[2] + s3[3]));
                const float r2 = 1.f / (tot * (1.f / D) + RMS_EPS);
                bf16_t* rowp = U + (size_t)row * FF + col0;
#pragma unroll
                for (int bj = 0; bj < 2; ++bj) {
                    f32x4 v0 = acc[ai][bj][m][0], v1 = acc[ai][bj][m][1];
#pragma unroll
                    for (int j = 0; j < 4; ++j) { const float a = fmaxf(v0[j], 0.f), b = fmaxf(v1[j], 0.f); v0[j] = a * a * r2; v1[j] = b * b * r2; }
                    *(u32x4_t*)(rowp + bj * HALF) = pack8(v0, v1);
                }
            }
    }
};

template <class Epi, class Sched, bool ALIGN_EPI = false, bool SP2 = false>
__device__ __forceinline__ void gemm_phase(PG8_LAS unsigned char* lds, const Gemm g, const Sched& S, const Epi& E) {
    const int tid = threadIdx.x, wid = __builtin_amdgcn_readfirstlane(tid >> 6), lane = tid & 63, wr = wid >> 2, wc = wid & 3, fr = lane & 15, fq = lane >> 4;
    const int K = g.K, nt = K / BK;
    unsigned voffA[2], voffB[2];
#pragma unroll
    for (int i = 0; i < 2; ++i) { int R, C; stage_rc(tid * 16 + i * 8192, R, C); const int Rb = Epi::PERM ? ((R & ~31) + perm32(R & 31)) : R;
        voffA[i] = (unsigned)(R * K + C) * 2u; voffB[i] = (unsigned)(Rb * K + C) * 2u; }
    const size_t kstep = (size_t)(BK * 2);
    const size_t hstep = (size_t)HALF * K * 2;
    const size_t tstep = 2 * hstep;
    const unsigned ldsw = (unsigned)wid * 1024u;
    const int aoff = lds_byte(wr * 64 + fr, fq * 8), boff = lds_byte(wc * 32 + fr, fq * 8);
#define PG8_SA(b, h) (((b) * 2 + (h)) * HTB)
#define PG8_SB(b, h) ((4 + (b) * 2 + (h)) * HTB)
#define PG8_STAGE(bufoff, gbase, voff) do { _Pragma("unroll") for (int _i = 0; _i < 2; ++_i) \
        __builtin_amdgcn_global_load_lds((const unsigned*)((const char*)(gbase) + (voff)[_i]), (PG8_LAS unsigned*)(lds + (bufoff) + ldsw + _i * 8192), 16, 0, 0); } while (0)
#define PG8_LDA(dst, b, h) do { _Pragma("unroll") for (int m = 0; m < 4; ++m) _Pragma("unroll") for (int k = 0; k < 2; ++k) dst[m][k] = *(const PG8_LAS bf16x8*)(lds + PG8_SA(b, h) + aoff + m * 2048 + k * 1024); } while (0)
#define PG8_LDB(dst, b, h) do { _Pragma("unroll") for (int n = 0; n < 2; ++n) _Pragma("unroll") for (int k = 0; k < 2; ++k) dst[n][k] = *(const PG8_LAS bf16x8*)(lds + PG8_SB(b, h) + boff + n * 2048 + k * 1024); } while (0)
#define PG8_MMA(ai, bj, At, Bt) do { __builtin_amdgcn_s_setprio(1); _Pragma("unroll") for (int m = 0; m < 4; ++m) _Pragma("unroll") for (int n = 0; n < 2; ++n) _Pragma("unroll") for (int k = 0; k < 2; ++k) \
        acc[ai][bj][m][n] = __builtin_amdgcn_mfma_f32_16x16x32_bf16(Bt[n][k], At[m][k], acc[ai][bj][m][n], 0, 0, 0); __builtin_amdgcn_s_setprio(0); } while (0)
#define PG8_WAIT_V(n) asm volatile("s_waitcnt vmcnt(" #n ")" ::: "memory")
#define PG8_WAIT_L(n) asm volatile("s_waitcnt lgkmcnt(" #n ")" ::: "memory")
#define PG8_BAR __builtin_amdgcn_s_barrier()
#define PG8_SCHED __builtin_amdgcn_sched_barrier(0)
    Unit cur, nxt; int ui = 0;
    if (!S.next(0, cur)) return;
    f32x4 acc[2][2][4][2];
#pragma unroll
    for (int a = 0; a < 2; ++a)
#pragma unroll
        for (int b = 0; b < 2; ++b)
#pragma unroll
            for (int m = 0; m < 4; ++m)
#pragma unroll
                for (int n = 0; n < 2; ++n) acc[a][b][m][n] = (f32x4){0.f, 0.f, 0.f, 0.f};
    bf16x8 At[4][2], B0[2][2], B1[2][2];
    const char* cA = (const char*)g.A + (size_t)cur.pm * tstep; const char* cB = (const char*)g.Bt + (size_t)cur.pn * tstep;
    S.a_ready(cur);
    if constexpr (SP2) {
        PG8_STAGE(PG8_SB(0, 0), cB, voffB); PG8_STAGE(PG8_SB(0, 1), cB + hstep, voffB); PG8_STAGE(PG8_SA(0, 0), cA, voffA); PG8_STAGE(PG8_SA(0, 1), cA + hstep, voffA);
        if (wr == 1) PG8_BAR;
        PG8_WAIT_V(2); PG8_BAR;
        PG8_STAGE(PG8_SB(1, 0), cB + kstep, voffB); PG8_STAGE(PG8_SA(1, 0), cA + kstep, voffA); PG8_STAGE(PG8_SB(1, 1), cB + hstep + kstep, voffB);
        PG8_WAIT_V(6); PG8_BAR;
    } else {
        PG8_STAGE(PG8_SB(0, 0), cB, voffB); PG8_STAGE(PG8_SA(0, 0), cA, voffA); PG8_STAGE(PG8_SB(0, 1), cB + hstep, voffB); PG8_STAGE(PG8_SA(0, 1), cA + hstep, voffA);
        if (wr == 1) PG8_BAR;
        PG8_WAIT_V(4); PG8_BAR;
        PG8_STAGE(PG8_SB(1, 0), cB + kstep, voffB); PG8_STAGE(PG8_SA(1, 0), cA + kstep, voffA); PG8_STAGE(PG8_SB(1, 1), cB + hstep + kstep, voffB);
        PG8_WAIT_V(6); PG8_BAR;
    }
    for (;;) {
        const bool has_next = S.next(ui + 1, nxt);
        const char* nA = has_next ? (const char*)g.A + (size_t)nxt.pm * tstep : cA; const char* nB = has_next ? (const char*)g.Bt + (size_t)nxt.pn * tstep : cB;
        for (int t = 0; t < nt; t += 2) {
            const bool last = (t == nt - 2);
            const char* a1 = cA + (size_t)(t + 1) * kstep;
            const char* a2 = last ? nA : cA + (size_t)(t + 2) * kstep; const char* b2 = last ? nB : cB + (size_t)(t + 2) * kstep;
            const char* a3 = a2 + kstep; const char* b3 = b2 + kstep;
            if (last && has_next) S.a_ready(nxt);
            if constexpr (SP2) {
            PG8_LDB(B0, 0, 0); PG8_LDB(B1, 0, 1); PG8_SCHED; PG8_LDA(At, 0, 0); PG8_STAGE(PG8_SA(1, 1), a1 + hstep, voffA);
            PG8_WAIT_V(8); PG8_WAIT_L(0); PG8_BAR; PG8_MMA(0, 0, At, B0); PG8_MMA(0, 1, At, B1); PG8_BAR; PG8_SCHED;
            PG8_LDA(At, 0, 1); PG8_STAGE(PG8_SB(0, 0), b2, voffB); PG8_STAGE(PG8_SB(0, 1), b2 + hstep, voffB); PG8_STAGE(PG8_SA(0, 0), a2, voffA);
            PG8_WAIT_V(8); PG8_WAIT_L(0); PG8_BAR; PG8_MMA(1, 0, At, B0); PG8_MMA(1, 1, At, B1); PG8_BAR; PG8_SCHED;
            PG8_LDB(B0, 1, 0); PG8_LDB(B1, 1, 1); PG8_SCHED; PG8_LDA(At, 1, 0); PG8_STAGE(PG8_SA(0, 1), a2 + hstep, voffA);
            PG8_WAIT_V(8); PG8_WAIT_L(0); PG8_BAR; PG8_MMA(0, 0, At, B0); PG8_MMA(0, 1, At, B1); PG8_BAR; PG8_SCHED;
            PG8_LDA(At, 1, 1); PG8_STAGE(PG8_SB(1, 0), b3, voffB); PG8_STAGE(PG8_SB(1, 1), b3 + hstep, voffB); PG8_STAGE(PG8_SA(1, 0), a3, voffA);
            PG8_WAIT_V(8); PG8_WAIT_L(0); PG8_BAR; PG8_MMA(1, 0, At, B0); PG8_MMA(1, 1, At, B1); PG8_BAR; PG8_SCHED;
            } else {
            PG8_LDB(B0, 0, 0); PG8_SCHED; PG8_LDA(At, 0, 0); PG8_STAGE(PG8_SA(1, 1), a1 + hstep, voffA);
            PG8_WAIT_L(8); PG8_BAR; PG8_WAIT_L(0); PG8_MMA(0, 0, At, B0); PG8_BAR; PG8_SCHED;
            PG8_LDB(B1, 0, 1); PG8_STAGE(PG8_SB(0, 0), b2, voffB);
            PG8_BAR; PG8_WAIT_L(0); PG8_MMA(0, 1, At, B1); PG8_BAR;
            PG8_LDA(At, 0, 1); PG8_STAGE(PG8_SA(0, 0), a2, voffA);
            PG8_BAR; PG8_WAIT_L(0); PG8_MMA(1, 0, At, B0); PG8_BAR; PG8_SCHED;
            PG8_STAGE(PG8_SB(0, 1), b2 + hstep, voffB);
            PG8_WAIT_V(6); PG8_BAR; PG8_MMA(1, 1, At, B1); PG8_BAR;
            PG8_LDB(B0, 1, 0); PG8_SCHED; PG8_LDA(At, 1, 0); PG8_STAGE(PG8_SA(0, 1), a2 + hstep, voffA);
            PG8_WAIT_L(8); PG8_BAR; PG8_WAIT_L(0); PG8_MMA(0, 0, At, B0); PG8_BAR; PG8_SCHED;
            PG8_LDB(B1, 1, 1); PG8_STAGE(PG8_SB(1, 0), b3, voffB);
            PG8_BAR; PG8_WAIT_L(0); PG8_MMA(0, 1, At, B1); PG8_BAR;
            PG8_LDA(At, 1, 1); PG8_STAGE(PG8_SA(1, 0), a3, voffA);
            PG8_BAR; PG8_WAIT_L(0); PG8_MMA(1, 0, At, B0); PG8_BAR; PG8_SCHED;
            PG8_STAGE(PG8_SB(1, 1), b3 + hstep, voffB);
            PG8_WAIT_V(6); PG8_BAR; PG8_MMA(1, 1, At, B1); PG8_BAR;
            }
        }
        if constexpr (ALIGN_EPI) { if (wr == 0) PG8_BAR; }
        if constexpr (!Epi::AFTER_DRAIN) { E(acc, cur, wr, wc, fr, fq); S.done(cur); }
        if (!has_next) break;
#pragma unroll
        for (int a = 0; a < 2; ++a)
#pragma unroll
            for (int b = 0; b < 2; ++b)
#pragma unroll
                for (int m = 0; m < 4; ++m)
#pragma unroll
                    for (int n = 0; n < 2; ++n) acc[a][b][m][n] = (f32x4){0.f, 0.f, 0.f, 0.f};
        cur = nxt; cA = nA; cB = nB; ++ui;
        if constexpr (ALIGN_EPI) { if (wr == 1) PG8_BAR; }
    }
    PG8_WAIT_V(0);
    if constexpr (!ALIGN_EPI) { if (wr == 0) PG8_BAR; }
    PG8_BAR;
    if constexpr (Epi::AFTER_DRAIN) { E.fused(acc, cur, wr, wc, fr, fq, lds, wid, lane); S.done(cur); }
#undef PG8_SA
#undef PG8_SB
#undef PG8_STAGE
#undef PG8_LDA
#undef PG8_LDB
#undef PG8_MMA
#undef PG8_WAIT_V
#undef PG8_WAIT_L
#undef PG8_BAR
#undef PG8_SCHED
}
}

constexpr int NWAVES = 8;
constexpr size_t MiB = 1u << 20;
constexpr size_t WS_CTL = 0, CTL_ZERO_BYTES = 1 * MiB;
constexpr size_t WS_KSUM = 512 * 1024;
constexpr size_t WS_WIN = 2 * MiB, WS_WOUT = 10 * MiB, WS_WUP = 12 * MiB, WS_WDN = 20 * MiB;
constexpr size_t WS_GATE = 28 * MiB;
constexpr size_t WS_KSUMS = 29 * MiB;
constexpr size_t WS_XN = 32 * MiB;
constexpr size_t WS_SEG = 65 * MiB, SEG_BYTES = 17 * MiB;
constexpr size_t WS_H = 184 * MiB;
constexpr size_t WS_MIX = 217 * MiB;
constexpr size_t WS_X1 = 250 * MiB;
constexpr size_t WS_U = 320 * MiB;
constexpr size_t WS_END = 452 * MiB;
constexpr size_t WS_SSQ = 700 * MiB;
constexpr size_t WS_END_SSQ = 702 * MiB;
constexpr int CW_BAR = 4096;
constexpr int RING_OFF = 0, RING_BYTES = 131072;
constexpr int LDSCTL_OFF = RING_BYTES, MISC_OFF = LDSCTL_OFF + 320;
constexpr int LDS_BYTES = 151552;
constexpr int LUT8_OFF = LDSCTL_OFF + 13568;
#define GAS __attribute__((address_space(1)))
#define LAS __attribute__((address_space(3)))
typedef unsigned short bf16;
typedef unsigned v4u __attribute__((ext_vector_type(4)));
typedef float f32x4 __attribute__((ext_vector_type(4)));
typedef short bf16x8 __attribute__((ext_vector_type(8)));
typedef GAS unsigned gu32;
typedef GAS unsigned long long gu64;
#define RLX_AGENT __ATOMIC_RELAXED, __HIP_MEMORY_SCOPE_AGENT
#define LDS_WAIT() asm volatile("s_waitcnt lgkmcnt(0)" ::: "memory")
#define VM_WAIT() asm volatile("s_waitcnt vmcnt(0)" ::: "memory")
__device__ __forceinline__ unsigned long long rt() { return __builtin_amdgcn_s_memrealtime(); }
__device__ __forceinline__ unsigned pk2(float lo, float hi) { unsigned r; asm("v_cvt_pk_bf16_f32 %0, %1, %2" : "=v"(r) : "v"(lo), "v"(hi)); return r; }
__device__ __forceinline__ unsigned f2bf(float f) { return pk2(f, 0.f) & 0xffffu; }

#define XB_TMO      128
#define XB_XCNT(j)  (256  + 64 * (j))
#define XB_XSUB(j)  (1280 + 64 * (j))
#define XB_XGEN(j)  (2304 + 64 * (j))
#define XB_TOP      3328
#define XB_TOPGEN   3392
#define XCD_BAR_WORDS 3456
#define XB_SPIN_CAP (1u << 18)

__device__ __forceinline__ unsigned xb_ld(unsigned* p)              { return __hip_atomic_load(p, __ATOMIC_RELAXED, __HIP_MEMORY_SCOPE_AGENT); }
__device__ __forceinline__ unsigned xb_add(unsigned* p, unsigned v) { return __hip_atomic_fetch_add(p, v, __ATOMIC_RELAXED, __HIP_MEMORY_SCOPE_AGENT); }
__device__ __forceinline__ unsigned xb_xcc_id() { return (unsigned)__builtin_amdgcn_s_getreg((3 << 11) | 20) & 0xFu; }
#define XB_SPIN(cond, bar) do { unsigned _sp = 0; while (cond) { __builtin_amdgcn_s_sleep(1); \
    if ((++_sp & 255u) == 0u) { if (xb_ld(&(bar)[XB_TMO])) break; if (_sp > XB_SPIN_CAP) { atomicAdd(&(bar)[XB_TMO], 1u); break; } } } } while (0)

struct XcdBarrier {
    unsigned* bar; unsigned x;
    volatile LAS unsigned* st;
};

__device__ __forceinline__ XcdBarrier xcd_barrier_post(unsigned* bar, volatile LAS unsigned* st) {
    XcdBarrier b; b.bar = bar; b.x = xb_xcc_id(); b.st = st;
    if (threadIdx.x == 0) (void)xb_add(&bar[XB_XCNT(b.x)], 1u);
    return b;
}
__device__ __forceinline__ void xcd_barrier_complete(unsigned* bar, unsigned x, unsigned& nloc, unsigned& nx) {
    const unsigned G = gridDim.x * gridDim.y * gridDim.z;
    unsigned sum, cnt, mine, sp = 0u;
    for (;;) {
        sum = 0u; cnt = 0u; mine = 0u;
#pragma unroll
        for (unsigned j = 0; j < 16; ++j) { const unsigned c = xb_ld(&bar[XB_XCNT(j)]); sum += c; cnt += (c > 0u) ? 1u : 0u; mine = (j == x) ? c : mine; }
        if (sum == G) break;
        __builtin_amdgcn_s_sleep(1);
        if ((++sp & 255u) == 0u) { if (xb_ld(&bar[XB_TMO])) break; if (sp > XB_SPIN_CAP) { atomicAdd(&bar[XB_TMO], 1u); break; } }
    }
    nloc = mine > 0u ? mine : 1u; nx = cnt > 0u ? cnt : 1u;
}

__device__ __forceinline__ void xcd_barrier(const XcdBarrier& b) {
    asm volatile("s_waitcnt vmcnt(0)" ::: "memory");
    __syncthreads();
    if (threadIdx.x == 0) {
        unsigned* bar = b.bar;
        __builtin_amdgcn_s_waitcnt(0);
        unsigned nloc = b.st[0], nx = b.st[1];
        if (nloc == 0u) { xcd_barrier_complete(bar, b.x, nloc, nx); b.st[0] = nloc; b.st[1] = nx; }
        const unsigned old = xb_add(&bar[XB_XSUB(b.x)], 1u);
        const unsigned gen = old / nloc;
        if (old + 1u == (gen + 1u) * nloc) {
            __builtin_amdgcn_fence(__ATOMIC_RELEASE, "agent");
            asm volatile("s_waitcnt vmcnt(0)" ::: "memory");
            const unsigned og = xb_add(&bar[XB_TOP], 1u);
            const unsigned tg = og / nx;
            if (og + 1u == (tg + 1u) * nx) xb_add(&bar[XB_TOPGEN], 1u);
            else XB_SPIN(xb_ld(&bar[XB_TOPGEN]) == tg, bar);
            __builtin_amdgcn_fence(__ATOMIC_ACQUIRE, "agent");
            xb_add(&bar[XB_XGEN(b.x)], 1u);
            asm volatile("s_waitcnt vmcnt(0)" ::: "memory");
        } else {
            XB_SPIN(xb_ld(&bar[XB_XGEN(b.x)]) == gen, bar);
            __builtin_amdgcn_fence(__ATOMIC_ACQUIRE, "agent");
            asm volatile("s_waitcnt vmcnt(0)" ::: "memory");
        }
    }
    __syncthreads();
}

struct Frame {
    LAS unsigned char* lds;
    volatile LAS unsigned* MISC;
    gu32* ctl;
    int tid, lane, wave, vcu, G;
    const float *xp, *xs, *cache_k, *cache_v, *state_C, *state_n, *state_m; const int* page_table;
    const float *rel_bias, *norm_mix, *w_in, *b_ig, *b_fg, *ml_norm, *w_out, *norm_ffn, *w_up, *w_down, *norm_final;
    float* out; unsigned char* ws;
    bf16 *Win_t, *Wout_t, *Wup_t, *Wdn_t, *XN, *SEG, *MIX, *U;
    float *KSUM, *KSUMS, *IG, *LF, *H, *X1;
};
constexpr size_t SEG_ELEMS = SEG_BYTES / 2;
#define LUT8(F) ((const LAS float*)((F).lds + LUT8_OFF))
#define SEG_AQ(F) ((F).SEG + 0 * SEG_ELEMS)
#define SEG_AK(F) ((F).SEG + 1 * SEG_ELEMS)
#define SEG_AV(F) ((F).SEG + 2 * SEG_ELEMS)
#define SEG_MQ(F) ((F).SEG + 3 * SEG_ELEMS)
#define SEG_MK(F) ((F).SEG + 4 * SEG_ELEMS)
#define SEG_MV(F) ((F).SEG + 5 * SEG_ELEMS)
#define SEG_MO(F) ((F).SEG + 6 * SEG_ELEMS)

__device__ __forceinline__ float bf2f(unsigned short b) { return __builtin_bit_cast(float, (unsigned)b << 16); }
__device__ __forceinline__ float wave_sum(float v) {
#pragma unroll
    for (int o = 1; o < 64; o <<= 1) v += __shfl_xor(v, o);
    return v;
}
__device__ __forceinline__ void p0_transpose_item(const float* W, int K, int ldw, int N, bf16* WT, LAS float* scr, int item, int lane) {
    const int nblk = N / 32, kb = item / nblk, nb = item % nblk, k0 = 64 * kb, n0 = 32 * nb;
    float wv[32];
#pragma unroll
    for (int i = 0; i < 32; ++i) wv[i] = W[(size_t)(k0 + 2 * i + (lane >> 5)) * ldw + n0 + (lane & 31)];
#pragma unroll
    for (int i = 0; i < 32; i += 8) asm volatile("" : "+v"(wv[i]), "+v"(wv[i + 1]), "+v"(wv[i + 2]), "+v"(wv[i + 3]), "+v"(wv[i + 4]), "+v"(wv[i + 5]), "+v"(wv[i + 6]), "+v"(wv[i + 7]));
#pragma unroll
    for (int i = 0; i < 32; ++i) scr[(2 * i + (lane >> 5)) * 33 + (lane & 31)] = wv[i];
    LDS_WAIT(); asm volatile("" ::: "memory");
    const int c = lane & 7;
#pragma unroll
    for (int j = 0; j < 4; ++j) { const int n = (lane >> 3) + 8 * j; const LAS float* s = scr + (8 * c) * 33 + n;
        v4u o; o.x = pk2(s[0 * 33], s[1 * 33]); o.y = pk2(s[2 * 33], s[3 * 33]); o.z = pk2(s[4 * 33], s[5 * 33]); o.w = pk2(s[6 * 33], s[7 * 33]);
        *(GAS v4u*)(WT + (size_t)(n0 + n) * K + k0 + 8 * c) = o; }
    LDS_WAIT(); asm volatile("" ::: "memory");
}
__device__ __forceinline__ void load_row(const float* xrow, int lane, f32x4 (&v)[4]) {
    const GAS f32x4* xr = (const GAS f32x4*)xrow + lane;
#pragma unroll
    for (int j = 0; j < 4; ++j) v[j] = xr[64 * j];
}
__device__ __forceinline__ void load_row_nt(const float* xrow, int lane, f32x4 (&v)[4]) {
    const GAS f32x4* xr = (const GAS f32x4*)xrow + lane;
#pragma unroll
    for (int j = 0; j < 4; ++j) v[j] = __builtin_nontemporal_load(xr + 64 * j);
}
template <bool GATES>
__device__ __forceinline__ void rms_row_to_bf16(Frame& F, const f32x4 (&vin)[4], const float* gain, bf16* orow, int m) {
    const GAS f32x4* gr = (const GAS f32x4*)gain + F.lane;
    f32x4 v[4]; float s = 0.f;
#pragma unroll
    for (int j = 0; j < 4; ++j) { v[j] = vin[j]; s += (v[j].x * v[j].x + v[j].y * v[j].y) + (v[j].z * v[j].z + v[j].w * v[j].w); }
#pragma unroll
    for (int j = 0; j < 4; ++j) v[j] = v[j] * gr[64 * j];
    float g8[8];
    if (GATES) {
#pragma unroll
        for (int c = 0; c < 8; ++c) g8[c] = 0.f;
#pragma unroll
        for (int j = 0; j < 4; ++j)
#pragma unroll
            for (int i = 0; i < 4; ++i) { const int k = 256 * j + 4 * F.lane + i; const LAS f32x4* wr = (const LAS f32x4*)(F.lds + RING_OFF + 131072 - 32768) + 2 * k; const f32x4 w0 = wr[0], w1 = wr[1]; const float xv = v[j][i];
                g8[0] += xv * w0.x; g8[1] += xv * w0.y; g8[2] += xv * w0.z; g8[3] += xv * w0.w; g8[4] += xv * w1.x; g8[5] += xv * w1.y; g8[6] += xv * w1.z; g8[7] += xv * w1.w; }
    }
    const float rstd = 1.f / sqrtf(wave_sum(s) * (1.f / D) + RMS_EPS);
    GAS unsigned long long* o8 = (GAS unsigned long long*)orow + F.lane;
#pragma unroll
    for (int j = 0; j < 4; ++j) o8[64 * j] = (unsigned long long)pk2(v[j].x * rstd, v[j].y * rstd) | ((unsigned long long)pk2(v[j].z * rstd, v[j].w * rstd) << 32);
    if (GATES) {
#pragma unroll
        for (int c = 0; c < 8; ++c) g8[c] = wave_sum(g8[c]) * rstd;
        if (F.lane < 8) { float z = 0.f;
#pragma unroll
            for (int c = 0; c < 8; ++c) z = (F.lane == c) ? g8[c] : z;
            if (F.lane < 4) { F.IG[(size_t)m * 4 + F.lane] = z + F.b_ig[F.lane]; }
            else { const int h = F.lane - 4; z += F.b_fg[h]; F.LF[(size_t)m * 4 + h] = fminf(z, 0.f) - log1pf(expf(-fabsf(z))); } }
    }
}
__device__ __forceinline__ const float* xrow_of(Frame& F, int m) { return (m < MP) ? F.xp + (size_t)m * D : F.xs + (size_t)(m - MP) * D; }

constexpr int PS_SPLIT = 2048;
constexpr int P1_GEMM_WGS = 228;
__device__ __forceinline__ void page_sums(Frame& F, int u0, int u1, int w, int NW) {
    for (int u = u0 + w; u < u1; u += NW) {
        f32x4 a0 = {0.f, 0.f, 0.f, 0.f}, a1 = {0.f, 0.f, 0.f, 0.f};
        const int page = F.page_table[u];
        const GAS f32x4* base = (const GAS f32x4*)(F.cache_k + (size_t)page * PAGE * AW) + 2 * F.lane;
#pragma unroll 16
        for (int r = 0; r < PAGE; ++r) { a0 += __builtin_nontemporal_load(base + (size_t)r * (AW / 4)); a1 += __builtin_nontemporal_load(base + (size_t)r * (AW / 4) + 1); }
        GAS f32x4* o = (GAS f32x4*)(F.KSUMS + (size_t)u * AW) + 2 * F.lane; o[0] = a0; o[1] = a1;
    }
}
__device__ __forceinline__ void late_transposes(Frame& F, int w, int NW) {
    LAS float* scr = (LAS float*)(F.lds + RING_OFF + F.wave * 16384);
    constexpr int I_O = (D / 64) * (D / 32), I_UP = (D / 64) * (FF / 32), I_DN = (FF / 64) * (D / 32);
    for (int it = w; it < I_O + I_UP + I_DN; it += NW) {
        int r = it;
        if (r < I_O) { p0_transpose_item(F.w_out, D, D, D, F.Wout_t, scr, r, F.lane); continue; } r -= I_O;
        if (r < I_UP) { p0_transpose_item(F.w_up, D, FF, FF, F.Wup_t, scr, r, F.lane); continue; } r -= I_UP;
        p0_transpose_item(F.w_down, FF, D, D, F.Wdn_t, scr, r, F.lane);
    }
}
__device__ __forceinline__ void p0_prologue(Frame& F) {
    LAS float* scr = (LAS float*)(F.lds + RING_OFF + F.wave * 16384);
    const int gw = F.vcu * NWAVES + F.wave, NGW = F.G * NWAVES;
    constexpr int I_IN = (D / 64) * (NPG / 32);
    for (int it = gw; it < I_IN; it += NGW) p0_transpose_item(F.w_in, D, NPROJ, NPG, F.Win_t, scr, it, F.lane);
    __syncthreads();
    for (int i = F.tid; i < D * 2; i += NWAVES * 64) ((LAS f32x4*)(F.lds + RING_OFF + 131072 - 32768))[i] = *(const f32x4*)(F.w_in + (size_t)(i >> 1) * NPROJ + NPG + 4 * (i & 1));
    __syncthreads();
    {
        f32x4 r0[4], r1[4], r2[4];
        if (gw < M) load_row(xrow_of(F, gw), F.lane, r0);
        { const int m1 = (gw + NGW < M) ? gw + NGW : gw; load_row(xrow_of(F, m1 < M ? m1 : 0), F.lane, r1); }
        for (int m = gw; m < M; m += NGW) {
            const int m2 = (m + 2 * NGW < M) ? m + 2 * NGW : m; load_row(xrow_of(F, m2), F.lane, r2);
            rms_row_to_bf16<true>(F, r0, F.norm_mix, F.XN + (size_t)m * D, m);
#pragma unroll
            for (int j = 0; j < 4; ++j) { r0[j] = r1[j]; r1[j] = r2[j]; }
        }
    }
    page_sums(F, 0, PS_SPLIT, gw, NGW);
}

__device__ __forceinline__ int t5_bucket_small(int n) {
    if (n < 16) return n;
    int b = 16 + (int)(logf((float)n * (1.0f / 16.0f)) / 2.0794415416798357f * 16.0f);
    return b < 31 ? b : 31;
}

__device__ __forceinline__ void final_norm_rows(Frame& F) {
    const int gw = F.vcu * NWAVES + F.wave, NGW = F.G * NWAVES;
    f32x4 cur[4], nxt[4], nx2[4];
    if (gw < M) load_row_nt(F.X1 + (size_t)gw * D, F.lane, cur);
    { const int m1 = (gw + NGW < M) ? gw + NGW : (gw < M ? gw : 0); load_row_nt(F.X1 + (size_t)m1 * D, F.lane, nxt); }
    for (int m = gw; m < M; m += NGW) {
        const int m2 = (m + 2 * NGW < M) ? m + 2 * NGW : m; load_row_nt(F.X1 + (size_t)m2 * D, F.lane, nx2);
        const f32x4* gr = (const f32x4*)F.norm_final + F.lane;
        float s = 0.f;
#pragma unroll
        for (int j = 0; j < 4; ++j) s += (cur[j].x * cur[j].x + cur[j].y * cur[j].y) + (cur[j].z * cur[j].z + cur[j].w * cur[j].w);
        const float rstd = 1.f / sqrtf(wave_sum(s) * (1.f / D) + RMS_EPS);
        f32x4* o = (f32x4*)(F.out + ((m < MP) ? O_YP + (size_t)m * D : O_YS + (size_t)(m - MP) * D)) + F.lane;
#pragma unroll
        for (int j = 0; j < 4; ++j) __builtin_nontemporal_store(cur[j] * rstd * gr[64 * j], o + 64 * j);
#pragma unroll
        for (int j = 0; j < 4; ++j) { cur[j] = nxt[j]; nxt[j] = nx2[j]; }
    }
}

typedef float f32x16 __attribute__((ext_vector_type(16)));
typedef short s16x4 __attribute__((ext_vector_type(4)));
typedef short v4i16_t __attribute__((ext_vector_type(4)));
__device__ __forceinline__ f32x16 mfma32(bf16x8 a, bf16x8 b, f32x16 c) { return __builtin_amdgcn_mfma_f32_32x32x16_bf16(a, b, c, 0, 0, 0); }
__device__ __forceinline__ int crow(int r, int hi) { return (r & 3) + 8 * (r >> 2) + 4 * hi; }
__device__ __forceinline__ s16x4 vtr(const LAS unsigned char* p) { return __builtin_bit_cast(s16x4, __builtin_amdgcn_ds_read_tr16_b64_v4i16((LAS v4i16_t*)p)); }
__device__ __forceinline__ bf16x8 tfrag(const LAS unsigned char* tile, int T, int s, int ct, int lane) {
    const int i = lane & 15, hi = lane >> 5;
    const LAS unsigned char* p = tile + ct * (T * 64) + (16 * s + 4 * hi + (i >> 2)) * 64 + ((lane >> 4) & 1) * 32 + (i & 3) * 8;
    const s16x4 lo = vtr(p), hh = vtr(p + 512);
    return (bf16x8){lo[0], lo[1], lo[2], lo[3], hh[0], hh[1], hh[2], hh[3]};
}
__device__ __forceinline__ bf16x8 rfrag(const LAS unsigned char* tile, int T, int rt, int s, int lane) {
    return *(const LAS bf16x8*)(tile + (2 * s + (lane >> 5)) * (T * 16) + (32 * rt + (lane & 31)) * 16);
}
__device__ __forceinline__ float half_swap_add(float v) { return v + __shfl_xor(v, 32); }

constexpr int MLC = 256, NCH = SEQ / MLC  , NSEQ = NBATCH * MH  ;
constexpr size_t WS_DCT = 452 * MiB;
constexpr size_t WS_CT = 468 * MiB;
constexpr size_t WS_MLS = 476 * MiB;
constexpr size_t MLS_DN = 0, MLS_NC = 32768, MLS_SC = 65536, MLS_MC = 66048;
constexpr size_t WS_END2 = 477 * MiB;
constexpr int ML_TAB_OFF = LDSCTL_OFF + 2048;
constexpr int ML_MISC = 1280, ML_WSC = 1296;

__device__ __forceinline__ void ml_scalars(Frame& F, int row0, int h, float m0, LAS float* tab) {
    if (F.wave == 0) {
        const int l = F.lane; float lf[4], ig[4], b[4], u[4], pm[4];
#pragma unroll
        for (int i = 0; i < 4; ++i) { lf[i] = F.LF[(size_t)(row0 + 4 * l + i) * 4 + h]; ig[i] = F.IG[(size_t)(row0 + 4 * l + i) * 4 + h]; }
        b[0] = lf[0]; b[1] = b[0] + lf[1]; b[2] = b[1] + lf[2]; b[3] = b[2] + lf[3];
        float x = b[3];
#pragma unroll
        for (int o = 1; o < 64; o <<= 1) { const float y = __shfl_up(x, o); if (l >= o) x += y; }
        const float excl = x - b[3];
#pragma unroll
        for (int i = 0; i < 4; ++i) { b[i] += excl; u[i] = ig[i] - b[i]; }
        pm[0] = u[0]; pm[1] = fmaxf(pm[0], u[1]); pm[2] = fmaxf(pm[1], u[2]); pm[3] = fmaxf(pm[2], u[3]);
        float xm = pm[3];
#pragma unroll
        for (int o = 1; o < 64; o <<= 1) { const float y = __shfl_up(xm, o); if (l >= o) xm = fmaxf(xm, y); }
        float em = __shfl_up(xm, 1); if (l == 0) em = -INFINITY;
        em = fmaxf(em, m0);
#pragma unroll
        for (int i = 0; i < 4; ++i) { tab[4 * l + i] = b[i]; tab[256 + 4 * l + i] = u[i]; tab[512 + 4 * l + i] = fmaxf(em, pm[i]); }
        if (l == 63) { tab[ML_MISC] = xm; tab[ML_MISC + 1] = b[3]; }
    }
}
template <bool SCALE>
__device__ __forceinline__ void stage_T128(Frame& F, const bf16* src, LAS unsigned char* tile, const LAS float* utab, float Mloc) {
    v4u w[8];
#pragma unroll
    for (int i = 0; i < 8; ++i) { const int piece = F.tid + 512 * i, token = piece >> 4, ch = piece & 15; w[i] = *(const v4u*)(src + (size_t)token * 512 + 8 * ch); }
    asm volatile("" : "+v"(w[0]), "+v"(w[1]), "+v"(w[2]), "+v"(w[3]), "+v"(w[4]), "+v"(w[5]), "+v"(w[6]), "+v"(w[7]));
#pragma unroll
    for (int i = 0; i < 8; ++i) {
        const int piece = F.tid + 512 * i, token = piece >> 4, ch = piece & 15;
        v4u x = w[i];
        if (SCALE) { const float g = __expf(utab[token] - Mloc); unsigned ww[4] = {x.x, x.y, x.z, x.w};
#pragma unroll
            for (int k = 0; k < 4; ++k) ww[k] = pk2(__builtin_bit_cast(float, ww[k] << 16) * g, __builtin_bit_cast(float, ww[k] & 0xffff0000u) * g);
            x.x = ww[0]; x.y = ww[1]; x.z = ww[2]; x.w = ww[3]; }
        *(LAS v4u*)(tile + (ch >> 2) * (MLC * 64) + token * 64 + (ch & 3) * 16) = x;
    }
}
__device__ __forceinline__ void stage_R128(Frame& F, const bf16* src, LAS unsigned char* tile) {
    v4u w[8];
#pragma unroll
    for (int i = 0; i < 8; ++i) { const int piece = F.tid + 512 * i, token = piece >> 4, ch = piece & 15; w[i] = *(const v4u*)(src + (size_t)token * 512 + 8 * ch); }
    asm volatile("" : "+v"(w[0]), "+v"(w[1]), "+v"(w[2]), "+v"(w[3]), "+v"(w[4]), "+v"(w[5]), "+v"(w[6]), "+v"(w[7]));
#pragma unroll
    for (int i = 0; i < 8; ++i) { const int piece = F.tid + 512 * i, token = piece >> 4, ch = piece & 15; *(LAS v4u*)(tile + ch * (MLC * 16) + token * 16) = w[i]; }
}
__device__ __forceinline__ void mlstm_stepA(Frame& F, int unit) {
    const int seq = unit >> 4, c = unit & 15, b = seq >> 2, h = seq & 3, row0 = b * SEQ + c * MLC;
    LAS float* tab = (LAS float*)(F.lds + ML_TAB_OFF);
    LAS unsigned char* KT = F.lds + RING_OFF; LAS unsigned char* VT = F.lds + RING_OFF + 65536;
    float* mls = (float*)((unsigned char*)F.ws + WS_MLS);
    v4u kw[8], vw[8];
    { const bf16* ksrc = SEG_MK(F) + (size_t)row0 * MW + h * MD; const bf16* vsrc = SEG_MV(F) + (size_t)row0 * MW + h * MD;
#pragma unroll
      for (int i = 0; i < 8; ++i) { const int piece = F.tid + 512 * i, token = piece >> 4, ch = piece & 15; kw[i] = *(const v4u*)(ksrc + (size_t)token * 512 + 8 * ch); vw[i] = *(const v4u*)(vsrc + (size_t)token * 512 + 8 * ch); } }
    ml_scalars(F, row0, h, -INFINITY, tab);
    asm volatile("" : "+v"(kw[0]), "+v"(kw[1]), "+v"(kw[2]), "+v"(kw[3]), "+v"(kw[4]), "+v"(kw[5]), "+v"(kw[6]), "+v"(kw[7]));
    asm volatile("" : "+v"(vw[0]), "+v"(vw[1]), "+v"(vw[2]), "+v"(vw[3]), "+v"(vw[4]), "+v"(vw[5]), "+v"(vw[6]), "+v"(vw[7]));
    __syncthreads();
    const float Mloc = tab[ML_MISC];
#pragma unroll
    for (int i = 0; i < 8; ++i) {
        const int piece = F.tid + 512 * i, token = piece >> 4, ch = piece & 15;
        const float g = __expf(tab[256 + token] - Mloc); unsigned ww[4] = {kw[i].x, kw[i].y, kw[i].z, kw[i].w};
#pragma unroll
        for (int k = 0; k < 4; ++k) ww[k] = pk2(__builtin_bit_cast(float, ww[k] << 16) * g, __builtin_bit_cast(float, ww[k] & 0xffff0000u) * g);
        v4u x; x.x = ww[0]; x.y = ww[1]; x.z = ww[2]; x.w = ww[3];
        const int off = (ch >> 2) * (MLC * 64) + token * 64 + (ch & 3) * 16;
        *(LAS v4u*)(KT + off) = x; *(LAS v4u*)(VT + off) = vw[i];
    }
    __syncthreads();
    const int et = F.wave >> 1, dt0 = 2 * (F.wave & 1);
    f32x16 acc0 = {}, acc1 = {};
#pragma unroll 4
    for (int s = 0; s < 16; ++s) {
        const bf16x8 a = tfrag(VT, MLC, s, et, F.lane), b0 = tfrag(KT, MLC, s, dt0, F.lane), b1 = tfrag(KT, MLC, s, dt0 + 1, F.lane);
        acc0 = mfma32(a, b0, acc0); acc1 = mfma32(a, b1, acc1);
    }
    float* dct = (float*)((unsigned char*)F.ws + WS_DCT) + ((size_t)(seq * NCH + c)) * MD * MD;
    const int hi = F.lane >> 5, cl = F.lane & 31;
#pragma unroll
    for (int r = 0; r < 16; ++r) { const int e = 32 * et + crow(r, hi); dct[(size_t)e * MD + 32 * dt0 + cl] = acc0[r]; dct[(size_t)e * MD + 32 * (dt0 + 1) + cl] = acc1[r]; }
    { const int d = F.tid & 127, qd = F.tid >> 7; float s = 0.f;
      const LAS unsigned short* kp = (const LAS unsigned short*)(KT + (d >> 5) * (MLC * 64) + (d & 31) * 2);
#pragma unroll 8
      for (int j = 0; j < 64; ++j) s += bf2f(kp[(size_t)(64 * qd + j) * 32]);
      tab[768 + F.tid] = s; }
    __syncthreads();
    if (F.tid < 128) mls[MLS_DN + (size_t)(seq * NCH + c) * MD + F.tid] = (tab[768 + F.tid] + tab[768 + 128 + F.tid]) + (tab[768 + 256 + F.tid] + tab[768 + 384 + F.tid]);
    if (F.tid == 0) { mls[MLS_SC + (seq * NCH + c) * 2] = Mloc; mls[MLS_SC + (seq * NCH + c) * 2 + 1] = tab[ML_MISC + 1]; }
    __syncthreads();
}
__device__ __forceinline__ void mlstm_stepB(Frame& F, int unit) {
    const int seq = unit >> 4, sl = unit & 15, d = F.tid & 127, el = F.tid >> 7, e0 = 8 * sl + el, e1 = e0 + 4;
    float* mls = (float*)((unsigned char*)F.ws + WS_MLS);
    const float* dctb = (const float*)((unsigned char*)F.ws + WS_DCT) + (size_t)seq * NCH * MD * MD;
    bf16* ctb = (bf16*)((unsigned char*)F.ws + WS_CT) + (size_t)seq * NCH * MD * MD;
    float x0[NCH], x1[NCH], dn[NCH];
#pragma unroll
    for (int c = 0; c < NCH; ++c) { x0[c] = dctb[(size_t)c * MD * MD + (size_t)e0 * MD + d]; x1[c] = dctb[(size_t)c * MD * MD + (size_t)e1 * MD + d]; dn[c] = mls[MLS_DN + (size_t)(seq * NCH + c) * MD + d]; }
    float C0 = 0.f, C1 = 0.f, nv = 0.f, m = 0.f;
    const bool nwriter = (sl == 0) && (el == 0);
#pragma unroll
    for (int c = 0; c < NCH; ++c) {
        ctb[(size_t)c * MD * MD + (size_t)e0 * MD + d] = (bf16)f2bf(C0); ctb[(size_t)c * MD * MD + (size_t)e1 * MD + d] = (bf16)f2bf(C1);
        if (nwriter) { mls[MLS_NC + (size_t)(seq * NCH + c) * MD + d] = nv; if (d == 0) mls[MLS_MC + seq * NCH + c] = m; }
        const float Mloc = mls[MLS_SC + (seq * NCH + c) * 2], bL = mls[MLS_SC + (seq * NCH + c) * 2 + 1];
        const float Mt = fmaxf(m, Mloc), fa = __expf(m - Mt), fb = __expf(Mloc - Mt);
        C0 = fa * C0 + fb * x0[c]; C1 = fa * C1 + fb * x1[c]; nv = fa * nv + fb * dn[c];
        m = bL + Mt;
    }
    F.out[O_CP + (size_t)seq * MD * MD + (size_t)d * MD + e0] = C0; F.out[O_CP + (size_t)seq * MD * MD + (size_t)d * MD + e1] = C1;
    if (nwriter) { F.out[O_NP + (size_t)seq * MD + d] = nv; if (d == 0) F.out[O_MP + seq] = m; }
}
__device__ __forceinline__ void mlstm_stepC(Frame& F, int unit) {
    const int seq = unit >> 4, c = unit & 15, b = seq >> 2, h = seq & 3, row0 = b * SEQ + c * MLC;
    LAS float* tab = (LAS float*)(F.lds + ML_TAB_OFF);
    LAS unsigned char* KR = F.lds + RING_OFF; LAS unsigned char* VT = F.lds + RING_OFF + 65536;
    const float* mls = (const float*)((unsigned char*)F.ws + WS_MLS);
    const float m0 = mls[MLS_MC + seq * NCH + c];
    v4u kw[8], vw[8];
    { const bf16* ksrc = SEG_MK(F) + (size_t)row0 * MW + h * MD; const bf16* vsrc = SEG_MV(F) + (size_t)row0 * MW + h * MD;
#pragma unroll
      for (int i = 0; i < 8; ++i) { const int piece = F.tid + 512 * i, token = piece >> 4, ch = piece & 15; kw[i] = *(const v4u*)(ksrc + (size_t)token * 512 + 8 * ch); vw[i] = *(const v4u*)(vsrc + (size_t)token * 512 + 8 * ch); } }
    ml_scalars(F, row0, h, m0, tab);
    if (F.tid < 128) tab[768 + F.tid] = mls[MLS_NC + (size_t)(seq * NCH + c) * MD + F.tid];
    asm volatile("" : "+v"(kw[0]), "+v"(kw[1]), "+v"(kw[2]), "+v"(kw[3]), "+v"(kw[4]), "+v"(kw[5]), "+v"(kw[6]), "+v"(kw[7]));
    asm volatile("" : "+v"(vw[0]), "+v"(vw[1]), "+v"(vw[2]), "+v"(vw[3]), "+v"(vw[4]), "+v"(vw[5]), "+v"(vw[6]), "+v"(vw[7]));
#pragma unroll
    for (int i = 0; i < 8; ++i) { const int piece = F.tid + 512 * i, token = piece >> 4, ch = piece & 15;
        *(LAS v4u*)(KR + ch * (MLC * 16) + token * 16) = kw[i];
        *(LAS v4u*)(VT + (ch >> 2) * (MLC * 64) + token * 64 + (ch & 3) * 16) = vw[i]; }
    __syncthreads();
    const int w = F.wave, lane = F.lane, tl = lane & 31, hi = lane >> 5, t0 = 32 * w, t = t0 + tl;
    bf16x8 qf[8];
    { const bf16* qp = SEG_MQ(F) + (size_t)(row0 + t) * MW + h * MD + 8 * hi;
#pragma unroll
      for (int s = 0; s < 8; ++s) qf[s] = *(const bf16x8*)(qp + 16 * s); }
    float qn = 0.f;
#pragma unroll
    for (int s = 0; s < 8; ++s)
#pragma unroll
        for (int i = 0; i < 8; ++i) qn += bf2f((unsigned short)qf[s][i]) * tab[768 + 16 * s + 8 * hi + i];
    qn = half_swap_add(qn);
    const float Mt = tab[512 + t], wt = __expf(m0 - Mt);
    f32x16 acc[4];
    const bf16* ct = (const bf16*)((unsigned char*)F.ws + WS_CT) + (size_t)(seq * NCH + c) * MD * MD;
#pragma unroll
    for (int et = 0; et < 4; ++et) { acc[et] = (f32x16){};
#pragma unroll
        for (int s = 0; s < 8; ++s) { const bf16x8 cf = *(const bf16x8*)(ct + (size_t)(32 * et + tl) * MD + 16 * s + 8 * hi); acc[et] = mfma32(qf[s], cf, acc[et]); } }
    LAS float* wsc = tab + ML_WSC + 64 * w;
    if (hi == 0) wsc[tl] = wt;
    asm volatile("s_waitcnt lgkmcnt(0)" ::: "memory");
#pragma unroll
    for (int r = 0; r < 16; ++r) { const float ws_ = wsc[crow(r, hi)];
#pragma unroll
        for (int et = 0; et < 4; ++et) acc[et][r] *= ws_; }
    float rs = 0.f;
    for (int jt = 0; jt <= w; ++jt) {
        f32x16 st = {};
#pragma unroll
        for (int s = 0; s < 8; ++s) st = mfma32(rfrag(KR, MLC, jt, s, lane), qf[s], st);
#pragma unroll
        for (int r = 0; r < 16; ++r) { const int j = 32 * jt + crow(r, hi); const float v = st[r] * __expf(tab[256 + j] - Mt); st[r] = (j <= t) ? v : 0.f; rs += st[r]; }
        bf16x8 pa0, pa1;
#pragma unroll
        for (int i = 0; i < 4; ++i) { const unsigned p0 = pk2(st[2 * i], st[2 * i + 1]), p1 = pk2(st[8 + 2 * i], st[8 + 2 * i + 1]);
            pa0[2 * i] = (short)(p0 & 0xffff); pa0[2 * i + 1] = (short)(p0 >> 16); pa1[2 * i] = (short)(p1 & 0xffff); pa1[2 * i + 1] = (short)(p1 >> 16); }
#pragma unroll
        for (int et = 0; et < 4; ++et) { acc[et] = mfma32(pa0, tfrag(VT, MLC, 2 * jt, et, lane), acc[et]); acc[et] = mfma32(pa1, tfrag(VT, MLC, 2 * jt + 1, et, lane), acc[et]); }
    }
    rs = half_swap_add(rs);
    const float den = wt * qn + rs, mt = tab[t] + Mt, sc = 1.f / fmaxf(fabsf(den), __expf(-mt));
    asm volatile("s_waitcnt lgkmcnt(0)" ::: "memory");
    if (hi == 0) wsc[32 + tl] = sc;
    asm volatile("s_waitcnt lgkmcnt(0)" ::: "memory");
    __syncthreads();
    LAS float* hl = (LAS float*)(F.lds + RING_OFF) + w * 4096;
#pragma unroll
    for (int r = 0; r < 16; ++r) { const int tr = crow(r, hi); const float s_ = wsc[32 + tr];
#pragma unroll
        for (int et = 0; et < 4; ++et) hl[tr * 128 + 32 * et + tl] = acc[et][r] * s_; }
    asm volatile("s_waitcnt lgkmcnt(0)" ::: "memory");
    {
        const float g0 = F.ml_norm[h * MD + 2 * lane], g1 = F.ml_norm[h * MD + 2 * lane + 1];
#pragma unroll
        for (int hb = 0; hb < 2; ++hb) {
            unsigned mo[16];
#pragma unroll
            for (int i = 0; i < 16; ++i) mo[i] = *(const unsigned*)(SEG_MO(F) + (size_t)(row0 + 32 * w + 16 * hb + i) * MW + h * MD + 2 * lane);
#pragma unroll
            for (int i = 0; i < 16; ++i) { const size_t row = (size_t)(row0 + 32 * w + 16 * hb + i);
                typedef float f32x2_l __attribute__((ext_vector_type(2))); const f32x2_l hv = *(const LAS f32x2_l*)(hl + (16 * hb + i) * 128 + 2 * lane);
                const float rstd = 1.f / sqrtf(wave_sum(hv.x * hv.x + hv.y * hv.y) * (1.f / MD) + RMS_EPS);
                const float z0 = __builtin_bit_cast(float, mo[i] << 16), z1 = __builtin_bit_cast(float, mo[i] & 0xffff0000u);
                *(unsigned*)(F.MIX + row * D + AW + h * MD + 2 * lane) = pk2(hv.x * rstd * g0 / (1.f + __expf(-z0)), hv.y * rstd * g1 / (1.f + __expf(-z1))); }
        }
    }
    __syncthreads();
}

__device__ __forceinline__ void mlstm_sample_full(Frame& F, int seq) {
    const int sb = seq >> 2, h = seq & 3, e = F.tid & 127, dq = F.tid >> 7, row0 = MP + sb * DS;
    LAS float* red = (LAS float*)(F.lds + RING_OFF);
    float C[32], nn[32];
    const float* C0 = F.state_C + (size_t)seq * MD * MD;
#pragma unroll
    for (int i = 0; i < 32; ++i) { C[i] = C0[(size_t)(32 * dq + i) * MD + e]; nn[i] = F.state_n[(size_t)seq * MD + 32 * dq + i]; }
    float mm = F.state_m[seq];
    LAS unsigned* inb = (LAS unsigned*)(red + 2048);
    LAS float* gts = red + 2048 + 1536;
    __syncthreads();
    for (int i = F.tid; i < DS * 3 * 64; i += NWAVES * 64) { const int t = i / 192, r = i % 192, which = r >> 6, wd = r & 63;
        inb[i] = *((const unsigned*)(F.SEG + (size_t)(3 + which) * SEG_ELEMS + (size_t)(row0 + t) * MW + h * MD) + wd); }
    if (F.tid < DS * 2) { const int t = F.tid >> 1; gts[F.tid] = (F.tid & 1) ? F.LF[(size_t)(row0 + t) * 4 + h] : F.IG[(size_t)(row0 + t) * 4 + h]; }
    __syncthreads();
    for (int t = 0; t < DS; ++t) {
        const LAS v4u* qp = (const LAS v4u*)(inb + t * 192) + 4 * dq; const LAS v4u* kp = (const LAS v4u*)(inb + t * 192 + 64) + 4 * dq;
        const unsigned vw = inb[t * 192 + 128 + (e >> 1)]; const float v = __builtin_bit_cast(float, (e & 1) ? (vw & 0xffff0000u) : (vw << 16));
        const float ig = gts[2 * t], lf = gts[2 * t + 1];
        const float mn = fmaxf(lf + mm, ig), fs = __expf(lf + mm - mn), is = __expf(ig - mn);
        float num = 0.f, den = 0.f;
#pragma unroll
        for (int c = 0; c < 4; ++c) { const v4u qw = qp[c], kw = kp[c]; const unsigned qq[4] = {qw.x, qw.y, qw.z, qw.w}, kk[4] = {kw.x, kw.y, kw.z, kw.w};
#pragma unroll
            for (int j = 0; j < 8; ++j) { const int i = 8 * c + j;
                const float qv = __builtin_bit_cast(float, (j & 1) ? (qq[j >> 1] & 0xffff0000u) : (qq[j >> 1] << 16)), kv = __builtin_bit_cast(float, (j & 1) ? (kk[j >> 1] & 0xffff0000u) : (kk[j >> 1] << 16));
                C[i] = fs * C[i] + is * kv * v; nn[i] = fs * nn[i] + is * kv; num += qv * C[i]; den += qv * nn[i]; } }
        mm = mn;
        red[dq * 128 + e] = num; red[512 + dq * 128 + e] = den;
        __syncthreads();
        if (dq == 0) { const float nu = (red[e] + red[128 + e]) + (red[256 + e] + red[384 + e]), de = (red[512 + e] + red[640 + e]) + (red[768 + e] + red[896 + e]);
            red[1024 + t * 128 + e] = nu / fmaxf(fabsf(de), __expf(-mn)); }
        __syncthreads();
    }
    { const int t = F.wave; const size_t row = (size_t)(row0 + t);
      const float h0 = red[1024 + t * 128 + 2 * F.lane], h1 = red[1024 + t * 128 + 2 * F.lane + 1];
      const float rstd = 1.f / sqrtf(wave_sum(h0 * h0 + h1 * h1) * (1.f / MD) + RMS_EPS);
      const unsigned mo = *(const unsigned*)(SEG_MO(F) + row * MW + h * MD + 2 * F.lane);
      const float z0 = __builtin_bit_cast(float, mo << 16), z1 = __builtin_bit_cast(float, mo & 0xffff0000u);
      const float g0 = F.ml_norm[h * MD + 2 * F.lane], g1 = F.ml_norm[h * MD + 2 * F.lane + 1];
      *(unsigned*)(F.MIX + row * D + AW + h * MD + 2 * F.lane) = pk2(h0 * rstd * g0 / (1.f + __expf(-z0)), h1 * rstd * g1 / (1.f + __expf(-z1))); }
    float* Co = F.out + O_CS + (size_t)seq * MD * MD;
#pragma unroll
    for (int i = 0; i < 32; ++i) Co[(size_t)(32 * dq + i) * MD + e] = C[i];
    if (e == 0) {
#pragma unroll
        for (int i = 0; i < 32; ++i) F.out[O_NS + (size_t)seq * MD + 32 * dq + i] = nn[i];
        if (dq == 0) F.out[O_MS + seq] = mm;
    }
    __syncthreads();
}

constexpr size_t WS_LIST = 480 * MiB;
constexpr size_t WS_CNT = 484 * MiB;
constexpr size_t WS_PARTO = 485 * MiB;
constexpr size_t WS_PARTS = 534 * MiB;
constexpr size_t WS_END3 = 538 * MiB;
constexpr size_t WS_QG = 560 * MiB;
constexpr size_t WS_END_QG = 682 * MiB;
__host__ __device__ constexpr int past_item_index(int bh, int n, int o) { return bh * 120 + 15 * n - (n * (n - 1)) / 2 + (o - n - 1); }
constexpr int AT_WSC = 192;
constexpr int AT_LUT = 768;

__device__ __forceinline__ void build_lut(Frame& F, const LAS int* bucket, int h, LAS float* lut) {
    if (F.tid < 128) lut[F.tid] = F.rel_bias[bucket[F.tid] * AH + h];
    if (F.tid == 128) lut[128] = F.rel_bias[31 * AH + h];
}
__device__ __forceinline__ void stage_kv64(Frame& F, const bf16* ksrc, const bf16* vsrc, LAS unsigned char* KR, LAS unsigned char* VT) {
    v4u kk[4], vv[4];
#pragma unroll
    for (int i = 0; i < 4; ++i) { const int piece = F.tid + 512 * i, key = piece >> 3, ch = piece & 7;
        kk[i] = *(const v4u*)(ksrc + (size_t)key * AW + 8 * ch); vv[i] = *(const v4u*)(vsrc + (size_t)key * AW + 8 * ch); }
    asm volatile("" : "+v"(kk[0]), "+v"(kk[1]), "+v"(kk[2]), "+v"(kk[3]), "+v"(vv[0]), "+v"(vv[1]), "+v"(vv[2]), "+v"(vv[3]));
#pragma unroll
    for (int i = 0; i < 4; ++i) { const int piece = F.tid + 512 * i, key = piece >> 3, ch = piece & 7;
        *(LAS v4u*)(KR + ch * (256 * 16) + key * 16) = kk[i];
        *(LAS v4u*)(VT + (ch >> 2) * (256 * 64) + key * 64 + (ch & 3) * 16) = vv[i]; }
}
__device__ __forceinline__ void attn_select2(Frame& F, int ua, int ub) {
    const int half = F.tid >> 8, qt = F.tid & 255, unit = half ? ub : ua;
    const bool act = unit >= 0;
    const int bh = act ? unit / 15 : 0, o = act ? unit % 15 + 1 : 1, b = bh >> 3, h = bh & 7;
    LAS float* ks = (LAS float*)(F.lds + RING_OFF + half * 8192);
    LAS int* cnt = (LAS int*)(F.lds + RING_OFF + half * 8192 + 4096);
    __syncthreads();
    const int m = b * SEQ + o * 256 + qt;
    v4u qw[8];
    { const v4u* qp = (const v4u*)(SEG_AQ(F) + (size_t)m * AW + h * AD);
#pragma unroll
      for (int c = 0; c < 8; ++c) qw[c] = act ? qp[c] : (v4u){0u, 0u, 0u, 0u}; }
    float kv[4];
#pragma unroll
    for (int i = 0; i < 4; ++i) { const int idx = qt + 256 * i; kv[i] = (act && idx < o * 64) ? F.KSUM[((size_t)(b * NBLK_P + (idx >> 6))) * AW + h * AD + (idx & 63)] : 0.f; }
#pragma unroll
    for (int i = 0; i < 4; ++i) { const int idx = qt + 256 * i; if (idx < 15 * 64) ks[idx] = kv[i]; }
    if (qt < 16) cnt[qt] = 0;
    __syncthreads();
    if (act) {
        float q[64];
#pragma unroll
        for (int c = 0; c < 8; ++c) { const v4u w = qw[c];
            q[8 * c + 0] = __builtin_bit_cast(float, w.x << 16); q[8 * c + 1] = __builtin_bit_cast(float, w.x & 0xffff0000u);
            q[8 * c + 2] = __builtin_bit_cast(float, w.y << 16); q[8 * c + 3] = __builtin_bit_cast(float, w.y & 0xffff0000u);
            q[8 * c + 4] = __builtin_bit_cast(float, w.z << 16); q[8 * c + 5] = __builtin_bit_cast(float, w.z & 0xffff0000u);
            q[8 * c + 6] = __builtin_bit_cast(float, w.w << 16); q[8 * c + 7] = __builtin_bit_cast(float, w.w & 0xffff0000u); }
        float s0 = -INFINITY, s1 = -INFINITY, s2 = -INFINITY; int i0 = -1, i1 = -1, i2 = -1;
        for (int n = 0; n < o; ++n) {
            float s = 0.f;
#pragma unroll
            for (int d = 0; d < 64; ++d) s += q[d] * ks[n * 64 + d];
            if (s > s0) { s2 = s1; i2 = i1; s1 = s0; i1 = i0; s0 = s; i0 = n; }
            else if (s > s1) { s2 = s1; i2 = i1; s1 = s; i1 = n; }
            else if (s > s2) { s2 = s; i2 = n; }
        }
        unsigned short* list = (unsigned short*)(F.ws + WS_LIST);
#pragma unroll
        for (int j = 0; j < 3; ++j) {
            const int n = (j == 0) ? i0 : (j == 1 ? i1 : i2);
            if (n >= 0) { const int slot = __hip_atomic_fetch_add(&cnt[n], 1, __ATOMIC_RELAXED, __HIP_MEMORY_SCOPE_WORKGROUP);
                const size_t e = (size_t)past_item_index(bh, n, o) * 256 + slot;
                list[e] = (unsigned short)(qt | (j << 8));
                v4u* qg = (v4u*)((bf16*)(F.ws + WS_QG) + e * 64);
#pragma unroll
                for (int c = 0; c < 8; ++c) qg[c] = qw[c]; }
        }
    }
    __syncthreads();
    if (act && qt < o) ((int*)(F.ws + WS_CNT))[past_item_index(bh, qt, o)] = cnt[qt];
}
struct AttnOut { f32x16 o0, o1; float mx, l; };
__device__ __forceinline__ float max3f(float a, float b, float c) { float r; asm("v_max3_f32 %0, %1, %2, %3" : "=v"(r) : "v"(a), "v"(b), "v"(c)); return r; }
__device__ __forceinline__ void pack_p(const f32x16& p, bf16x8& pa0, bf16x8& pa1) {
#pragma unroll
    for (int i = 0; i < 4; ++i) { const unsigned p0 = pk2(p[2 * i], p[2 * i + 1]), p1 = pk2(p[8 + 2 * i], p[8 + 2 * i + 1]);
        pa0[2 * i] = (short)(p0 & 0xffff); pa0[2 * i + 1] = (short)(p0 >> 16); pa1[2 * i] = (short)(p1 & 0xffff); pa1[2 * i + 1] = (short)(p1 >> 16); }
}
template <bool CAUSAL>
__device__ __forceinline__ f32x16 score_tile(const LAS unsigned char* KR, const bf16x8 (&qf)[4], int lane, int kt, int tq, bool lutp, const LAS float* lut, float b31) {
    const int hi = lane >> 5;
    f32x16 a = {};
#pragma unroll
    for (int s = 0; s < 4; ++s) a = mfma32(rfrag(KR, 256, kt, s, lane), qf[s], a);
    if (lutp) {
#pragma unroll
        for (int r = 0; r < 16; ++r) { const int key = 32 * kt + crow(r, hi); int dist = tq - key; dist = dist < 0 ? 0 : (dist > 128 ? 128 : dist); a[r] += lut[dist]; if (CAUSAL && key > tq) a[r] = -INFINITY; }
    } else {
#pragma unroll
        for (int r = 0; r < 16; ++r) a[r] += b31;
    }
    return a;
}
template <bool CAUSAL>
__device__ __forceinline__ AttnOut wave_attend(const LAS unsigned char* KR, const LAS unsigned char* VT, const bf16x8 (&qf)[4], int lane, int nkt  ,
                                               int tq  , bool use_lut  , int lut_from_kt  , const LAS float* lut, float b31, int kt0 = 0  ) {
    AttnOut R; R.o0 = (f32x16){}; R.o1 = (f32x16){}; R.mx = -1e30f; R.l = 0.f;
    for (int kt = kt0; kt < nkt; kt += 2) {
        const bool two = (kt + 1 < nkt);
        f32x16 a0 = score_tile<CAUSAL>(KR, qf, lane, kt, tq, use_lut && kt >= lut_from_kt, lut, b31);
        f32x16 a1 = a0;
        if (two) a1 = score_tile<CAUSAL>(KR, qf, lane, kt + 1, tq, use_lut && kt + 1 >= lut_from_kt, lut, b31);
        float cm0 = max3f(a0[0], a0[1], a1[0]), cm1 = max3f(a0[2], a0[3], a1[1]);
        cm0 = max3f(cm0, a1[2], a1[3]);
#pragma unroll
        for (int r = 4; r < 16; r += 4) { cm0 = max3f(cm0, a0[r], a0[r + 1]); cm1 = max3f(cm1, a0[r + 2], a0[r + 3]); cm0 = max3f(cm0, a1[r], a1[r + 1]); cm1 = max3f(cm1, a1[r + 2], a1[r + 3]); }
        float cm = max3f(cm0, cm1, cm1);
        cm = fmaxf(cm, __shfl_xor(cm, 32));
        constexpr float L2E = 1.4426950408889634f;
        const float mn = fmaxf(R.mx, cm), f = __builtin_amdgcn_exp2f((R.mx - mn) * L2E), mnl = mn * L2E;
        R.mx = mn; R.l *= f;
#pragma unroll
        for (int r = 0; r < 16; ++r) { R.o0[r] *= f; R.o1[r] *= f; }
        float ls = 0.f;
#pragma unroll
        for (int r = 0; r < 16; ++r) { a0[r] = __builtin_amdgcn_exp2f(fmaf(a0[r], L2E, -mnl)); ls += a0[r]; }
        bf16x8 pa0, pa1;
        pack_p(a0, pa0, pa1);
        R.o0 = mfma32(tfrag(VT, 256, 2 * kt, 0, lane), pa0, R.o0); R.o1 = mfma32(tfrag(VT, 256, 2 * kt, 1, lane), pa0, R.o1);
        R.o0 = mfma32(tfrag(VT, 256, 2 * kt + 1, 0, lane), pa1, R.o0); R.o1 = mfma32(tfrag(VT, 256, 2 * kt + 1, 1, lane), pa1, R.o1);
        if (two) {
#pragma unroll
            for (int r = 0; r < 16; ++r) { a1[r] = __builtin_amdgcn_exp2f(fmaf(a1[r], L2E, -mnl)); ls += a1[r]; }
            pack_p(a1, pa0, pa1);
            R.o0 = mfma32(tfrag(VT, 256, 2 * kt + 2, 0, lane), pa0, R.o0); R.o1 = mfma32(tfrag(VT, 256, 2 * kt + 2, 1, lane), pa0, R.o1);
            R.o0 = mfma32(tfrag(VT, 256, 2 * kt + 3, 0, lane), pa1, R.o0); R.o1 = mfma32(tfrag(VT, 256, 2 * kt + 3, 1, lane), pa1, R.o1);
        }
        R.l += ls;
    }
    R.l += __shfl_xor(R.l, 32);
    return R;
}
constexpr int PAST_NITEMS = 32 * 120;
__device__ __forceinline__ void past_item_decode(int it, int& bh, int& n, int& o) { bh = it / 120; int pr = it % 120; n = 0; while (pr >= 15 - n) { pr -= 15 - n; ++n; } o = n + 1 + pr; }
__device__ __forceinline__ void attn_past_items(Frame& F, const LAS int* bucket) {
    LAS unsigned char* KR = F.lds + RING_OFF; LAS unsigned char* VT = F.lds + RING_OFF + 32768;
    LAS int* S = (LAS int*)(F.lds + RING_OFF + 65536);
    LAS int* C = S + 4096;
    LAS int* wsum = C + 4096;
    const int lane = F.lane, tl = lane & 31, hi = lane >> 5;
    const int* cntg = (const int*)(F.ws + WS_CNT);
    __syncthreads();
    {
        int cc[8] = {0, 0, 0, 0, 0, 0, 0, 0};
        if (8 * F.tid < PAST_NITEMS) { const int4 a = *(const int4*)(cntg + 8 * F.tid), bq = *(const int4*)(cntg + 8 * F.tid + 4); cc[0] = a.x; cc[1] = a.y; cc[2] = a.z; cc[3] = a.w; cc[4] = bq.x; cc[5] = bq.y; cc[6] = bq.z; cc[7] = bq.w; }
        int g[8], tot = 0;
#pragma unroll
        for (int k = 0; k < 8; ++k) { g[k] = (cc[k] + 31) >> 5; tot += g[k]; }
        int x = tot;
#pragma unroll
        for (int o = 1; o < 64; o <<= 1) { const int y = __shfl_up(x, o); if (lane >= o) x += y; }
        if (lane == 63) wsum[F.wave] = x;
        __syncthreads();
        int base = x - tot;
#pragma unroll
        for (int w = 0; w < 8; ++w) if (w < F.wave) base += wsum[w];
#pragma unroll
        for (int k = 0; k < 8; ++k) { const int it = 8 * F.tid + k; if (it < PAST_NITEMS) { S[it] = base; C[it] = cc[k]; } base += g[k]; }
        if (F.tid == 511) S[PAST_NITEMS] = base;
        __syncthreads();
    }
    const int T = S[PAST_NITEMS];
    const int lo = (int)(((long long)T * blockIdx.x) / F.G), hiG = (int)(((long long)T * (blockIdx.x + 1)) / F.G);
    int it = 0;
    { int a = 0, b = PAST_NITEMS; while (b - a > 1) { const int m = (a + b) >> 1; if (S[m] <= lo) a = m; else b = m; } it = a; }
    while (lo < hiG && it < PAST_NITEMS && S[it] < hiG) {
        if (S[it + 1] == S[it] || S[it + 1] <= lo) { ++it; continue; }
        int bh, n, o0; past_item_decode(it, bh, n, o0);
        const int b = bh >> 3, h = bh & 7;
        const int run_end_item = it + (15 - o0) + 1;
        const int ra = S[it] > lo ? S[it] : lo;
        int rbx = S[run_end_item < PAST_NITEMS ? run_end_item : PAST_NITEMS]; const int rb = rbx < hiG ? rbx : hiG;
        int wi = it;
        int gamma = ra + F.wave;
        int p_dst = -1, p_tl = 0, p_o = 0; bf16x8 pq[4] = {};
        int r_dst = -1, r_tl = 0, r_o = 0; bf16x8 rq[4] = {};
#define PAST_FETCH(G_, DST_, TL_, O_, Q_) do { while (S[wi + 1] <= (G_)) ++wi; const int o_ = o0 + (wi - it); const int c_ = C[wi]; \
            const int qi_ = 32 * ((G_) - S[wi]) + tl; const bool v_ = qi_ < c_; const size_t e_ = (size_t)wi * 256 + (v_ ? qi_ : 0); \
            const unsigned ent_ = ((const unsigned short*)(F.ws + WS_LIST))[e_]; \
            const bf16* qp_ = (const bf16*)(F.ws + WS_QG) + e_ * 64 + 8 * hi; \
            _Pragma("unroll") for (int s_ = 0; s_ < 4; ++s_) (Q_)[s_] = *(const bf16x8*)(qp_ + 16 * s_); \
            (TL_) = ent_ & 255; (O_) = o_; (DST_) = v_ ? (((b * SEQ + o_ * 256 + (int)(ent_ & 255)) * AH + h) * 3 + (int)(ent_ >> 8)) : -1; } while (0)
        if (gamma < rb) PAST_FETCH(gamma, p_dst, p_tl, p_o, pq);
        if (gamma + 8 < rb) PAST_FETCH(gamma + 8, r_dst, r_tl, r_o, rq);
        __syncthreads();
        const LAS float* lut = LUT8(F) + h * 132;
        stage_kv64(F, SEG_AK(F) + (size_t)(b * SEQ + n * 256) * AW + h * AD, SEG_AV(F) + (size_t)(b * SEQ + n * 256) * AW + h * AD, KR, VT);
        __syncthreads();
        const float b31 = lut[128];
        while (gamma < rb) {
            const int dst = p_dst, t_local = p_tl; const bool adj = (p_o == n + 1);
            bf16x8 qf[4] = {pq[0], pq[1], pq[2], pq[3]};
            p_dst = r_dst; p_tl = r_tl; p_o = r_o; pq[0] = rq[0]; pq[1] = rq[1]; pq[2] = rq[2]; pq[3] = rq[3];
            if (gamma + 16 < rb) PAST_FETCH(gamma + 16, r_dst, r_tl, r_o, rq);
            AttnOut R = wave_attend<false>(KR, VT, qf, lane, 8, 256 + t_local, adj, 4, lut, b31);
            if (dst >= 0) {
                if (hi == 0) { float* ps = (float*)(F.ws + WS_PARTS) + (size_t)dst * 2; ps[0] = R.mx; ps[1] = R.l; }
                const float rl = 1.f / R.l;
                bf16* po = (bf16*)(F.ws + WS_PARTO) + (size_t)dst * 64 + 4 * hi;
#pragma unroll
                for (int g = 0; g < 4; ++g) {
                    *(unsigned long long*)(po + 8 * g) = (unsigned long long)pk2(R.o0[4 * g] * rl, R.o0[4 * g + 1] * rl) | ((unsigned long long)pk2(R.o0[4 * g + 2] * rl, R.o0[4 * g + 3] * rl) << 32);
                    *(unsigned long long*)(po + 32 + 8 * g) = (unsigned long long)pk2(R.o1[4 * g] * rl, R.o1[4 * g + 1] * rl) | ((unsigned long long)pk2(R.o1[4 * g + 2] * rl, R.o1[4 * g + 3] * rl) << 32);
                }
            }
            gamma += 8;
        }
#undef PAST_FETCH
        it = run_end_item;
    }
    __syncthreads();
}
struct OwnLoads { bf16x8 qf[4]; float pm[3], pl[3]; unsigned long long pw0[3][4], pw1[3][4]; };
__device__ __forceinline__ void own_group_load(Frame& F, int b, int h, int o, int grp, OwnLoads& L) {
    const int lane = F.lane, tl = lane & 31, hi = lane >> 5;
    const int row = b * SEQ + o * 256 + 32 * grp + tl;
    { const bf16* qp = SEG_AQ(F) + (size_t)row * AW + h * AD + 8 * hi;
#pragma unroll
      for (int s = 0; s < 4; ++s) L.qf[s] = *(const bf16x8*)(qp + 16 * s); }
    const int np = o < 3 ? o : 3;
    const float* ps = (const float*)(F.ws + WS_PARTS) + (size_t)(row * AH + h) * 6;
    const bf16* po = (const bf16*)(F.ws + WS_PARTO) + (size_t)(row * AH + h) * 3 * 64 + 4 * hi;
#pragma unroll
    for (int j = 0; j < 3; ++j) {
        if (j < np) { L.pm[j] = ps[2 * j]; L.pl[j] = ps[2 * j + 1];
#pragma unroll
            for (int g = 0; g < 4; ++g) { L.pw0[j][g] = *(const unsigned long long*)(po + j * 64 + 8 * g); L.pw1[j][g] = *(const unsigned long long*)(po + j * 64 + 32 + 8 * g); } }
        else { L.pm[j] = -INFINITY; L.pl[j] = 0.f;
#pragma unroll
            for (int g = 0; g < 4; ++g) { L.pw0[j][g] = 0ull; L.pw1[j][g] = 0ull; } }
    }
}
__device__ __forceinline__ void own_group_compute(Frame& F, const LAS unsigned char* KR, const LAS unsigned char* VT, const LAS float* lut, int b, int h, int o, int grp, const OwnLoads& L) {
    const int lane = F.lane, tl = lane & 31, hi = lane >> 5;
    const int t_local = 32 * grp + tl, row = b * SEQ + o * 256 + t_local, np = o < 3 ? o : 3;
    AttnOut R = wave_attend<true>(KR, VT, L.qf, lane, grp + 1, t_local, true, 0, lut, 0.f);
    float mt = R.mx;
#pragma unroll
    for (int j = 0; j < 3; ++j) mt = fmaxf(mt, L.pm[j]);
    const float e_own = __expf(R.mx - mt); float aj[3], Ls = e_own * R.l;
#pragma unroll
    for (int j = 0; j < 3; ++j) { aj[j] = (j < np) ? __expf(L.pm[j] - mt) * L.pl[j] : 0.f; Ls += aj[j]; }
    const float rL = 1.f / Ls, a_own = e_own * rL;
#pragma unroll
    for (int j = 0; j < 3; ++j) aj[j] *= rL;
    bf16* mp = F.MIX + (size_t)row * D + h * AD + 4 * hi;
#pragma unroll
    for (int g = 0; g < 4; ++g) {
        float v0[4], v1[4];
#pragma unroll
        for (int i = 0; i < 4; ++i) { v0[i] = R.o0[4 * g + i] * a_own; v1[i] = R.o1[4 * g + i] * a_own; }
#pragma unroll
        for (int j = 0; j < 3; ++j) {
#pragma unroll
            for (int i = 0; i < 4; ++i) { v0[i] += aj[j] * bf2f((unsigned short)(L.pw0[j][g] >> (16 * i))); v1[i] += aj[j] * bf2f((unsigned short)(L.pw1[j][g] >> (16 * i))); }
        }
        *(unsigned long long*)(mp + 8 * g) = (unsigned long long)pk2(v0[0], v0[1]) | ((unsigned long long)pk2(v0[2], v0[3]) << 32);
        *(unsigned long long*)(mp + 32 + 8 * g) = (unsigned long long)pk2(v1[0], v1[1]) | ((unsigned long long)pk2(v1[2], v1[3]) << 32);
    }
}
__device__ __forceinline__ void attn_own_pair(Frame& F, const LAS int* bucket, int ua, int ub) {
    const int bha = ua >> 4, oa = ua & 15, ba = bha >> 3, ha = bha & 7, bhb = ub >> 4, ob = ub & 15, bb = bhb >> 3, hb = bhb & 7;
    LAS unsigned char* KA = F.lds + RING_OFF; LAS unsigned char* VA = KA + 32768; LAS unsigned char* KB = KA + 65536; LAS unsigned char* VB = KA + 98304;
    const LAS float* lutA = LUT8(F) + ha * 132; const LAS float* lutB = LUT8(F) + hb * 132;
    __syncthreads();
    OwnLoads LA; own_group_load(F, ba, ha, oa, F.wave, LA);
    {
        const bf16* ka = SEG_AK(F) + (size_t)(ba * SEQ + oa * 256) * AW + ha * AD; const bf16* va = SEG_AV(F) + (size_t)(ba * SEQ + oa * 256) * AW + ha * AD;
        const bf16* kb = SEG_AK(F) + (size_t)(bb * SEQ + ob * 256) * AW + hb * AD; const bf16* vb = SEG_AV(F) + (size_t)(bb * SEQ + ob * 256) * AW + hb * AD;
        v4u x[16];
#pragma unroll
        for (int i = 0; i < 4; ++i) { const int piece = F.tid + 512 * i, key = piece >> 3, ch = piece & 7; const size_t off = (size_t)key * AW + 8 * ch;
            x[4 * i] = *(const v4u*)(ka + off); x[4 * i + 1] = *(const v4u*)(va + off); x[4 * i + 2] = *(const v4u*)(kb + off); x[4 * i + 3] = *(const v4u*)(vb + off); }
        asm volatile("" : "+v"(x[0]), "+v"(x[1]), "+v"(x[2]), "+v"(x[3]), "+v"(x[4]), "+v"(x[5]), "+v"(x[6]), "+v"(x[7]));
        asm volatile("" : "+v"(x[8]), "+v"(x[9]), "+v"(x[10]), "+v"(x[11]), "+v"(x[12]), "+v"(x[13]), "+v"(x[14]), "+v"(x[15]));
#pragma unroll
        for (int i = 0; i < 4; ++i) { const int piece = F.tid + 512 * i, key = piece >> 3, ch = piece & 7;
            const int ko = ch * (256 * 16) + key * 16, vo = (ch >> 2) * (256 * 64) + key * 64 + (ch & 3) * 16;
            *(LAS v4u*)(KA + ko) = x[4 * i]; *(LAS v4u*)(VA + vo) = x[4 * i + 1]; *(LAS v4u*)(KB + ko) = x[4 * i + 2]; *(LAS v4u*)(VB + vo) = x[4 * i + 3]; }
    }
    __syncthreads();
    OwnLoads LB; own_group_load(F, bb, hb, ob, 7 - F.wave, LB);
    own_group_compute(F, KA, VA, lutA, ba, ha, oa, F.wave, LA);
    own_group_compute(F, KB, VB, lutB, bb, hb, ob, 7 - F.wave, LB);
}
constexpr size_t WS_SELS = 538 * MiB;
constexpr size_t WS_PARTOS = 539 * MiB;
constexpr size_t WS_PARTSS = 540 * MiB;
constexpr size_t WS_KSUMP = 541 * MiB;
constexpr size_t WS_SITEMS = 545 * MiB;
constexpr size_t WS_END4 = 546 * MiB;
constexpr int CW_SITEMS = 8192;
__device__ __forceinline__ void sample_select(Frame& F) {
    LAS unsigned* um = (LAS unsigned*)(F.lds + RING_OFF);
    LAS unsigned* rk = um + 16;
    const int lane = F.lane, n = lane & 31, st = 2 * F.wave + (lane >> 5);
    for (int pr = blockIdx.x; pr < DB * AH; pr += F.G) {
        const int sb = pr >> 3, h = pr & 7;
        __syncthreads();
        if (F.tid == 0) um[0] = 0u;
        if (F.tid < 32) rk[F.tid] = 0u;
        __syncthreads();
        if (F.wave < 4) {
            const int m = MP + sb * DS + st;
            v4u qw[8]; f32x4 ka[16], kb[16];
            { const v4u* qp = (const v4u*)(SEG_AQ(F) + (size_t)m * AW + h * AD);
#pragma unroll
              for (int c = 0; c < 8; ++c) qw[c] = qp[c]; }
            { const f32x4* k0 = (const f32x4*)((const float*)(F.ws + WS_KSUMP) + ((size_t)(sb * NPAGES + 2 * n)) * AW + h * AD); const f32x4* k1 = k0 + AW / 4;
#pragma unroll
              for (int c = 0; c < 16; ++c) { ka[c] = k0[c]; kb[c] = k1[c]; } }
            float s = 0.f;
#pragma unroll
            for (int c = 0; c < 8; ++c) { const unsigned ww[4] = {qw[c].x, qw[c].y, qw[c].z, qw[c].w};
                const f32x4 a0 = ka[2 * c] + kb[2 * c], a1 = ka[2 * c + 1] + kb[2 * c + 1];
                s += __builtin_bit_cast(float, ww[0] << 16) * a0.x + __builtin_bit_cast(float, ww[0] & 0xffff0000u) * a0.y + __builtin_bit_cast(float, ww[1] << 16) * a0.z + __builtin_bit_cast(float, ww[1] & 0xffff0000u) * a0.w
                   + __builtin_bit_cast(float, ww[2] << 16) * a1.x + __builtin_bit_cast(float, ww[2] & 0xffff0000u) * a1.y + __builtin_bit_cast(float, ww[3] << 16) * a1.z + __builtin_bit_cast(float, ww[3] & 0xffff0000u) * a1.w; }
            int sel[3]; unsigned mask = 0u;
#pragma unroll
            for (int j = 0; j < 3; ++j) {
                float v = s; int bn = n;
#pragma unroll
                for (int o = 1; o < 32; o <<= 1) { const float ov = __shfl_xor(v, o); const int on = __shfl_xor(bn, o); if (ov > v || (ov == v && on < bn)) { v = ov; bn = on; } }
                sel[j] = bn; mask |= 1u << bn;
                if (bn == n) s = -INFINITY;
            }
            if (n == 0) { int* so = (int*)(F.ws + WS_SELS) + (size_t)((sb * DS + st) * AH + h) * 3; so[0] = sel[0]; so[1] = sel[1]; so[2] = sel[2];
                __hip_atomic_fetch_or(um, mask, __ATOMIC_RELAXED, __HIP_MEMORY_SCOPE_WORKGROUP);
#pragma unroll
                for (int j = 0; j < 3; ++j) __hip_atomic_fetch_or(rk + sel[j], (unsigned)(j + 1) << (2 * st), __ATOMIC_RELAXED, __HIP_MEMORY_SCOPE_WORKGROUP); }
        }
        __syncthreads();
        if (F.wave == 0) {
            const unsigned mask = um[0];
            unsigned base = 0u;
            if (lane == 0) base = __hip_atomic_fetch_add((unsigned*)(F.ctl + CW_SITEMS), (unsigned)__popc(mask), __ATOMIC_RELAXED, __HIP_MEMORY_SCOPE_AGENT);
            base = __shfl(base, 0);
            if (lane < 32 && ((mask >> lane) & 1u)) ((int*)(F.ws + WS_SITEMS))[base + __popc(mask & ((1u << lane) - 1u))] = (int)((rk[lane] << 16) | (unsigned)((sb << 8) | (h << 5) | lane));
        }
    }
    __syncthreads();
}
struct KvRegs { f32x4 a[11], b[11]; };
__device__ __forceinline__ void load_kv64_paged(Frame& F, int sb, int n, int h, KvRegs& R) {
    const int pg0 = F.page_table[sb * NPAGES + 2 * n], pg1 = F.page_table[sb * NPAGES + 2 * n + 1];
    const int lt = F.tid - 128;
#pragma unroll
    for (int i = 0; i < 11; ++i) {
        const int piece = lt + 384 * i;
        if (i < 10 || piece < 4096) {
            const int idx = piece & 2047, key = idx >> 3, ch = idx & 7;
            const float* base = (piece < 2048) ? F.cache_k : F.cache_v;
            const float* src = base + ((size_t)((key < PAGE) ? pg0 : pg1) * PAGE + (key & (PAGE - 1))) * AW + h * AD + 8 * ch;
            R.a[i] = __builtin_nontemporal_load((const f32x4*)src); R.b[i] = __builtin_nontemporal_load((const f32x4*)(src + 4));
        }
    }
}
__device__ __forceinline__ void store_kv64_tiles(Frame& F, const KvRegs& R, LAS unsigned char* KR, LAS unsigned char* VT) {
    const int lt = F.tid - 128;
#pragma unroll
    for (int i = 0; i < 11; ++i) {
        const int piece = lt + 384 * i;
        if (i < 10 || piece < 4096) {
            const int idx = piece & 2047, key = idx >> 3, ch = idx & 7;
            const f32x4 x0 = R.a[i], x1 = R.b[i];
            v4u w; w.x = pk2(x0.x, x0.y); w.y = pk2(x0.z, x0.w); w.z = pk2(x1.x, x1.y); w.w = pk2(x1.z, x1.w);
            LAS unsigned char* dst = (piece < 2048) ? KR + ch * (256 * 16) + key * 16 : VT + (ch >> 2) * (256 * 64) + key * 64 + (ch & 3) * 16;
            *(LAS v4u*)dst = w;
        }
    }
}
__device__ __forceinline__ void sample_past_items(Frame& F, const LAS int* bucket) {
    LAS float* tab = (LAS float*)(F.lds + ML_TAB_OFF);
    const int lane = F.lane, tl = lane & 31, hi = lane >> 5;
    const int L = (int)__hip_atomic_load((unsigned*)(F.ctl + CW_SITEMS), __ATOMIC_RELAXED, __HIP_MEMORY_SCOPE_AGENT);
    const int* items = (const int*)(F.ws + WS_SITEMS);
    int idx = blockIdx.x, cur = 0;
#define ITEM_AT(k) items[idx + (k) * F.G]
#define HAS(k) (idx + (k) * F.G < L)
#define LOADER_STEP(RX) do { if (HAS(1)) { \
            LAS unsigned char* kb_ = F.lds + RING_OFF + (cur ^ 1) * 65536; store_kv64_tiles(F, RX, kb_, kb_ + 32768); \
            if (HAS(3)) { const int i3_ = ITEM_AT(3); load_kv64_paged(F, (i3_ >> 8) & 31, i3_ & 31, (i3_ >> 5) & 7, RX); } } \
        __syncthreads(); cur ^= 1; idx += F.G; } while (0)
    __syncthreads();
    if (F.wave >= 2) {
        KvRegs RA, RB;
        if (HAS(0)) {
            const int it = ITEM_AT(0);
            load_kv64_paged(F, (it >> 8) & 31, it & 31, (it >> 5) & 7, RA); store_kv64_tiles(F, RA, F.lds + RING_OFF, F.lds + RING_OFF + 32768);
            if (HAS(1)) { const int i1 = ITEM_AT(1); load_kv64_paged(F, (i1 >> 8) & 31, i1 & 31, (i1 >> 5) & 7, RA); }
            if (HAS(2)) { const int i2 = ITEM_AT(2); load_kv64_paged(F, (i2 >> 8) & 31, i2 & 31, (i2 >> 5) & 7, RB); }
        }
        __syncthreads();
        while (idx < L) { LOADER_STEP(RA); if (idx >= L) break; LOADER_STEP(RB); }
    } else {
        int pj = -1, pst = 0; bf16x8 pq[4] = {};
#define SAMPLE_ITEM_QUERY(IT, J, ST, QF) do { const int h_ = ((IT) >> 5) & 7, sb_ = ((IT) >> 8) & 31; const unsigned rk_ = (unsigned)(IT) >> 16; \
        const int j_ = (tl < 8) ? (int)((rk_ >> (2 * tl)) & 3u) - 1 : -1;                         \
        int first_ = 0; _Pragma("unroll") for (int s_ = 7; s_ >= 0; --s_) if ((rk_ >> (2 * s_)) & 3u) first_ = s_; \
        (J) = j_; (ST) = (j_ >= 0) ? tl : first_;                                                  \
        const bf16* qp_ = SEG_AQ(F) + (size_t)(MP + sb_ * DS + (ST)) * AW + h_ * AD + 8 * hi; \
        _Pragma("unroll") for (int s_ = 0; s_ < 4; ++s_) (QF)[s_] = *(const bf16x8*)(qp_ + 16 * s_); } while (0)
        LAS float* hand = tab + ML_WSC;
        volatile LAS int* flag = (volatile LAS int*)(tab + ML_WSC + 1160);
        if (HAS(0)) { const int it = ITEM_AT(0); SAMPLE_ITEM_QUERY(it, pj, pst, pq); }
        if (F.tid == 0) flag[0] = 0;
        __syncthreads();
        int seq = 0;
        for (; idx < L; idx += F.G) {
            const int it = ITEM_AT(0), n = it & 31, h = (it >> 5) & 7, sb = (it >> 8) & 31;
            const LAS unsigned char* KR = F.lds + RING_OFF + cur * 65536; const LAS unsigned char* VT = KR + 32768; const LAS float* lut = LUT8(F) + h * 132;
            const int j = pj, st = pst; const bool valid = j >= 0;
            bf16x8 qf[4] = {pq[0], pq[1], pq[2], pq[3]};
            if (HAS(1)) { const int i1 = ITEM_AT(1); SAMPLE_ITEM_QUERY(i1, pj, pst, pq); }
            ++seq;
            AttnOut O = wave_attend<false>(KR, VT, qf, lane, 4 + 4 * F.wave, 256 + st, n == NBLK_S - 1, 4, lut, lut[128], 4 * F.wave);
            LAS float* hp = hand + (seq & 1) * 576 + ((lane >> 5) * 8 + (tl & 7)) * 36;
            if (F.wave == 1) {
                if (tl < 8) { hp[0] = O.mx; hp[1] = O.l;
#pragma unroll
                    for (int r = 0; r < 16; ++r) { hp[2 + r] = O.o0[r]; hp[18 + r] = O.o1[r]; } }
                asm volatile("s_waitcnt lgkmcnt(0)" ::: "memory");
                if (lane == 0) flag[0] = seq;
            } else {
                while (flag[0] < seq) __builtin_amdgcn_s_sleep(1);
                asm volatile("" ::: "memory");
                if (valid) {
                    const float m1 = hp[0], l1 = hp[1], mt = fmaxf(O.mx, m1), f0 = __expf(O.mx - mt), f1 = __expf(m1 - mt), lt_ = O.l * f0 + l1 * f1;
                    const size_t dst = (size_t)((sb * DS + st) * AH + h) * 3 + j;
                    if (hi == 0) { float* ps = (float*)(F.ws + WS_PARTSS) + dst * 2; ps[0] = mt; ps[1] = lt_; }
                    const float rl = 1.f / lt_, g0 = f0 * rl, g1 = f1 * rl;
                    bf16* po = (bf16*)(F.ws + WS_PARTOS) + dst * 64 + 4 * hi;
#pragma unroll
                    for (int g = 0; g < 4; ++g) {
                        float a[4], b[4];
#pragma unroll
                        for (int i = 0; i < 4; ++i) { a[i] = O.o0[4 * g + i] * g0 + hp[2 + 4 * g + i] * g1; b[i] = O.o1[4 * g + i] * g0 + hp[18 + 4 * g + i] * g1; }
                        *(unsigned long long*)(po + 8 * g) = (unsigned long long)pk2(a[0], a[1]) | ((unsigned long long)pk2(a[2], a[3]) << 32);
                        *(unsigned long long*)(po + 32 + 8 * g) = (unsigned long long)pk2(b[0], b[1]) | ((unsigned long long)pk2(b[2], b[3]) << 32);
                    }
                }
            }
            __syncthreads();
            cur ^= 1;
        }
#undef SAMPLE_ITEM_QUERY
    }
#undef LOADER_STEP
#undef ITEM_AT
#undef HAS
    __syncthreads();
}
__device__ __forceinline__ void sample_own_merge(Frame& F, const LAS int* bucket) {
    const int gw = blockIdx.x * NWAVES + F.wave, NGW = F.G * NWAVES, d = F.lane;
    for (int idx = gw; idx < MS * AH; idx += NGW) {
        const int r = idx >> 3, h = idx & 7, sb = r >> 3, st = r & 7, m = MP + r;
        const float q = bf2f(SEG_AQ(F)[(size_t)m * AW + h * AD + d]);
        float s[8], vv[8];
#pragma unroll
        for (int p = 0; p < 8; ++p) { const size_t off = ((size_t)(MP + sb * DS + p)) * AW + h * AD + d; s[p] = q * bf2f(SEG_AK(F)[off]); vv[p] = bf2f(SEG_AV(F)[off]); }
#pragma unroll
        for (int p = 0; p < 8; ++p) { s[p] = wave_sum(s[p]); s[p] = (p <= st) ? s[p] + LUT8(F)[h * 132 + ((st - p) & 7)] : -INFINITY; }
        float mx = s[0];
#pragma unroll
        for (int p = 1; p < 8; ++p) mx = fmaxf(mx, s[p]);
        float l = 0.f, o = 0.f;
#pragma unroll
        for (int p = 0; p < 8; ++p) { const float pw = __expf(s[p] - mx); l += pw; o += pw * vv[p]; }
        const float* ps = (const float*)(F.ws + WS_PARTSS) + (size_t)idx * 6;
        float mt = mx; float pm[3], pl[3];
#pragma unroll
        for (int j = 0; j < 3; ++j) { pm[j] = ps[2 * j]; pl[j] = ps[2 * j + 1]; mt = fmaxf(mt, pm[j]); }
        const float e_own = __expf(mx - mt); float aj[3], L = e_own * l;
#pragma unroll
        for (int j = 0; j < 3; ++j) { aj[j] = __expf(pm[j] - mt) * pl[j]; L += aj[j]; }
        const float rL = 1.f / L;
        const bf16* po = (const bf16*)(F.ws + WS_PARTOS) + (size_t)idx * 3 * 64 + d;
        F.MIX[(size_t)m * D + h * AD + d] = (bf16)f2bf(rL * (o * e_own + aj[0] * bf2f(po[0]) + aj[1] * bf2f(po[64]) + aj[2] * bf2f(po[128])));
    }
}

template <int BATCH, class Epi>
__device__ __forceinline__ void skinny_gemm(Frame& F, const bf16* A, int lda, const bf16* Wt, int ldw, int ntile, int K, const Epi& E) {
    const int lane = F.lane, r = lane & 31, hi = lane >> 5, kw = K / 8;
    LAS float* red = (LAS float*)(F.lds + RING_OFF);
    for (int u = blockIdx.x; u < 8 * ntile; u += F.G) {
        const int rg = u & 7, ct = u >> 3, k0 = F.wave * kw;
        const bf16* ap = A + (size_t)(32 * rg + r) * lda + k0 + 8 * hi;
        const bf16* bp = Wt + (size_t)(32 * ct + r) * ldw + k0 + 8 * hi;
        f32x16 acc = {};
        for (int s = 0; s < kw / 16; s += BATCH) {
            bf16x8 af[BATCH], bfr[BATCH];
#pragma unroll
            for (int i = 0; i < BATCH; ++i) { af[i] = *(const bf16x8*)(ap + 16 * (s + i)); bfr[i] = *(const bf16x8*)(bp + 16 * (s + i)); }
#pragma unroll
            for (int i = 0; i < BATCH; ++i) acc = mfma32(af[i], bfr[i], acc);
        }
        __syncthreads();
#pragma unroll
        for (int i = 0; i < 16; ++i) red[(F.wave * 16 + i) * 64 + lane] = acc[i];
        __syncthreads();
#pragma unroll
        for (int q = 0; q < 2; ++q) {
            const int e = F.tid + 512 * q; float s = 0.f;
#pragma unroll
            for (int w = 0; w < 8; ++w) s += red[w * 1024 + e];
            const int reg = e >> 6, ln = e & 63;
            E(s, 32 * rg + crow(reg, ln >> 5), 32 * ct + (ln & 31));
        }
    }
    __syncthreads();
}
struct SkResid { const float* xs; float* x1; __device__ __forceinline__ void operator()(float s, int row, int col) const { x1[(size_t)(MP + row) * D + col] = xs[(size_t)row * D + col] + s; } };
struct SkAccum { float* x1; __device__ __forceinline__ void operator()(float s, int row, int col) const { float* p = x1 + (size_t)(MP + row) * D + col; *p = *p + s; } };
struct SkRelu2U { bf16* U; __device__ __forceinline__ void operator()(float s, int row, int col) const { const float a = fmaxf(s, 0.f); U[(size_t)(MP + row) * FF + col] = (bf16)f2bf(a * a); } };

__device__ __forceinline__ void skinny_up4(Frame& F) {
    const int lane = F.lane, r = lane & 31, hi = lane >> 5, kw = D / 8;
    LAS float* red = (LAS float*)(F.lds + RING_OFF);
    const bf16* A = F.XN + (size_t)MP * D;
    for (int u = blockIdx.x; u < 8 * (FF / 128); u += F.G) {
        const int rg = u & 7, c4 = u >> 3, k0 = F.wave * kw;
        const bf16* ap = A + (size_t)(32 * rg + r) * D + k0 + 8 * hi;
        bf16x8 af[8];
#pragma unroll
        for (int i = 0; i < 8; ++i) af[i] = *(const bf16x8*)(ap + 16 * i);
        f32x16 acc[4];
#pragma unroll
        for (int t = 0; t < 4; ++t) {
            const bf16* bp = F.Wup_t + (size_t)(32 * (4 * c4 + t) + r) * D + k0 + 8 * hi;
            bf16x8 bfr[8];
#pragma unroll
            for (int i = 0; i < 8; ++i) bfr[i] = *(const bf16x8*)(bp + 16 * i);
            acc[t] = (f32x16){};
#pragma unroll
            for (int i = 0; i < 8; ++i) acc[t] = mfma32(af[i], bfr[i], acc[t]);
        }
        __syncthreads();
#pragma unroll
        for (int t = 0; t < 4; ++t)
#pragma unroll
            for (int i = 0; i < 16; ++i) red[((t * 8 + F.wave) * 16 + i) * 64 + lane] = acc[t][i];
        __syncthreads();
#pragma unroll
        for (int q = 0; q < 8; ++q) {
            const int e4 = F.tid + 512 * q, t = e4 >> 10, e = e4 & 1023; float s = 0.f;
#pragma unroll
            for (int w = 0; w < 8; ++w) s += red[(t * 8 + w) * 1024 + e];
            const int reg = e >> 6, ln = e & 63; const float a = fmaxf(s, 0.f);
            F.U[(size_t)(MP + 32 * rg + crow(reg, ln >> 5)) * FF + 32 * (4 * c4 + t) + (ln & 31)] = (bf16)f2bf(a * a);
        }
    }
    __syncthreads();
}

__device__ __forceinline__ void sample_ffn_norm(Frame& F) {
    for (int u = blockIdx.x; u < 8 * (FF / 128); u += F.G) {
        const int rg = u & 7;
#pragma unroll
        for (int i = 0; i < 4; ++i) {
            const int r = 32 * rg + 4 * F.wave + i;
            f32x4 v[4]; load_row(F.X1 + (size_t)(MP + r) * D, F.lane, v);
            rms_row_to_bf16<false>(F, v, F.norm_ffn, F.XN + (size_t)(MP + r) * D, MP + r);
        }
    }
    asm volatile("s_waitcnt vmcnt(0)" ::: "memory");
    __syncthreads();
}

#ifndef MK_ONE_LAUNCH
#define MK_ONE_LAUNCH 1
#endif
constexpr int N_PHASES = 11;
struct Args { const void* in[19]; float* out; unsigned char* ws; int ph_lo, ph_hi; };
static_assert(sizeof(Args) == 19 * 8 + 8 + 8 + 8, "Args has no padding bytes");
__global__ void __launch_bounds__(NWAVES * 64, 2) hymba_fwd(Args args) {
    extern __shared__ __attribute__((aligned(16))) unsigned char lds[];
    Frame F;
    F.lds = (LAS unsigned char*)lds;
    F.MISC = (volatile LAS unsigned*)(F.lds + MISC_OFF);
    F.tid = threadIdx.x; F.lane = F.tid & 63; F.wave = __builtin_amdgcn_readfirstlane(F.tid >> 6);
    F.G = gridDim.x; { const int bx = blockIdx.x; F.vcu = (F.G % 8 == 0) ? (bx % 8) * (F.G / 8) + bx / 8 : bx; }
    unsigned char* ws = args.ws; F.ws = ws;
    F.ctl = (gu32*)(ws + WS_CTL);
    F.xp = (const float*)args.in[0]; F.xs = (const float*)args.in[1]; F.cache_k = (const float*)args.in[2]; F.cache_v = (const float*)args.in[3];
    F.state_C = (const float*)args.in[4]; F.state_n = (const float*)args.in[5]; F.state_m = (const float*)args.in[6]; F.page_table = (const int*)args.in[7];
    F.rel_bias = (const float*)args.in[8]; F.norm_mix = (const float*)args.in[9]; F.w_in = (const float*)args.in[10]; F.b_ig = (const float*)args.in[11];
    F.b_fg = (const float*)args.in[12]; F.ml_norm = (const float*)args.in[13]; F.w_out = (const float*)args.in[14]; F.norm_ffn = (const float*)args.in[15];
    F.w_up = (const float*)args.in[16]; F.w_down = (const float*)args.in[17]; F.norm_final = (const float*)args.in[18];
    F.out = args.out;
    F.Win_t = (bf16*)(ws + WS_WIN); F.Wout_t = (bf16*)(ws + WS_WOUT); F.Wup_t = (bf16*)(ws + WS_WUP); F.Wdn_t = (bf16*)(ws + WS_WDN);
    F.XN = (bf16*)(ws + WS_XN); F.SEG = (bf16*)(ws + WS_SEG); F.MIX = (bf16*)(ws + WS_MIX); F.U = (bf16*)(ws + WS_U);
    F.KSUM = (float*)(ws + WS_KSUM); F.KSUMS = (float*)(ws + WS_KSUMP); F.IG = (float*)(ws + WS_GATE); F.LF = (float*)(ws + WS_GATE + 512 * 1024);
    F.H = (float*)(ws + WS_H); F.X1 = (float*)(ws + WS_X1);
    for (int u = F.tid; u < (LDS_BYTES - LDSCTL_OFF) / 4; u += NWAVES * 64) ((LAS unsigned*)(F.lds + LDSCTL_OFF))[u] = 0u;
    __syncthreads();
    LAS int* bucket = (LAS int*)(F.lds + LDSCTL_OFF + 1024);
    if (F.tid < 128) bucket[F.tid] = t5_bucket_small(F.tid);
    __syncthreads();
    { LAS float* l8 = (LAS float*)(F.lds + LUT8_OFF);
      for (int i = F.tid; i < AH * 129; i += NWAVES * 64) { const int h_ = i / 129, d_ = i % 129; l8[h_ * 132 + d_] = F.rel_bias[(d_ < 128 ? bucket[d_] : 31) * AH + h_]; }
    }
    __syncthreads();
    const int lo = args.ph_lo, hi = args.ph_hi;
    XcdBarrier bar; bar.bar = (unsigned*)(F.ctl + CW_BAR); bar.x = 0; bar.st = nullptr;
    if (hi - lo > 1) bar = xcd_barrier_post((unsigned*)(F.ctl + CW_BAR), F.MISC + 8);
#define IN(k) (lo <= (k) && (k) < hi)
#define SEAM(k) do { if (IN(k) && IN((k) + 1)) xcd_barrier(bar); } while (0)

    if (IN(0)) { p0_prologue(F); } SEAM(0);
    if (IN(1)) {
        const int gwg = (F.G > P1_GEMM_WGS) ? P1_GEMM_WGS : F.G;
        if ((int)blockIdx.x < gwg) {
            pg8::Gemm g{F.XN, F.Win_t, M, NPG, D}; pg8::StaticOrder S; S.init(M, NPG, gwg, (int)blockIdx.x); pg8::EpiInProj E{F.SEG, SEG_ELEMS, F.out, F.KSUM};
            pg8::gemm_phase<pg8::EpiInProj, pg8::StaticOrder, true, true>(F.lds + RING_OFF, g, S, E);
        }
        if (F.G > gwg) { if ((int)blockIdx.x >= gwg) { page_sums(F, PS_SPLIT, DB * NPAGES, ((int)blockIdx.x - gwg) * NWAVES + F.wave, (F.G - gwg) * NWAVES); late_transposes(F, ((int)blockIdx.x - gwg) * NWAVES + F.wave, (F.G - gwg) * NWAVES); } }
        else { page_sums(F, PS_SPLIT, DB * NPAGES, F.vcu * NWAVES + F.wave, F.G * NWAVES); late_transposes(F, F.vcu * NWAVES + F.wave, F.G * NWAVES); }
    } SEAM(1);
    if (IN(2)) {
        for (int u = blockIdx.x; u < NSEQ * NCH; u += F.G) mlstm_stepA(F, u);
        for (int u = blockIdx.x; u < 32 * 15; u += 2 * F.G) attn_select2(F, u, (u + F.G < 32 * 15) ? u + F.G : -1);
        sample_select(F);
    } SEAM(2);
    if (IN(3)) {
        for (int u = blockIdx.x; u < NSEQ * 16; u += F.G) mlstm_stepB(F, u);
        attn_past_items(F, bucket);
        sample_past_items(F, bucket);
    } SEAM(3);
    if (IN(4)) {
        for (int u = blockIdx.x; u < NSEQ * NCH; u += F.G) mlstm_stepC(F, u);
        for (int u = blockIdx.x; u < 16 * 16; u += F.G) attn_own_pair(F, bucket, u, u + 256);
        for (int u = blockIdx.x; u < DB * MH; u += F.G) mlstm_sample_full(F, u);
        __syncthreads();
        sample_own_merge(F, bucket);
    }
    if (IN(4) && IN(6)) xcd_barrier(bar);
    if (IN(6)) {
        pg8::Gemm g{F.MIX, F.Wout_t, MP, D, D}; pg8::StaticOrder S; S.init(MP, D, F.G, (int)blockIdx.x); pg8::EpiResid E{F.xp, F.xs, F.X1, F.norm_ffn, F.XN, (float*)(F.ws + WS_SSQ)};
        pg8::gemm_phase<pg8::EpiResid, pg8::StaticOrder, true, true>(F.lds + RING_OFF, g, S, E);
        skinny_gemm<8>(F, F.MIX + (size_t)MP * D, D, F.Wout_t, D, D / 32, D, SkResid{F.xs, F.X1});
    }
    if (IN(6) && IN(8)) xcd_barrier(bar);
    if (IN(8)) {
        pg8::Gemm g{F.XN, F.Wup_t, MP, FF, D}; pg8::StaticOrder S; S.init(MP, FF, F.G, (int)blockIdx.x); pg8::EpiRelu2 E{F.U, (const float*)(F.ws + WS_SSQ)};
        pg8::gemm_phase<pg8::EpiRelu2, pg8::StaticOrder, true, true>(F.lds + RING_OFF, g, S, E);
        sample_ffn_norm(F); skinny_up4(F);
    } SEAM(8);
    if (IN(9)) {
        pg8::Gemm g{F.U, F.Wdn_t, MP, D, FF}; pg8::StaticOrder S; S.init(MP, D, F.G, (int)blockIdx.x);
        pg8::EpiAccum E{F.X1};
        pg8::gemm_phase<pg8::EpiAccum, pg8::StaticOrder, true, true>(F.lds + RING_OFF, g, S, E);
        skinny_gemm<16>(F, F.U + (size_t)MP * FF, FF, F.Wdn_t, FF, D / 32, FF, SkAccum{F.X1});
    } SEAM(9);
    if (IN(10)) { final_norm_rows(F); }
#undef IN
#undef SEAM
}

extern "C" void kernel_launch(void* const* d_in, const int* in_sizes, int n_in, void* d_out, int out_size, void* d_ws, size_t ws_size, hipStream_t stream) {
    static int grid = 0;
    if (grid == 0) {
        if (n_in != 19 || (size_t)out_size != O_END || ws_size < WS_END_SSQ) { fprintf(stderr, "kernel_launch: unexpected shapes (n_in %d out %d ws %zu)\n", n_in, out_size, ws_size); grid = -1; return; }
        int dev = 0, cus = 0, per_cu = 0;
        if (hipGetDevice(&dev) != hipSuccess || hipDeviceGetAttribute(&cus, hipDeviceAttributeMultiprocessorCount, dev) != hipSuccess) { grid = -1; return; }
        if (hipFuncSetAttribute((const void*)hymba_fwd, hipFuncAttributeMaxDynamicSharedMemorySize, LDS_BYTES) != hipSuccess) { fprintf(stderr, "kernel_launch: hipFuncSetAttribute failed\n"); grid = -1; return; }
        if (hipOccupancyMaxActiveBlocksPerMultiprocessor(&per_cu, (const void*)hymba_fwd, NWAVES * 64, LDS_BYTES) != hipSuccess || per_cu < 1)
            fprintf(stderr, "kernel_launch: note: occupancy query reports %d workgroups per CU\n", per_cu);
        (void)hipGetLastError();
        grid = cus;
    }
    if (grid < 0) return;
    if (hipMemsetAsync((char*)d_ws + WS_CTL, 0, CTL_ZERO_BYTES, stream) != hipSuccess) { fprintf(stderr, "kernel_launch: memset failed\n"); return; }
    Args a{};
    for (int i = 0; i < 19; ++i) a.in[i] = d_in[i];
    a.out = (float*)d_out; a.ws = (unsigned char*)d_ws;
#if MK_ONE_LAUNCH
    a.ph_lo = 0; a.ph_hi = N_PHASES;
    hipLaunchKernelGGL(hymba_fwd, dim3(grid), dim3(NWAVES * 64), LDS_BYTES, stream, a);
#else
    for (int p = 0; p < N_PHASES; ++p) {
        a.ph_lo = p; a.ph_hi = p + 1;
        hipLaunchKernelGGL(hymba_fwd, dim3(grid), dim3(NWAVES * 64), LDS_BYTES, stream, a);
    }
#endif
    const hipError_t le = hipPeekAtLastError();
    if (le != hipSuccess) fprintf(stderr, "kernel_launch: launch failed: %s\n", hipGetErrorName(le));
}
```

```cpp
#include <hip/hip_runtime.h>
#include <cstdio>
#include <cstdint>
#include <cmath>
constexpr int D = 1024, SEQ = 4096, NBATCH = 4, MP = NBATCH * SEQ  , DB = 32, DS = 8, MS = DB * DS  , M = MP + MS  ;
constexpr int FF = 4096, NPROJ = 3592, NPG = 3584  ;
constexpr int AH = 8, AD = 64, AW = 512, MH = 4, MD = 128, MW = 512;
constexpr int PAST = 8192, PAGE = 128, NPAGES = PAST / PAGE  , MBLK = 256, NBLK_P = SEQ / MBLK  , NBLK_S = PAST / MBLK  ;
constexpr float RMS_EPS = 1e-6f;
constexpr size_t O_YP = 0, O_YS = 16777216, O_KP = 17039360, O_VP = 25427968, O_CP = 33816576, O_NP = 34078720, O_MP = 34080768,
                 O_KS = 34080784, O_VS = 34211856, O_CS = 34342928, O_NS = 36440080, O_MS = 36456464, O_END = 36456592;
namespace pg8 {
#define PG8_LAS __attribute__((address_space(3)))
typedef unsigned short bf16_t;
typedef short bf16x8 __attribute__((ext_vector_type(8)));
typedef float f32x4 __attribute__((ext_vector_type(4)));
typedef unsigned u32x4 __attribute__((ext_vector_type(4)));
constexpr int BM = 256, BK = 64, HALF = 128, HTB = HALF * BK * 2  , STAGE_BYTES = 8 * HTB, NXCD = 8, WGM = 8;

__host__ __device__ __forceinline__ int lds_byte(int r, int c) { const int st = (r >> 4) * 2 + (c >> 5), rr = r & 15, cc = c & 31, ob = rr * 64 + cc * 2; return st * 1024 + (ob ^ (((ob >> 9) & 1) << 5)); }
__host__ __device__ __forceinline__ void stage_rc(int b, int& R, int& C) { const int st = b / 1024, sb = b % 1024, swz = sb ^ (((sb >> 9) & 1) << 5); R = (st >> 1) * 16 + swz / 64; C = (st & 1) * 32 + (swz % 64) / 2; }
__host__ __device__ __forceinline__ int perm32(int rho) { const int n = rho >> 4, i = rho & 15; return 8 * (i >> 2) + 4 * n + (i & 3); }

struct Unit { int pm, pn; };
struct Gemm { const bf16_t* A; const bf16_t* Bt; int M, N, K; };

struct StaticOrder {
    int nM, nN, nwg, G, c;
    __host__ __device__ void init(int M, int N, int G_, int c_) { nM = M / BM; nN = N / BM; nwg = nM * nN; G = G_; c = c_; }
    __host__ __device__ bool next(int i, Unit& u) const {
        const long L = (long)i * G + c; if (L >= nwg) return false;
        int wgid = (int)L; { const int q = nwg / NXCD, r = nwg % NXCD, xcd = wgid % NXCD, off = wgid / NXCD; wgid = (xcd < r ? xcd * (q + 1) : r * (q + 1) + (xcd - r) * q) + off; }
        const int nig = WGM * nN, gid = wgid / nig, fm = gid * WGM, gsz = (nM - fm) < WGM ? (nM - fm) : WGM;
        u.pm = fm + ((wgid % nig) % gsz); u.pn = (wgid % nig) / gsz; return true;
    }
    __device__ __forceinline__ void a_ready(const Unit&) const {}
    __device__ __forceinline__ void done(const Unit&) const {}
};

__device__ __forceinline__ unsigned cvt_pk_bf16(float lo, float hi) { unsigned r; asm volatile("v_cvt_pk_bf16_f32 %0, %1, %2" : "=v"(r) : "v"(lo), "v"(hi)); return r; }
typedef float f32x2 __attribute__((ext_vector_type(2)));
typedef unsigned u32x4_t __attribute__((ext_vector_type(4)));
__device__ __forceinline__ u32x4_t pack8(f32x4 v0, f32x4 v1) { u32x4_t w; w.x = cvt_pk_bf16(v0[0], v0[1]); w.y = cvt_pk_bf16(v0[2], v0[3]); w.z = cvt_pk_bf16(v1[0], v1[1]); w.w = cvt_pk_bf16(v1[2], v1[3]); return w; }
struct EpiInProj {
    static constexpr bool PERM = true, AFTER_DRAIN = false;
    bf16_t* seg0; size_t seg_stride; float* out; float* ksum;
    __device__ __forceinline__ void operator()(const f32x4 (&acc)[2][2][4][2], const Unit& u, int wr, int wc, int fr, int fq) const {
        const int seg = u.pn >> 1;
        const float sc = (seg == 0) ? 0.125f : ((seg == 4) ? 0.08838834764831845f : 1.0f);
        bf16_t* base = seg0 + (size_t)seg * seg_stride;
        const int cs0 = (u.pn & 1) * 256 + wc * 32 + 8 * fq;
        const int row0 = u.pm * BM + wr * 64 + fr;
        const bool kv = (seg == 1) || (seg == 2);
        const bool prompt = u.pm < (MP / BM);
        float* fo = out + (prompt ? (seg == 1 ? O_KP : O_VP) : (seg == 1 ? O_KS : O_VS));
        const int frow0 = prompt ? row0 : row0 - MP;
        f32x4 cs[2][2];
#pragma unroll
        for (int bj = 0; bj < 2; ++bj)
#pragma unroll
            for (int n = 0; n < 2; ++n) cs[bj][n] = (f32x4){0.f, 0.f, 0.f, 0.f};
#pragma unroll
        for (int ai = 0; ai < 2; ++ai)
#pragma unroll
            for (int m = 0; m < 4; ++m) {
                bf16_t* rowp = base + (size_t)(row0 + ai * HALF + m * 16) * 512 + cs0;
#pragma unroll
                for (int bj = 0; bj < 2; ++bj) {
                    f32x4 v0 = acc[ai][bj][m][0], v1 = acc[ai][bj][m][1];
                    if (kv) { float* fp = fo + (size_t)(frow0 + ai * HALF + m * 16) * 512 + cs0 + bj * HALF; __builtin_nontemporal_store(v0, (f32x4*)fp); __builtin_nontemporal_store(v1, (f32x4*)(fp + 4)); }
                    if (seg == 1) { cs[bj][0] += v0; cs[bj][1] += v1; }
                    v0 = v0 * sc; v1 = v1 * sc;
                    *(u32x4_t*)(rowp + bj * HALF) = pack8(v0, v1);
                }
            }
        if (seg == 1 && prompt) {
#pragma unroll
            for (int bj = 0; bj < 2; ++bj)
#pragma unroll
                for (int n = 0; n < 2; ++n)
#pragma unroll
                    for (int j = 0; j < 4; ++j) {
                        float v = cs[bj][n][j];
                        v += __shfl_xor(v, 1); v += __shfl_xor(v, 2); v += __shfl_xor(v, 4); v += __shfl_xor(v, 8);
                        if (fr == 0) __hip_atomic_fetch_add(ksum + (size_t)u.pm * 512 + cs0 + bj * HALF + n * 4 + j, v, __ATOMIC_RELAXED, __HIP_MEMORY_SCOPE_AGENT);
                    }
        }
    }
};
struct EpiResid {
    static constexpr bool PERM = false, AFTER_DRAIN = false;
    const float* xp; const float* xs; float* x1; const float* gain; bf16_t* xn; float* ssq;
    __device__ __forceinline__ void operator()(const f32x4 (&acc)[2][2][4][2], const Unit& u, int wr, int wc, int fr, int fq) const {
        const int row0 = u.pm * BM + wr * 64 + fr, col0 = u.pn * BM + wc * 32 + 4 * fq;
        const float* src = (u.pm < (MP / BM)) ? xp + (size_t)row0 * D : xs + (size_t)(row0 - MP) * D;
        float* dst = x1 + (size_t)row0 * D; bf16_t* dxn = xn + (size_t)row0 * D;
        f32x4 gv[2][2];
#pragma unroll
        for (int bj = 0; bj < 2; ++bj)
#pragma unroll
            for (int n = 0; n < 2; ++n) gv[bj][n] = *(const f32x4*)(gain + col0 + bj * HALF + n * 16);
#pragma unroll
        for (int ai = 0; ai < 2; ++ai)
#pragma unroll
            for (int m = 0; m < 4; ++m) {
                const size_t off = (size_t)(ai * HALF + m * 16) * D + col0; float sq = 0.f;
#pragma unroll
                for (int bj = 0; bj < 2; ++bj)
#pragma unroll
                    for (int n = 0; n < 2; ++n) { const f32x4 xv = *(const f32x4*)(src + off + bj * HALF + n * 16) + acc[ai][bj][m][n]; *(f32x4*)(dst + off + bj * HALF + n * 16) = xv;
                        sq += (xv[0] * xv[0] + xv[1] * xv[1]) + (xv[2] * xv[2] + xv[3] * xv[3]);
                        const f32x4 y = xv * gv[bj][n]; unsigned long long w = (unsigned long long)cvt_pk_bf16(y[0], y[1]) | ((unsigned long long)cvt_pk_bf16(y[2], y[3]) << 32);
                        *(unsigned long long*)(dxn + off + bj * HALF + n * 16) = w; }
                sq += __shfl_xor(sq, 16); sq += __shfl_xor(sq, 32);
                if (fq == 0) ssq[(size_t)(row0 + ai * HALF + m * 16) * 16 + u.pn * 4 + wc] = sq;
            }
    }
};
struct EpiAccum {
    static constexpr bool PERM = false, AFTER_DRAIN = false;
    float* x1;
    __device__ __forceinline__ void operator()(const f32x4 (&acc)[2][2][4][2], const Unit& u, int wr, int wc, int fr, int fq) const {
        const int row0 = u.pm * BM + wr * 64 + fr, col0 = u.pn * BM + wc * 32 + 4 * fq;
        float* dst = x1 + (size_t)row0 * D;
#pragma unroll
        for (int ai = 0; ai < 2; ++ai)
#pragma unroll
            for (int m = 0; m < 4; ++m) {
                const size_t off = (size_t)(ai * HALF + m * 16) * D + col0;
#pragma unroll
                for (int bj = 0; bj < 2; ++bj)
#pragma unroll
                    for (int n = 0; n < 2; ++n) { float* p = dst + off + bj * HALF + n * 16; const f32x4 xv = *(const f32x4*)p; *(f32x4*)p = xv + acc[ai][bj][m][n]; }
            }
    }
};
struct EpiRelu2 {
    static constexpr bool PERM = true, AFTER_DRAIN = false;
    bf16_t* U; const float* ssq;
    __device__ __forceinline__ void operator()(const f32x4 (&acc)[2][2][4][2], const Unit& u, int wr, int wc, int fr, int fq) const {
        const int row0 = u.pm * BM + wr * 64 + fr, col0 = u.pn * BM + wc * 32 + 8 * fq;
#pragma unroll
        for (int ai = 0; ai < 2; ++ai)
#pragma unroll
            for (int m = 0; m < 4; ++m) {
                const int row = row0 + ai * HALF + m * 16;
                const f32x4* sp = (const f32x4*)(ssq + (size_t)row * 16); const f32x4 s0 = sp[0], s1 = sp[1], s2 = sp[2], s3 = sp[3];
                const float tot = ((s0[0] + s0[1]) + (s0[2] + s0[3])) + ((s1[0] + s1[1]) + (s1[2] + s1[3])) + ((s2[0] + s2[1]) + (s2[2] + s2[3])) + ((s3[0] + s3[1]) + (s3[2] + s3[3]));
                const float r2 = 1.f / (tot * (1.f / D) + RMS_EPS);
                bf16_t* rowp = U + (size_t)row * FF + col0;
#pragma unroll
                for (int bj = 0; bj < 2; ++bj) {
                    f32x4 v0 = acc[ai][bj][m][0], v1 = acc[ai][bj][m][1];
#pragma unroll
                    for (int j = 0; j < 4; ++j) { const float a = fmaxf(v0[j], 0.f), b = fmaxf(v1[j], 0.f); v0[j] = a * a * r2; v1[j] = b * b * r2; }
                    *(u32x4_t*)(rowp + bj * HALF) = pack8(v0, v1);
                }
            }
    }
};

template <class Epi, class Sched, bool ALIGN_EPI = false, bool SP2 = false>
__device__ __forceinline__ void gemm_phase(PG8_LAS unsigned char* lds, const Gemm g, const Sched& S, const Epi& E) {
    const int tid = threadIdx.x, wid = __builtin_amdgcn_readfirstlane(tid >> 6), lane = tid & 63, wr = wid >> 2, wc = wid & 3, fr = lane & 15, fq = lane >> 4;
    const int K = g.K, nt = K / BK;
    unsigned voffA[2], voffB[2];
#pragma unroll
    for (int i = 0; i < 2; ++i) { int R, C; stage_rc(tid * 16 + i * 8192, R, C); const int Rb = Epi::PERM ? ((R & ~31) + perm32(R & 31)) : R;
        voffA[i] = (unsigned)(R * K + C) * 2u; voffB[i] = (unsigned)(Rb * K + C) * 2u; }
    const size_t kstep = (size_t)(BK * 2);
    const size_t hstep = (size_t)HALF * K * 2;
    const size_t tstep = 2 * hstep;
    const unsigned ldsw = (unsigned)wid * 1024u;
    const int aoff = lds_byte(wr * 64 + fr, fq * 8), boff = lds_byte(wc * 32 + fr, fq * 8);
#define PG8_SA(b, h) (((b) * 2 + (h)) * HTB)
#define PG8_SB(b, h) ((4 + (b) * 2 + (h)) * HTB)
#define PG8_STAGE(bufoff, gbase, voff) do { _Pragma("unroll") for (int _i = 0; _i < 2; ++_i) \
        __builtin_amdgcn_global_load_lds((const unsigned*)((const char*)(gbase) + (voff)[_i]), (PG8_LAS unsigned*)(lds + (bufoff) + ldsw + _i * 8192), 16, 0, 0); } while (0)
#define PG8_LDA(dst, b, h) do { _Pragma("unroll") for (int m = 0; m < 4; ++m) _Pragma("unroll") for (int k = 0; k < 2; ++k) dst[m][k] = *(const PG8_LAS bf16x8*)(lds + PG8_SA(b, h) + aoff + m * 2048 + k * 1024); } while (0)
#define PG8_LDB(dst, b, h) do { _Pragma("unroll") for (int n = 0; n < 2; ++n) _Pragma("unroll") for (int k = 0; k < 2; ++k) dst[n][k] = *(const PG8_LAS bf16x8*)(lds + PG8_SB(b, h) + boff + n * 2048 + k * 1024); } while (0)
#define PG8_MMA(ai, bj, At, Bt) do { __builtin_amdgcn_s_setprio(1); _Pragma("unroll") for (int m = 0; m < 4; ++m) _Pragma("unroll") for (int n = 0; n < 2; ++n) _Pragma("unroll") for (int k = 0; k < 2; ++k) \
        acc[ai][bj][m][n] = __builtin_amdgcn_mfma_f32_16x16x32_bf16(Bt[n][k], At[m][k], acc[ai][bj][m][n], 0, 0, 0); __builtin_amdgcn_s_setprio(0); } while (0)
#define PG8_WAIT_V(n) asm volatile("s_waitcnt vmcnt(" #n ")" ::: "memory")
#define PG8_WAIT_L(n) asm volatile("s_waitcnt lgkmcnt(" #n ")" ::: "memory")
#define PG8_BAR __builtin_amdgcn_s_barrier()
#define PG8_SCHED __builtin_amdgcn_sched_barrier(0)
    Unit cur, nxt; int ui = 0;
    if (!S.next(0, cur)) return;
    f32x4 acc[2][2][4][2];
#pragma unroll
    for (int a = 0; a < 2; ++a)
#pragma unroll
        for (int b = 0; b < 2; ++b)
#pragma unroll
            for (int m = 0; m < 4; ++m)
#pragma unroll
                for (int n = 0; n < 2; ++n) acc[a][b][m][n] = (f32x4){0.f, 0.f, 0.f, 0.f};
    bf16x8 At[4][2], B0[2][2], B1[2][2];
    const char* cA = (const char*)g.A + (size_t)cur.pm * tstep; const char* cB = (const char*)g.Bt + (size_t)cur.pn * tstep;
    S.a_ready(cur);
    if constexpr (SP2) {
        PG8_STAGE(PG8_SB(0, 0), cB, voffB); PG8_STAGE(PG8_SB(0, 1), cB + hstep, voffB); PG8_STAGE(PG8_SA(0, 0), cA, voffA); PG8_STAGE(PG8_SA(0, 1), cA + hstep, voffA);
        if (wr == 1) PG8_BAR;
        PG8_WAIT_V(2); PG8_BAR;
        PG8_STAGE(PG8_SB(1, 0), cB + kstep, voffB); PG8_STAGE(PG8_SA(1, 0), cA + kstep, voffA); PG8_STAGE(PG8_SB(1, 1), cB + hstep + kstep, voffB);
        PG8_WAIT_V(6); PG8_BAR;
    } else {
        PG8_STAGE(PG8_SB(0, 0), cB, voffB); PG8_STAGE(PG8_SA(0, 0), cA, voffA); PG8_STAGE(PG8_SB(0, 1), cB + hstep, voffB); PG8_STAGE(PG8_SA(0, 1), cA + hstep, voffA);
        if (wr == 1) PG8_BAR;
        PG8_WAIT_V(4); PG8_BAR;
        PG8_STAGE(PG8_SB(1, 0), cB + kstep, voffB); PG8_STAGE(PG8_SA(1, 0), cA + kstep, voffA); PG8_STAGE(PG8_SB(1, 1), cB + hstep + kstep, voffB);
        PG8_WAIT_V(6); PG8_BAR;
    }
    for (;;) {
        const bool has_next = S.next(ui + 1, nxt);
        const char* nA = has_next ? (const char*)g.A + (size_t)nxt.pm * tstep : cA; const char* nB = has_next ? (const char*)g.Bt + (size_t)nxt.pn * tstep : cB;
        for (int t = 0; t < nt; t += 2) {
            const bool last = (t == nt - 2);
            const char* a1 = cA + (size_t)(t + 1) * kstep;
            const char* a2 = last ? nA : cA + (size_t)(t + 2) * kstep; const char* b2 = last ? nB : cB + (size_t)(t + 2) * kstep;
            const char* a3 = a2 + kstep; const char* b3 = b2 + kstep;
            if (last && has_next) S.a_ready(nxt);
            if constexpr (SP2) {
            PG8_LDB(B0, 0, 0); PG8_LDB(B1, 0, 1); PG8_SCHED; PG8_LDA(At, 0, 0); PG8_STAGE(PG8_SA(1, 1), a1 + hstep, voffA);
            PG8_WAIT_V(8); PG8_WAIT_L(0); PG8_BAR; PG8_MMA(0, 0, At, B0); PG8_MMA(0, 1, At, B1); PG8_BAR; PG8_SCHED;
            PG8_LDA(At, 0, 1); PG8_STAGE(PG8_SB(0, 0), b2, voffB); PG8_STAGE(PG8_SB(0, 1), b2 + hstep, voffB); PG8_STAGE(PG8_SA(0, 0), a2, voffA);
            PG8_WAIT_V(8); PG8_WAIT_L(0); PG8_BAR; PG8_MMA(1, 0, At, B0); PG8_MMA(1, 1, At, B1); PG8_BAR; PG8_SCHED;
            PG8_LDB(B0, 1, 0); PG8_LDB(B1, 1, 1); PG8_SCHED; PG8_LDA(At, 1, 0); PG8_STAGE(PG8_SA(0, 1), a2 + hstep, voffA);
            PG8_WAIT_V(8); PG8_WAIT_L(0); PG8_BAR; PG8_MMA(0, 0, At, B0); PG8_MMA(0, 1, At, B1); PG8_BAR; PG8_SCHED;
            PG8_LDA(At, 1, 1); PG8_STAGE(PG8_SB(1, 0), b3, voffB); PG8_STAGE(PG8_SB(1, 1), b3 + hstep, voffB); PG8_STAGE(PG8_SA(1, 0), a3, voffA);
            PG8_WAIT_V(8); PG8_WAIT_L(0); PG8_BAR; PG8_MMA(1, 0, At, B0); PG8_MMA(1, 1, At, B1); PG8_BAR; PG8_SCHED;
            } else {
            PG8_LDB(B0, 0, 0); PG8_SCHED; PG8_LDA(At, 0, 0); PG8_STAGE(PG8_SA(1, 1), a1 + hstep, voffA);
            PG8_WAIT_L(8); PG8_BAR; PG8_WAIT_L(0); PG8_MMA(0, 0, At, B0); PG8_BAR; PG8_SCHED;
            PG8_LDB(B1, 0, 1); PG8_STAGE(PG8_SB(0, 0), b2, voffB);
            PG8_BAR; PG8_WAIT_L(0); PG8_MMA(0, 1, At, B1); PG8_BAR;
            PG8_LDA(At, 0, 1); PG8_STAGE(PG8_SA(0, 0), a2, voffA);
            PG8_BAR; PG8_WAIT_L(0); PG8_MMA(1, 0, At, B0); PG8_BAR; PG8_SCHED;
            PG8_STAGE(PG8_SB(0, 1), b2 + hstep, voffB);
            PG8_WAIT_V(6); PG8_BAR; PG8_MMA(1, 1, At, B1); PG8_BAR;
            PG8_LDB(B0, 1, 0); PG8_SCHED; PG8_LDA(At, 1, 0); PG8_STAGE(PG8_SA(0, 1), a2 + hstep, voffA);
            PG8_WAIT_L(8); PG8_BAR; PG8_WAIT_L(0); PG8_MMA(0, 0, At, B0); PG8_BAR; PG8_SCHED;
            PG8_LDB(B1, 1, 1); PG8_STAGE(PG8_SB(1, 0), b3, voffB);
            PG8_BAR; PG8_WAIT_L(0); PG8_MMA(0, 1, At, B1); PG8_BAR;
            PG8_LDA(At, 1, 1); PG8_STAGE(PG8_SA(1, 0), a3, voffA);
            PG8_BAR; PG8_WAIT_L(0); PG8_MMA(1, 0, At, B0); PG8_BAR; PG8_SCHED;
            PG8_STAGE(PG8_SB(1, 1), b3 + hstep, voffB);
            PG8_WAIT_V(6); PG8_BAR; PG8_MMA(1, 1, At, B1); PG8_BAR;
            }
        }
        if constexpr (ALIGN_EPI) { if (wr == 0) PG8_BAR; }
        if constexpr (!Epi::AFTER_DRAIN) { E(acc, cur, wr, wc, fr, fq); S.done(cur); }
        if (!has_next) break;
#pragma unroll
        for (int a = 0; a < 2; ++a)
#pragma unroll
            for (int b = 0; b < 2; ++b)
#pragma unroll
                for (int m = 0; m < 4; ++m)
#pragma unroll
                    for (int n = 0; n < 2; ++n) acc[a][b][m][n] = (f32x4){0.f, 0.f, 0.f, 0.f};
        cur = nxt; cA = nA; cB = nB; ++ui;
        if constexpr (ALIGN_EPI) { if (wr == 1) PG8_BAR; }
    }
    PG8_WAIT_V(0);
    if constexpr (!ALIGN_EPI) { if (wr == 0) PG8_BAR; }
    PG8_BAR;
    if constexpr (Epi::AFTER_DRAIN) { E.fused(acc, cur, wr, wc, fr, fq, lds, wid, lane); S.done(cur); }
#undef PG8_SA
#undef PG8_SB
#undef PG8_STAGE
#undef PG8_LDA
#undef PG8_LDB
#undef PG8_MMA
#undef PG8_WAIT_V
#undef PG8_WAIT_L
#undef PG8_BAR
#undef PG8_SCHED
}
}

constexpr int NWAVES = 8;
constexpr size_t MiB = 1u << 20;
constexpr size_t WS_CTL = 0, CTL_ZERO_BYTES = 1 * MiB;
constexpr size_t WS_KSUM = 512 * 1024;
constexpr size_t WS_WIN = 2 * MiB, WS_WOUT = 10 * MiB, WS_WUP = 12 * MiB, WS_WDN = 20 * MiB;
constexpr size_t WS_GATE = 28 * MiB;
constexpr size_t WS_KSUMS = 29 * MiB;
constexpr size_t WS_XN = 32 * MiB;
constexpr size_t WS_SEG = 65 * MiB, SEG_BYTES = 17 * MiB;
constexpr size_t WS_H = 184 * MiB;
constexpr size_t WS_MIX = 217 * MiB;
constexpr size_t WS_X1 = 250 * MiB;
constexpr size_t WS_U = 320 * MiB;
constexpr size_t WS_END = 452 * MiB;
constexpr size_t WS_SSQ = 700 * MiB;
constexpr size_t WS_END_SSQ = 702 * MiB;
constexpr int CW_BAR = 4096;
constexpr int RING_OFF = 0, RING_BYTES = 131072;
constexpr int LDSCTL_OFF = RING_BYTES, MISC_OFF = LDSCTL_OFF + 320;
constexpr int LDS_BYTES = 151552;
constexpr int LUT8_OFF = LDSCTL_OFF + 13568;
#define GAS __attribute__((address_space(1)))
#define LAS __attribute__((address_space(3)))
typedef unsigned short bf16;
typedef unsigned v4u __attribute__((ext_vector_type(4)));
typedef float f32x4 __attribute__((ext_vector_type(4)));
typedef short bf16x8 __attribute__((ext_vector_type(8)));
typedef GAS unsigned gu32;
typedef GAS unsigned long long gu64;
#define RLX_AGENT __ATOMIC_RELAXED, __HIP_MEMORY_SCOPE_AGENT
#define LDS_WAIT() asm volatile("s_waitcnt lgkmcnt(0)" ::: "memory")
#define VM_WAIT() asm volatile("s_waitcnt vmcnt(0)" ::: "memory")
__device__ __forceinline__ unsigned long long rt() { return __builtin_amdgcn_s_memrealtime(); }
__device__ __forceinline__ unsigned pk2(float lo, float hi) { unsigned r; asm("v_cvt_pk_bf16_f32 %0, %1, %2" : "=v"(r) : "v"(lo), "v"(hi)); return r; }
__device__ __forceinline__ unsigned f2bf(float f) { return pk2(f, 0.f) & 0xffffu; }

#define XB_TMO      128
#define XB_XCNT(j)  (256  + 64 * (j))
#define XB_XSUB(j)  (1280 + 64 * (j))
#define XB_XGEN(j)  (2304 + 64 * (j))
#define XB_TOP      3328
#define XB_TOPGEN   3392
#define XCD_BAR_WORDS 3456
#define XB_SPIN_CAP (1u << 18)

__device__ __forceinline__ unsigned xb_ld(unsigned* p)              { return __hip_atomic_load(p, __ATOMIC_RELAXED, __HIP_MEMORY_SCOPE_AGENT); }
__device__ __forceinline__ unsigned xb_add(unsigned* p, unsigned v) { return __hip_atomic_fetch_add(p, v, __ATOMIC_RELAXED, __HIP_MEMORY_SCOPE_AGENT); }
__device__ __forceinline__ unsigned xb_xcc_id() { return (unsigned)__builtin_amdgcn_s_getreg((3 << 11) | 20) & 0xFu; }
#define XB_SPIN(cond, bar) do { unsigned _sp = 0; while (cond) { __builtin_amdgcn_s_sleep(1); \
    if ((++_sp & 255u) == 0u) { if (xb_ld(&(bar)[XB_TMO])) break; if (_sp > XB_SPIN_CAP) { atomicAdd(&(bar)[XB_TMO], 1u); break; } } } } while (0)

struct XcdBarrier {
    unsigned* bar; unsigned x;
    volatile LAS unsigned* st;
};

__device__ __forceinline__ XcdBarrier xcd_barrier_post(unsigned* bar, volatile LAS unsigned* st) {
    XcdBarrier b; b.bar = bar; b.x = xb_xcc_id(); b.st = st;
    if (threadIdx.x == 0) (void)xb_add(&bar[XB_XCNT(b.x)], 1u);
    return b;
}
__device__ __forceinline__ void xcd_barrier_complete(unsigned* bar, unsigned x, unsigned& nloc, unsigned& nx) {
    const unsigned G = gridDim.x * gridDim.y * gridDim.z;
    unsigned sum, cnt, mine, sp = 0u;
    for (;;) {
        sum = 0u; cnt = 0u; mine = 0u;
#pragma unroll
        for (unsigned j = 0; j < 16; ++j) { const unsigned c = xb_ld(&bar[XB_XCNT(j)]); sum += c; cnt += (c > 0u) ? 1u : 0u; mine = (j == x) ? c : mine; }
        if (sum == G) break;
        __builtin_amdgcn_s_sleep(1);
        if ((++sp & 255u) == 0u) { if (xb_ld(&bar[XB_TMO])) break; if (sp > XB_SPIN_CAP) { atomicAdd(&bar[XB_TMO], 1u); break; } }
    }
    nloc = mine > 0u ? mine : 1u; nx = cnt > 0u ? cnt : 1u;
}

__device__ __forceinline__ void xcd_barrier(const XcdBarrier& b) {
    asm volatile("s_waitcnt vmcnt(0)" ::: "memory");
    __syncthreads();
    if (threadIdx.x == 0) {
        unsigned* bar = b.bar;
        __builtin_amdgcn_s_waitcnt(0);
        unsigned nloc = b.st[0], nx = b.st[1];
        if (nloc == 0u) { xcd_barrier_complete(bar, b.x, nloc, nx); b.st[0] = nloc; b.st[1] = nx; }
        const unsigned old = xb_add(&bar[XB_XSUB(b.x)], 1u);
        const unsigned gen = old / nloc;
        if (old + 1u == (gen + 1u) * nloc) {
            __builtin_amdgcn_fence(__ATOMIC_RELEASE, "agent");
            asm volatile("s_waitcnt vmcnt(0)" ::: "memory");
            const unsigned og = xb_add(&bar[XB_TOP], 1u);
            const unsigned tg = og / nx;
            if (og + 1u == (tg + 1u) * nx) xb_add(&bar[XB_TOPGEN], 1u);
            else XB_SPIN(xb_ld(&bar[XB_TOPGEN]) == tg, bar);
            __builtin_amdgcn_fence(__ATOMIC_ACQUIRE, "agent");
            xb_add(&bar[XB_XGEN(b.x)], 1u);
            asm volatile("s_waitcnt vmcnt(0)" ::: "memory");
        } else {
            XB_SPIN(xb_ld(&bar[XB_XGEN(b.x)]) == gen, bar);
            __builtin_amdgcn_fence(__ATOMIC_ACQUIRE, "agent");
            asm volatile("s_waitcnt vmcnt(0)" ::: "memory");
        }
    }
    __syncthreads();
}

struct Frame {
    LAS unsigned char* lds;
    volatile LAS unsigned* MISC;
    gu32* ctl;
    int tid, lane, wave, vcu, G;
    const float *xp, *xs, *cache_k, *cache_v, *state_C, *state_n, *state_m; const int* page_table;
    const float *rel_bias, *norm_mix, *w_in, *b_ig, *b_fg, *ml_norm, *w_out, *norm_ffn, *w_up, *w_down, *norm_final;
    float* out; unsigned char* ws;
    bf16 *Win_t, *Wout_t, *Wup_t, *Wdn_t, *XN, *SEG, *MIX, *U;
    float *KSUM, *KSUMS, *IG, *LF, *H, *X1;
};
constexpr size_t SEG_ELEMS = SEG_BYTES / 2;
#define LUT8(F) ((const LAS float*)((F).lds + LUT8_OFF))
#define SEG_AQ(F) ((F).SEG + 0 * SEG_ELEMS)
#define SEG_AK(F) ((F).SEG + 1 * SEG_ELEMS)
#define SEG_AV(F) ((F).SEG + 2 * SEG_ELEMS)
#define SEG_MQ(F) ((F).SEG + 3 * SEG_ELEMS)
#define SEG_MK(F) ((F).SEG + 4 * SEG_ELEMS)
#define SEG_MV(F) ((F).SEG + 5 * SEG_ELEMS)
#define SEG_MO(F) ((F).SEG + 6 * SEG_ELEMS)

__device__ __forceinline__ float bf2f(unsigned short b) { return __builtin_bit_cast(float, (unsigned)b << 16); }
__device__ __forceinline__ float wave_sum(float v) {
#pragma unroll
    for (int o = 1; o < 64; o <<= 1) v += __shfl_xor(v, o);
    return v;
}
__device__ __forceinline__ void p0_transpose_item(const float* W, int K, int ldw, int N, bf16* WT, LAS float* scr, int item, int lane) {
    const int nblk = N / 32, kb = item / nblk, nb = item % nblk, k0 = 64 * kb, n0 = 32 * nb;
    float wv[32];
#pragma unroll
    for (int i = 0; i < 32; ++i) wv[i] = W[(size_t)(k0 + 2 * i + (lane >> 5)) * ldw + n0 + (lane & 31)];
#pragma unroll
    for (int i = 0; i < 32; i += 8) asm volatile("" : "+v"(wv[i]), "+v"(wv[i + 1]), "+v"(wv[i + 2]), "+v"(wv[i + 3]), "+v"(wv[i + 4]), "+v"(wv[i + 5]), "+v"(wv[i + 6]), "+v"(wv[i + 7]));
#pragma unroll
    for (int i = 0; i < 32; ++i) scr[(2 * i + (lane >> 5)) * 33 + (lane & 31)] = wv[i];
    LDS_WAIT(); asm volatile("" ::: "memory");
    const int c = lane & 7;
#pragma unroll
    for (int j = 0; j < 4; ++j) { const int n = (lane >> 3) + 8 * j; const LAS float* s = scr + (8 * c) * 33 + n;
        v4u o; o.x = pk2(s[0 * 33], s[1 * 33]); o.y = pk2(s[2 * 33], s[3 * 33]); o.z = pk2(s[4 * 33], s[5 * 33]); o.w = pk2(s[6 * 33], s[7 * 33]);
        *(GAS v4u*)(WT + (size_t)(n0 + n) * K + k0 + 8 * c) = o; }
    LDS_WAIT(); asm volatile("" ::: "memory");
}
__device__ __forceinline__ void load_row(const float* xrow, int lane, f32x4 (&v)[4]) {
    const GAS f32x4* xr = (const GAS f32x4*)xrow + lane;
#pragma unroll
    for (int j = 0; j < 4; ++j) v[j] = xr[64 * j];
}
__device__ __forceinline__ void load_row_nt(const float* xrow, int lane, f32x4 (&v)[4]) {
    const GAS f32x4* xr = (const GAS f32x4*)xrow + lane;
#pragma unroll
    for (int j = 0; j < 4; ++j) v[j] = __builtin_nontemporal_load(xr + 64 * j);
}
template <bool GATES>
__device__ __forceinline__ void rms_row_to_bf16(Frame& F, const f32x4 (&vin)[4], const float* gain, bf16* orow, int m) {
    const GAS f32x4* gr = (const GAS f32x4*)gain + F.lane;
    f32x4 v[4]; float s = 0.f;
#pragma unroll
    for (int j = 0; j < 4; ++j) { v[j] = vin[j]; s += (v[j].x * v[j].x + v[j].y * v[j].y) + (v[j].z * v[j].z + v[j].w * v[j].w); }
#pragma unroll
    for (int j = 0; j < 4; ++j) v[j] = v[j] * gr[64 * j];
    float g8[8];
    if (GATES) {
#pragma unroll
        for (int c = 0; c < 8; ++c) g8[c] = 0.f;
#pragma unroll
        for (int j = 0; j < 4; ++j)
#pragma unroll
            for (int i = 0; i < 4; ++i) { const int k = 256 * j + 4 * F.lane + i; const LAS f32x4* wr = (const LAS f32x4*)(F.lds + RING_OFF + 131072 - 32768) + 2 * k; const f32x4 w0 = wr[0], w1 = wr[1]; const float xv = v[j][i];
                g8[0] += xv * w0.x; g8[1] += xv * w0.y; g8[2] += xv * w0.z; g8[3] += xv * w0.w; g8[4] += xv * w1.x; g8[5] += xv * w1.y; g8[6] += xv * w1.z; g8[7] += xv * w1.w; }
    }
    const float rstd = 1.f / sqrtf(wave_sum(s) * (1.f / D) + RMS_EPS);
    GAS unsigned long long* o8 = (GAS unsigned long long*)orow + F.lane;
#pragma unroll
    for (int j = 0; j < 4; ++j) o8[64 * j] = (unsigned long long)pk2(v[j].x * rstd, v[j].y * rstd) | ((unsigned long long)pk2(v[j].z * rstd, v[j].w * rstd) << 32);
    if (GATES) {
#pragma unroll
        for (int c = 0; c < 8; ++c) g8[c] = wave_sum(g8[c]) * rstd;
        if (F.lane < 8) { float z = 0.f;
#pragma unroll
            for (int c = 0; c < 8; ++c) z = (F.lane == c) ? g8[c] : z;
            if (F.lane < 4) { F.IG[(size_t)m * 4 + F.lane] = z + F.b_ig[F.lane]; }
            else { const int h = F.lane - 4; z += F.b_fg[h]; F.LF[(size_t)m * 4 + h] = fminf(z, 0.f) - log1pf(expf(-fabsf(z))); } }
    }
}
__device__ __forceinline__ const float* xrow_of(Frame& F, int m) { return (m < MP) ? F.xp + (size_t)m * D : F.xs + (size_t)(m - MP) * D; }

constexpr int PS_SPLIT = 2048;
constexpr int P1_GEMM_WGS = 228;
__device__ __forceinline__ void page_sums(Frame& F, int u0, int u1, int w, int NW) {
    for (int u = u0 + w; u < u1; u += NW) {
        f32x4 a0 = {0.f, 0.f, 0.f, 0.f}, a1 = {0.f, 0.f, 0.f, 0.f};
        const int page = F.page_table[u];
        const GAS f32x4* base = (const GAS f32x4*)(F.cache_k + (size_t)page * PAGE * AW) + 2 * F.lane;
#pragma unroll 16
        for (int r = 0; r < PAGE; ++r) { a0 += __builtin_nontemporal_load(base + (size_t)r * (AW / 4)); a1 += __builtin_nontemporal_load(base + (size_t)r * (AW / 4) + 1); }
        GAS f32x4* o = (GAS f32x4*)(F.KSUMS + (size_t)u * AW) + 2 * F.lane; o[0] = a0; o[1] = a1;
    }
}
__device__ __forceinline__ void late_transposes(Frame& F, int w, int NW) {
    LAS float* scr = (LAS float*)(F.lds + RING_OFF + F.wave * 16384);
    constexpr int I_O = (D / 64) * (D / 32), I_UP = (D / 64) * (FF / 32), I_DN = (FF / 64) * (D / 32);
    for (int it = w; it < I_O + I_UP + I_DN; it += NW) {
        int r = it;
        if (r < I_O) { p0_transpose_item(F.w_out, D, D, D, F.Wout_t, scr, r, F.lane); continue; } r -= I_O;
        if (r < I_UP) { p0_transpose_item(F.w_up, D, FF, FF, F.Wup_t, scr, r, F.lane); continue; } r -= I_UP;
        p0_transpose_item(F.w_down, FF, D, D, F.Wdn_t, scr, r, F.lane);
    }
}
__device__ __forceinline__ void p0_prologue(Frame& F) {
    LAS float* scr = (LAS float*)(F.lds + RING_OFF + F.wave * 16384);
    const int gw = F.vcu * NWAVES + F.wave, NGW = F.G * NWAVES;
    constexpr int I_IN = (D / 64) * (NPG / 32);
    for (int it = gw; it < I_IN; it += NGW) p0_transpose_item(F.w_in, D, NPROJ, NPG, F.Win_t, scr, it, F.lane);
    __syncthreads();
    for (int i = F.tid; i < D * 2; i += NWAVES * 64) ((LAS f32x4*)(F.lds + RING_OFF + 131072 - 32768))[i] = *(const f32x4*)(F.w_in + (size_t)(i >> 1) * NPROJ + NPG + 4 * (i & 1));
    __syncthreads();
    {
        f32x4 r0[4], r1[4], r2[4];
        if (gw < M) load_row(xrow_of(F, gw), F.lane, r0);
        { const int m1 = (gw + NGW < M) ? gw + NGW : gw; load_row(xrow_of(F, m1 < M ? m1 : 0), F.lane, r1); }
        for (int m = gw; m < M; m += NGW) {
            const int m2 = (m + 2 * NGW < M) ? m + 2 * NGW : m; load_row(xrow_of(F, m2), F.lane, r2);
            rms_row_to_bf16<true>(F, r0, F.norm_mix, F.XN + (size_t)m * D, m);
#pragma unroll
            for (int j = 0; j < 4; ++j) { r0[j] = r1[j]; r1[j] = r2[j]; }
        }
    }
    page_sums(F, 0, PS_SPLIT, gw, NGW);
}

__device__ __forceinline__ int t5_bucket_small(int n) {
    if (n < 16) return n;
    int b = 16 + (int)(logf((float)n * (1.0f / 16.0f)) / 2.0794415416798357f * 16.0f);
    return b < 31 ? b : 31;
}

__device__ __forceinline__ void final_norm_rows(Frame& F) {
    const int gw = F.vcu * NWAVES + F.wave, NGW = F.G * NWAVES;
    f32x4 cur[4], nxt[4], nx2[4];
    if (gw < M) load_row_nt(F.X1 + (size_t)gw * D, F.lane, cur);
    { const int m1 = (gw + NGW < M) ? gw + NGW : (gw < M ? gw : 0); load_row_nt(F.X1 + (size_t)m1 * D, F.lane, nxt); }
    for (int m = gw; m < M; m += NGW) {
        const int m2 = (m + 2 * NGW < M) ? m + 2 * NGW : m; load_row_nt(F.X1 + (size_t)m2 * D, F.lane, nx2);
        const f32x4* gr = (const f32x4*)F.norm_final + F.lane;
        float s = 0.f;
#pragma unroll
        for (int j = 0; j < 4; ++j) s += (cur[j].x * cur[j].x + cur[j].y * cur[j].y) + (cur[j].z * cur[j].z + cur[j].w * cur[j].w);
        const float rstd = 1.f / sqrtf(wave_sum(s) * (1.f / D) + RMS_EPS);
        f32x4* o = (f32x4*)(F.out + ((m < MP) ? O_YP + (size_t)m * D : O_YS + (size_t)(m - MP) * D)) + F.lane;
#pragma unroll
        for (int j = 0; j < 4; ++j) __builtin_nontemporal_store(cur[j] * rstd * gr[64 * j], o + 64 * j);
#pragma unroll
        for (int j = 0; j < 4; ++j) { cur[j] = nxt[j]; nxt[j] = nx2[j]; }
    }
}

typedef float f32x16 __attribute__((ext_vector_type(16)));
typedef short s16x4 __attribute__((ext_vector_type(4)));
typedef short v4i16_t __attribute__((ext_vector_type(4)));
__device__ __forceinline__ f32x16 mfma32(bf16x8 a, bf16x8 b, f32x16 c) { return __builtin_amdgcn_mfma_f32_32x32x16_bf16(a, b, c, 0, 0, 0); }
__device__ __forceinline__ int crow(int r, int hi) { return (r & 3) + 8 * (r >> 2) + 4 * hi; }
__device__ __forceinline__ s16x4 vtr(const LAS unsigned char* p) { return __builtin_bit_cast(s16x4, __builtin_amdgcn_ds_read_tr16_b64_v4i16((LAS v4i16_t*)p)); }
__device__ __forceinline__ bf16x8 tfrag(const LAS unsigned char* tile, int T, int s, int ct, int lane) {
    const int i = lane & 15, hi = lane >> 5;
    const LAS unsigned char* p = tile + ct * (T * 64) + (16 * s + 4 * hi + (i >> 2)) * 64 + ((lane >> 4) & 1) * 32 + (i & 3) * 8;
    const s16x4 lo = vtr(p), hh = vtr(p + 512);
    return (bf16x8){lo[0], lo[1], lo[2], lo[3], hh[0], hh[1], hh[2], hh[3]};
}
__device__ __forceinline__ bf16x8 rfrag(const LAS unsigned char* tile, int T, int rt, int s, int lane) {
    return *(const LAS bf16x8*)(tile + (2 * s + (lane >> 5)) * (T * 16) + (32 * rt + (lane & 31)) * 16);
}
__device__ __forceinline__ float half_swap_add(float v) { return v + __shfl_xor(v, 32); }

constexpr int MLC = 256, NCH = SEQ / MLC  , NSEQ = NBATCH * MH  ;
constexpr size_t WS_DCT = 452 * MiB;
constexpr size_t WS_CT = 468 * MiB;
constexpr size_t WS_MLS = 476 * MiB;
constexpr size_t MLS_DN = 0, MLS_NC = 32768, MLS_SC = 65536, MLS_MC = 66048;
constexpr size_t WS_END2 = 477 * MiB;
constexpr int ML_TAB_OFF = LDSCTL_OFF + 2048;
constexpr int ML_MISC = 1280, ML_WSC = 1296;

__device__ __forceinline__ void ml_scalars(Frame& F, int row0, int h, float m0, LAS float* tab) {
    if (F.wave == 0) {
        const int l = F.lane; float lf[4], ig[4], b[4], u[4], pm[4];
#pragma unroll
        for (int i = 0; i < 4; ++i) { lf[i] = F.LF[(size_t)(row0 + 4 * l + i) * 4 + h]; ig[i] = F.IG[(size_t)(row0 + 4 * l + i) * 4 + h]; }
        b[0] = lf[0]; b[1] = b[0] + lf[1]; b[2] = b[1] + lf[2]; b[3] = b[2] + lf[3];
        float x = b[3];
#pragma unroll
        for (int o = 1; o < 64; o <<= 1) { const float y = __shfl_up(x, o); if (l >= o) x += y; }
        const float excl = x - b[3];
#pragma unroll
        for (int i = 0; i < 4; ++i) { b[i] += excl; u[i] = ig[i] - b[i]; }
        pm[0] = u[0]; pm[1] = fmaxf(pm[0], u[1]); pm[2] = fmaxf(pm[1], u[2]); pm[3] = fmaxf(pm[2], u[3]);
        float xm = pm[3];
#pragma unroll
        for (int o = 1; o < 64; o <<= 1) { const float y = __shfl_up(xm, o); if (l >= o) xm = fmaxf(xm, y); }
        float em = __shfl_up(xm, 1); if (l == 0) em = -INFINITY;
        em = fmaxf(em, m0);
#pragma unroll
        for (int i = 0; i < 4; ++i) { tab[4 * l + i] = b[i]; tab[256 + 4 * l + i] = u[i]; tab[512 + 4 * l + i] = fmaxf(em, pm[i]); }
        if (l == 63) { tab[ML_MISC] = xm; tab[ML_MISC + 1] = b[3]; }
    }
}
template <bool SCALE>
__device__ __forceinline__ void stage_T128(Frame& F, const bf16* src, LAS unsigned char* tile, const LAS float* utab, float Mloc) {
    v4u w[8];
#pragma unroll
    for (int i = 0; i < 8; ++i) { const int piece = F.tid + 512 * i, token = piece >> 4, ch = piece & 15; w[i] = *(const v4u*)(src + (size_t)token * 512 + 8 * ch); }
    asm volatile("" : "+v"(w[0]), "+v"(w[1]), "+v"(w[2]), "+v"(w[3]), "+v"(w[4]), "+v"(w[5]), "+v"(w[6]), "+v"(w[7]));
#pragma unroll
    for (int i = 0; i < 8; ++i) {
        const int piece = F.tid + 512 * i, token = piece >> 4, ch = piece & 15;
        v4u x = w[i];
        if (SCALE) { const float g = __expf(utab[token] - Mloc); unsigned ww[4] = {x.x, x.y, x.z, x.w};
#pragma unroll
            for (int k = 0; k < 4; ++k) ww[k] = pk2(__builtin_bit_cast(float, ww[k] << 16) * g, __builtin_bit_cast(float, ww[k] & 0xffff0000u) * g);
            x.x = ww[0]; x.y = ww[1]; x.z = ww[2]; x.w = ww[3]; }
        *(LAS v4u*)(tile + (ch >> 2) * (MLC * 64) + token * 64 + (ch & 3) * 16) = x;
    }
}
__device__ __forceinline__ void stage_R128(Frame& F, const bf16* src, LAS unsigned char* tile) {
    v4u w[8];
#pragma unroll
    for (int i = 0; i < 8; ++i) { const int piece = F.tid + 512 * i, token = piece >> 4, ch = piece & 15; w[i] = *(const v4u*)(src + (size_t)token * 512 + 8 * ch); }
    asm volatile("" : "+v"(w[0]), "+v"(w[1]), "+v"(w[2]), "+v"(w[3]), "+v"(w[4]), "+v"(w[5]), "+v"(w[6]), "+v"(w[7]));
#pragma unroll
    for (int i = 0; i < 8; ++i) { const int piece = F.tid + 512 * i, token = piece >> 4, ch = piece & 15; *(LAS v4u*)(tile + ch * (MLC * 16) + token * 16) = w[i]; }
}
__device__ __forceinline__ void mlstm_stepA(Frame& F, int unit) {
    const int seq = unit >> 4, c = unit & 15, b = seq >> 2, h = seq & 3, row0 = b * SEQ + c * MLC;
    LAS float* tab = (LAS float*)(F.lds + ML_TAB_OFF);
    LAS unsigned char* KT = F.lds + RING_OFF; LAS unsigned char* VT = F.lds + RING_OFF + 65536;
    float* mls = (float*)((unsigned char*)F.ws + WS_MLS);
    v4u kw[8], vw[8];
    { const bf16* ksrc = SEG_MK(F) + (size_t)row0 * MW + h * MD; const bf16* vsrc = SEG_MV(F) + (size_t)row0 * MW + h * MD;
#pragma unroll
      for (int i = 0; i < 8; ++i) { const int piece = F.tid + 512 * i, token = piece >> 4, ch = piece & 15; kw[i] = *(const v4u*)(ksrc + (size_t)token * 512 + 8 * ch); vw[i] = *(const v4u*)(vsrc + (size_t)token * 512 + 8 * ch); } }
    ml_scalars(F, row0, h, -INFINITY, tab);
    asm volatile("" : "+v"(kw[0]), "+v"(kw[1]), "+v"(kw[2]), "+v"(kw[3]), "+v"(kw[4]), "+v"(kw[5]), "+v"(kw[6]), "+v"(kw[7]));
    asm volatile("" : "+v"(vw[0]), "+v"(vw[1]), "+v"(vw[2]), "+v"(vw[3]), "+v"(vw[4]), "+v"(vw[5]), "+v"(vw[6]), "+v"(vw[7]));
    __syncthreads();
    const float Mloc = tab[ML_MISC];
#pragma unroll
    for (int i = 0; i < 8; ++i) {
        const int piece = F.tid + 512 * i, token = piece >> 4, ch = piece & 15;
        const float g = __expf(tab[256 + token] - Mloc); unsigned ww[4] = {kw[i].x, kw[i].y, kw[i].z, kw[i].w};
#pragma unroll
        for (int k = 0; k < 4; ++k) ww[k] = pk2(__builtin_bit_cast(float, ww[k] << 16) * g, __builtin_bit_cast(float, ww[k] & 0xffff0000u) * g);
        v4u x; x.x = ww[0]; x.y = ww[1]; x.z = ww[2]; x.w = ww[3];
        const int off = (ch >> 2) * (MLC * 64) + token * 64 + (ch & 3) * 16;
        *(LAS v4u*)(KT + off) = x; *(LAS v4u*)(VT + off) = vw[i];
    }
    __syncthreads();
    const int et = F.wave >> 1, dt0 = 2 * (F.wave & 1);
    f32x16 acc0 = {}, acc1 = {};
#pragma unroll 4
    for (int s = 0; s < 16; ++s) {
        const bf16x8 a = tfrag(VT, MLC, s, et, F.lane), b0 = tfrag(KT, MLC, s, dt0, F.lane), b1 = tfrag(KT, MLC, s, dt0 + 1, F.lane);
        acc0 = mfma32(a, b0, acc0); acc1 = mfma32(a, b1, acc1);
    }
    float* dct = (float*)((unsigned char*)F.ws + WS_DCT) + ((size_t)(seq * NCH + c)) * MD * MD;
    const int hi = F.lane >> 5, cl = F.lane & 31;
#pragma unroll
    for (int r = 0; r < 16; ++r) { const int e = 32 * et + crow(r, hi); dct[(size_t)e * MD + 32 * dt0 + cl] = acc0[r]; dct[(size_t)e * MD + 32 * (dt0 + 1) + cl] = acc1[r]; }
    { const int d = F.tid & 127, qd = F.tid >> 7; float s = 0.f;
      const LAS unsigned short* kp = (const LAS unsigned short*)(KT + (d >> 5) * (MLC * 64) + (d & 31) * 2);
#pragma unroll 8
      for (int j = 0; j < 64; ++j) s += bf2f(kp[(size_t)(64 * qd + j) * 32]);
      tab[768 + F.tid] = s; }
    __syncthreads();
    if (F.tid < 128) mls[MLS_DN + (size_t)(seq * NCH + c) * MD + F.tid] = (tab[768 + F.tid] + tab[768 + 128 + F.tid]) + (tab[768 + 256 + F.tid] + tab[768 + 384 + F.tid]);
    if (F.tid == 0) { mls[MLS_SC + (seq * NCH + c) * 2] = Mloc; mls[MLS_SC + (seq * NCH + c) * 2 + 1] = tab[ML_MISC + 1]; }
    __syncthreads();
}
__device__ __forceinline__ void mlstm_stepB(Frame& F, int unit) {
    const int seq = unit >> 4, sl = unit & 15, d = F.tid & 127, el = F.tid >> 7, e0 = 8 * sl + el, e1 = e0 + 4;
    float* mls = (float*)((unsigned char*)F.ws + WS_MLS);
    const float* dctb = (const float*)((unsigned char*)F.ws + WS_DCT) + (size_t)seq * NCH * MD * MD;
    bf16* ctb = (bf16*)((unsigned char*)F.ws + WS_CT) + (size_t)seq * NCH * MD * MD;
    float x0[NCH], x1[NCH], dn[NCH];
#pragma unroll
    for (int c = 0; c < NCH; ++c) { x0[c] = dctb[(size_t)c * MD * MD + (size_t)e0 * MD + d]; x1[c] = dctb[(size_t)c * MD * MD + (size_t)e1 * MD + d]; dn[c] = mls[MLS_DN + (size_t)(seq * NCH + c) * MD + d]; }
    float C0 = 0.f, C1 = 0.f, nv = 0.f, m = 0.f;
    const bool nwriter = (sl == 0) && (el == 0);
#pragma unroll
    for (int c = 0; c < NCH; ++c) {
        ctb[(size_t)c * MD * MD + (size_t)e0 * MD + d] = (bf16)f2bf(C0); ctb[(size_t)c * MD * MD + (size_t)e1 * MD + d] = (bf16)f2bf(C1);
        if (nwriter) { mls[MLS_NC + (size_t)(seq * NCH + c) * MD + d] = nv; if (d == 0) mls[MLS_MC + seq * NCH + c] = m; }
        const float Mloc = mls[MLS_SC + (seq * NCH + c) * 2], bL = mls[MLS_SC + (seq * NCH + c) * 2 + 1];
        const float Mt = fmaxf(m, Mloc), fa = __expf(m - Mt), fb = __expf(Mloc - Mt);
        C0 = fa * C0 + fb * x0[c]; C1 = fa * C1 + fb * x1[c]; nv = fa * nv + fb * dn[c];
        m = bL + Mt;
    }
    F.out[O_CP + (size_t)seq * MD * MD + (size_t)d * MD + e0] = C0; F.out[O_CP + (size_t)seq * MD * MD + (size_t)d * MD + e1] = C1;
    if (nwriter) { F.out[O_NP + (size_t)seq * MD + d] = nv; if (d == 0) F.out[O_MP + seq] = m; }
}
__device__ __forceinline__ void mlstm_stepC(Frame& F, int unit) {
    const int seq = unit >> 4, c = unit & 15, b = seq >> 2, h = seq & 3, row0 = b * SEQ + c * MLC;
    LAS float* tab = (LAS float*)(F.lds + ML_TAB_OFF);
    LAS unsigned char* KR = F.lds + RING_OFF; LAS unsigned char* VT = F.lds + RING_OFF + 65536;
    const float* mls = (const float*)((unsigned char*)F.ws + WS_MLS);
    const float m0 = mls[MLS_MC + seq * NCH + c];
    v4u kw[8], vw[8];
    { const bf16* ksrc = SEG_MK(F) + (size_t)row0 * MW + h * MD; const bf16* vsrc = SEG_MV(F) + (size_t)row0 * MW + h * MD;
#pragma unroll
      for (int i = 0; i < 8; ++i) { const int piece = F.tid + 512 * i, token = piece >> 4, ch = piece & 15; kw[i] = *(const v4u*)(ksrc + (size_t)token * 512 + 8 * ch); vw[i] = *(const v4u*)(vsrc + (size_t)token * 512 + 8 * ch); } }
    ml_scalars(F, row0, h, m0, tab);
    if (F.tid < 128) tab[768 + F.tid] = mls[MLS_NC + (size_t)(seq * NCH + c) * MD + F.tid];
    asm volatile("" : "+v"(kw[0]), "+v"(kw[1]), "+v"(kw[2]), "+v"(kw[3]), "+v"(kw[4]), "+v"(kw[5]), "+v"(kw[6]), "+v"(kw[7]));
    asm volatile("" : "+v"(vw[0]), "+v"(vw[1]), "+v"(vw[2]), "+v"(vw[3]), "+v"(vw[4]), "+v"(vw[5]), "+v"(vw[6]), "+v"(vw[7]));
#pragma unroll
    for (int i = 0; i < 8; ++i) { const int piece = F.tid + 512 * i, token = piece >> 4, ch = piece & 15;
        *(LAS v4u*)(KR + ch * (MLC * 16) + token * 16) = kw[i];
        *(LAS v4u*)(VT + (ch >> 2) * (MLC * 64) + token * 64 + (ch & 3) * 16) = vw[i]; }
    __syncthreads();
    const int w = F.wave, lane = F.lane, tl = lane & 31, hi = lane >> 5, t0 = 32 * w, t = t0 + tl;
    bf16x8 qf[8];
    { const bf16* qp = SEG_MQ(F) + (size_t)(row0 + t) * MW + h * MD + 8 * hi;
#pragma unroll
      for (int s = 0; s < 8; ++s) qf[s] = *(const bf16x8*)(qp + 16 * s); }
    float qn = 0.f;
#pragma unroll
    for (int s = 0; s < 8; ++s)
#pragma unroll
        for (int i = 0; i < 8; ++i) qn += bf2f((unsigned short)qf[s][i]) * tab[768 + 16 * s + 8 * hi + i];
    qn = half_swap_add(qn);
    const float Mt = tab[512 + t], wt = __expf(m0 - Mt);
    f32x16 acc[4];
    const bf16* ct = (const bf16*)((unsigned char*)F.ws + WS_CT) + (size_t)(seq * NCH + c) * MD * MD;
#pragma unroll
    for (int et = 0; et < 4; ++et) { acc[et] = (f32x16){};
#pragma unroll
        for (int s = 0; s < 8; ++s) { const bf16x8 cf = *(const bf16x8*)(ct + (size_t)(32 * et + tl) * MD + 16 * s + 8 * hi); acc[et] = mfma32(qf[s], cf, acc[et]); } }
    LAS float* wsc = tab + ML_WSC + 64 * w;
    if (hi == 0) wsc[tl] = wt;
    asm volatile("s_waitcnt lgkmcnt(0)" ::: "memory");
#pragma unroll
    for (int r = 0; r < 16; ++r) { const float ws_ = wsc[crow(r, hi)];
#pragma unroll
        for (int et = 0; et < 4; ++et) acc[et][r] *= ws_; }
    float rs = 0.f;
    for (int jt = 0; jt <= w; ++jt) {
        f32x16 st = {};
#pragma unroll
        for (int s = 0; s < 8; ++s) st = mfma32(rfrag(KR, MLC, jt, s, lane), qf[s], st);
#pragma unroll
        for (int r = 0; r < 16; ++r) { const int j = 32 * jt + crow(r, hi); const float v = st[r] * __expf(tab[256 + j] - Mt); st[r] = (j <= t) ? v : 0.f; rs += st[r]; }
        bf16x8 pa0, pa1;
#pragma unroll
        for (int i = 0; i < 4; ++i) { const unsigned p0 = pk2(st[2 * i], st[2 * i + 1]), p1 = pk2(st[8 + 2 * i], st[8 + 2 * i + 1]);
            pa0[2 * i] = (short)(p0 & 0xffff); pa0[2 * i + 1] = (short)(p0 >> 16); pa1[2 * i] = (short)(p1 & 0xffff); pa1[2 * i + 1] = (short)(p1 >> 16); }
#pragma unroll
        for (int et = 0; et < 4; ++et) { acc[et] = mfma32(pa0, tfrag(VT, MLC, 2 * jt, et, lane), acc[et]); acc[et] = mfma32(pa1, tfrag(VT, MLC, 2 * jt + 1, et, lane), acc[et]); }
    }
    rs = half_swap_add(rs);
    const float den = wt * qn + rs, mt = tab[t] + Mt, sc = 1.f / fmaxf(fabsf(den), __expf(-mt));
    asm volatile("s_waitcnt lgkmcnt(0)" ::: "memory");
    if (hi == 0) wsc[32 + tl] = sc;
    asm volatile("s_waitcnt lgkmcnt(0)" ::: "memory");
    __syncthreads();
    LAS float* hl = (LAS float*)(F.lds + RING_OFF) + w * 4096;
#pragma unroll
    for (int r = 0; r < 16; ++r) { const int tr = crow(r, hi); const float s_ = wsc[32 + tr];
#pragma unroll
        for (int et = 0; et < 4; ++et) hl[tr * 128 + 32 * et + tl] = acc[et][r] * s_; }
    asm volatile("s_waitcnt lgkmcnt(0)" ::: "memory");
    {
        const float g0 = F.ml_norm[h * MD + 2 * lane], g1 = F.ml_norm[h * MD + 2 * lane + 1];
#pragma unroll
        for (int hb = 0; hb < 2; ++hb) {
            unsigned mo[16];
#pragma unroll
            for (int i = 0; i < 16; ++i) mo[i] = *(const unsigned*)(SEG_MO(F) + (size_t)(row0 + 32 * w + 16 * hb + i) * MW + h * MD + 2 * lane);
#pragma unroll
            for (int i = 0; i < 16; ++i) { const size_t row = (size_t)(row0 + 32 * w + 16 * hb + i);
                typedef float f32x2_l __attribute__((ext_vector_type(2))); const f32x2_l hv = *(const LAS f32x2_l*)(hl + (16 * hb + i) * 128 + 2 * lane);
                const float rstd = 1.f / sqrtf(wave_sum(hv.x * hv.x + hv.y * hv.y) * (1.f / MD) + RMS_EPS);
                const float z0 = __builtin_bit_cast(float, mo[i] << 16), z1 = __builtin_bit_cast(float, mo[i] & 0xffff0000u);
                *(unsigned*)(F.MIX + row * D + AW + h * MD + 2 * lane) = pk2(hv.x * rstd * g0 / (1.f + __expf(-z0)), hv.y * rstd * g1 / (1.f + __expf(-z1))); }
        }
    }
    __syncthreads();
}

__device__ __forceinline__ void mlstm_sample_full(Frame& F, int seq) {
    const int sb = seq >> 2, h = seq & 3, e = F.tid & 127, dq = F.tid >> 7, row0 = MP + sb * DS;
    LAS float* red = (LAS float*)(F.lds + RING_OFF);
    float C[32], nn[32];
    const float* C0 = F.state_C + (size_t)seq * MD * MD;
#pragma unroll
    for (int i = 0; i < 32; ++i) { C[i] = C0[(size_t)(32 * dq + i) * MD + e]; nn[i] = F.state_n[(size_t)seq * MD + 32 * dq + i]; }
    float mm = F.state_m[seq];
    LAS unsigned* inb = (LAS unsigned*)(red + 2048);
    LAS float* gts = red + 2048 + 1536;
    __syncthreads();
    for (int i = F.tid; i < DS * 3 * 64; i += NWAVES * 64) { const int t = i / 192, r = i % 192, which = r >> 6, wd = r & 63;
        inb[i] = *((const unsigned*)(F.SEG + (size_t)(3 + which) * SEG_ELEMS + (size_t)(row0 + t) * MW + h * MD) + wd); }
    if (F.tid < DS * 2) { const int t = F.tid >> 1; gts[F.tid] = (F.tid & 1) ? F.LF[(size_t)(row0 + t) * 4 + h] : F.IG[(size_t)(row0 + t) * 4 + h]; }
    __syncthreads();
    for (int t = 0; t < DS; ++t) {
        const LAS v4u* qp = (const LAS v4u*)(inb + t * 192) + 4 * dq; const LAS v4u* kp = (const LAS v4u*)(inb + t * 192 + 64) + 4 * dq;
        const unsigned vw = inb[t * 192 + 128 + (e >> 1)]; const float v = __builtin_bit_cast(float, (e & 1) ? (vw & 0xffff0000u) : (vw << 16));
        const float ig = gts[2 * t], lf = gts[2 * t + 1];
        const float mn = fmaxf(lf + mm, ig), fs = __expf(lf + mm - mn), is = __expf(ig - mn);
        float num = 0.f, den = 0.f;
#pragma unroll
        for (int c = 0; c < 4; ++c) { const v4u qw = qp[c], kw = kp[c]; const unsigned qq[4] = {qw.x, qw.y, qw.z, qw.w}, kk[4] = {kw.x, kw.y, kw.z, kw.w};
#pragma unroll
            for (int j = 0; j < 8; ++j) { const int i = 8 * c + j;
                const float qv = __builtin_bit_cast(float, (j & 1) ? (qq[j >> 1] & 0xffff0000u) : (qq[j >> 1] << 16)), kv = __builtin_bit_cast(float, (j & 1) ? (kk[j >> 1] & 0xffff0000u) : (kk[j >> 1] << 16));
                C[i] = fs * C[i] + is * kv * v; nn[i] = fs * nn[i] + is * kv; num += qv * C[i]; den += qv * nn[i]; } }
        mm = mn;
        red[dq * 128 + e] = num; red[512 + dq * 128 + e] = den;
        __syncthreads();
        if (dq == 0) { const float nu = (red[e] + red[128 + e]) + (red[256 + e] + red[384 + e]), de = (red[512 + e] + red[640 + e]) + (red[768 + e] + red[896 + e]);
            red[1024 + t * 128 + e] = nu / fmaxf(fabsf(de), __expf(-mn)); }
        __syncthreads();
    }
    { const int t = F.wave; const size_t row = (size_t)(row0 + t);
      const float h0 = red[1024 + t * 128 + 2 * F.lane], h1 = red[1024 + t * 128 + 2 * F.lane + 1];
      const float rstd = 1.f / sqrtf(wave_sum(h0 * h0 + h1 * h1) * (1.f / MD) + RMS_EPS);
      const unsigned mo = *(const unsigned*)(SEG_MO(F) + row * MW + h * MD + 2 * F.lane);
      const float z0 = __builtin_bit_cast(float, mo << 16), z1 = __builtin_bit_cast(float, mo & 0xffff0000u);
      const float g0 = F.ml_norm[h * MD + 2 * F.lane], g1 = F.ml_norm[h * MD + 2 * F.lane + 1];
      *(unsigned*)(F.MIX + row * D + AW + h * MD + 2 * F.lane) = pk2(h0 * rstd * g0 / (1.f + __expf(-z0)), h1 * rstd * g1 / (1.f + __expf(-z1))); }
    float* Co = F.out + O_CS + (size_t)seq * MD * MD;
#pragma unroll
    for (int i = 0; i < 32; ++i) Co[(size_t)(32 * dq + i) * MD + e] = C[i];
    if (e == 0) {
#pragma unroll
        for (int i = 0; i < 32; ++i) F.out[O_NS + (size_t)seq * MD + 32 * dq + i] = nn[i];
        if (dq == 0) F.out[O_MS + seq] = mm;
    }
    __syncthreads();
}

constexpr size_t WS_LIST = 480 * MiB;
constexpr size_t WS_CNT = 484 * MiB;
constexpr size_t WS_PARTO = 485 * MiB;
constexpr size_t WS_PARTS = 534 * MiB;
constexpr size_t WS_END3 = 538 * MiB;
constexpr size_t WS_QG = 560 * MiB;
constexpr size_t WS_END_QG = 682 * MiB;
__host__ __device__ constexpr int past_item_index(int bh, int n, int o) { return bh * 120 + 15 * n - (n * (n - 1)) / 2 + (o - n - 1); }
constexpr int AT_WSC = 192;
constexpr int AT_LUT = 768;

__device__ __forceinline__ void build_lut(Frame& F, const LAS int* bucket, int h, LAS float* lut) {
    if (F.tid < 128) lut[F.tid] = F.rel_bias[bucket[F.tid] * AH + h];
    if (F.tid == 128) lut[128] = F.rel_bias[31 * AH + h];
}
struct Kv64Regs { v4u kk[4], vv[4]; };
__device__ __forceinline__ void load_kv64(Frame& F, const bf16* ksrc, const bf16* vsrc, Kv64Regs& R) {
#pragma unroll
    for (int i = 0; i < 4; ++i) { const int piece = F.tid + 512 * i, key = piece >> 3, ch = piece & 7;
        R.kk[i] = *(const v4u*)(ksrc + (size_t)key * AW + 8 * ch); R.vv[i] = *(const v4u*)(vsrc + (size_t)key * AW + 8 * ch); }
}
__device__ __forceinline__ void store_kv64(Frame& F, Kv64Regs& R, LAS unsigned char* KR, LAS unsigned char* VT) {
    asm volatile("" : "+v"(R.kk[0]), "+v"(R.kk[1]), "+v"(R.kk[2]), "+v"(R.kk[3]), "+v"(R.vv[0]), "+v"(R.vv[1]), "+v"(R.vv[2]), "+v"(R.vv[3]));
#pragma unroll
    for (int i = 0; i < 4; ++i) { const int piece = F.tid + 512 * i, key = piece >> 3, ch = piece & 7;
        *(LAS v4u*)(KR + ch * (256 * 16) + key * 16) = R.kk[i];
        *(LAS v4u*)(VT + (ch >> 2) * (256 * 64) + key * 64 + (ch & 3) * 16) = R.vv[i]; }
}
__device__ __forceinline__ void stage_kv64(Frame& F, const bf16* ksrc, const bf16* vsrc, LAS unsigned char* KR, LAS unsigned char* VT) {
    Kv64Regs R; load_kv64(F, ksrc, vsrc, R); store_kv64(F, R, KR, VT);
}
__device__ __forceinline__ void attn_select2(Frame& F, int ua, int ub) {
    const int half = F.tid >> 8, qt = F.tid & 255, unit = half ? ub : ua;
    const bool act = unit >= 0;
    const int bh = act ? unit / 15 : 0, o = act ? unit % 15 + 1 : 1, b = bh >> 3, h = bh & 7;
    LAS float* ks = (LAS float*)(F.lds + RING_OFF + half * 8192);
    LAS int* cnt = (LAS int*)(F.lds + RING_OFF + half * 8192 + 4096);
    __syncthreads();
    const int m = b * SEQ + o * 256 + qt;
    v4u qw[8];
    { const v4u* qp = (const v4u*)(SEG_AQ(F) + (size_t)m * AW + h * AD);
#pragma unroll
      for (int c = 0; c < 8; ++c) qw[c] = act ? qp[c] : (v4u){0u, 0u, 0u, 0u}; }
    float kv[4];
#pragma unroll
    for (int i = 0; i < 4; ++i) { const int idx = qt + 256 * i; kv[i] = (act && idx < o * 64) ? F.KSUM[((size_t)(b * NBLK_P + (idx >> 6))) * AW + h * AD + (idx & 63)] : 0.f; }
#pragma unroll
    for (int i = 0; i < 4; ++i) { const int idx = qt + 256 * i; if (idx < 15 * 64) ks[idx] = kv[i]; }
    if (qt < 16) cnt[qt] = 0;
    __syncthreads();
    if (act) {
        float q[64];
#pragma unroll
        for (int c = 0; c < 8; ++c) { const v4u w = qw[c];
            q[8 * c + 0] = __builtin_bit_cast(float, w.x << 16); q[8 * c + 1] = __builtin_bit_cast(float, w.x & 0xffff0000u);
            q[8 * c + 2] = __builtin_bit_cast(float, w.y << 16); q[8 * c + 3] = __builtin_bit_cast(float, w.y & 0xffff0000u);
            q[8 * c + 4] = __builtin_bit_cast(float, w.z << 16); q[8 * c + 5] = __builtin_bit_cast(float, w.z & 0xffff0000u);
            q[8 * c + 6] = __builtin_bit_cast(float, w.w << 16); q[8 * c + 7] = __builtin_bit_cast(float, w.w & 0xffff0000u); }
        float s0 = -INFINITY, s1 = -INFINITY, s2 = -INFINITY; int i0 = -1, i1 = -1, i2 = -1;
        for (int n = 0; n < o; ++n) {
            float s = 0.f;
#pragma unroll
            for (int d = 0; d < 64; ++d) s += q[d] * ks[n * 64 + d];
            if (s > s0) { s2 = s1; i2 = i1; s1 = s0; i1 = i0; s0 = s; i0 = n; }
            else if (s > s1) { s2 = s1; i2 = i1; s1 = s; i1 = n; }
            else if (s > s2) { s2 = s; i2 = n; }
        }
        unsigned short* list = (unsigned short*)(F.ws + WS_LIST);
#pragma unroll
        for (int j = 0; j < 3; ++j) {
            const int n = (j == 0) ? i0 : (j == 1 ? i1 : i2);
            if (n >= 0) { const int slot = __hip_atomic_fetch_add(&cnt[n], 1, __ATOMIC_RELAXED, __HIP_MEMORY_SCOPE_WORKGROUP);
                const size_t e = (size_t)past_item_index(bh, n, o) * 256 + slot;
                list[e] = (unsigned short)(qt | (j << 8));
                v4u* qg = (v4u*)((bf16*)(F.ws + WS_QG) + e * 64);
#pragma unroll
                for (int c = 0; c < 8; ++c) qg[c] = qw[c]; }
        }
    }
    __syncthreads();
    if (act && qt < o) ((int*)(F.ws + WS_CNT))[past_item_index(bh, qt, o)] = cnt[qt];
}
struct AttnOut { f32x16 o0, o1; float mx, l; };
__device__ __forceinline__ float max3f(float a, float b, float c) { float r; asm("v_max3_f32 %0, %1, %2, %3" : "=v"(r) : "v"(a), "v"(b), "v"(c)); return r; }
__device__ __forceinline__ void pack_p(const f32x16& p, bf16x8& pa0, bf16x8& pa1) {
#pragma unroll
    for (int i = 0; i < 4; ++i) { const unsigned p0 = pk2(p[2 * i], p[2 * i + 1]), p1 = pk2(p[8 + 2 * i], p[8 + 2 * i + 1]);
        pa0[2 * i] = (short)(p0 & 0xffff); pa0[2 * i + 1] = (short)(p0 >> 16); pa1[2 * i] = (short)(p1 & 0xffff); pa1[2 * i + 1] = (short)(p1 >> 16); }
}
template <bool CAUSAL>
__device__ __forceinline__ f32x16 score_tile(const LAS unsigned char* KR, const bf16x8 (&qf)[4], int lane, int kt, int tq, bool lutp, const LAS float* lut, float b31) {
    const int hi = lane >> 5;
    f32x16 a = {};
#pragma unroll
    for (int s = 0; s < 4; ++s) a = mfma32(rfrag(KR, 256, kt, s, lane), qf[s], a);
    if (lutp) {
#pragma unroll
        for (int r = 0; r < 16; ++r) { const int key = 32 * kt + crow(r, hi); int dist = tq - key; dist = dist < 0 ? 0 : (dist > 128 ? 128 : dist); a[r] += lut[dist]; if (CAUSAL && key > tq) a[r] = -INFINITY; }
    } else {
#pragma unroll
        for (int r = 0; r < 16; ++r) a[r] += b31;
    }
    return a;
}
template <bool CAUSAL>
__device__ __forceinline__ AttnOut wave_attend(const LAS unsigned char* KR, const LAS unsigned char* VT, const bf16x8 (&qf)[4], int lane, int nkt  ,
                                               int tq  , bool use_lut  , int lut_from_kt  , const LAS float* lut, float b31, int kt0 = 0  ) {
    AttnOut R; R.o0 = (f32x16){}; R.o1 = (f32x16){}; R.mx = -1e30f; R.l = 0.f;
    for (int kt = kt0; kt < nkt; kt += 2) {
        const bool two = (kt + 1 < nkt);
        f32x16 a0 = score_tile<CAUSAL>(KR, qf, lane, kt, tq, use_lut && kt >= lut_from_kt, lut, b31);
        f32x16 a1 = a0;
        if (two) a1 = score_tile<CAUSAL>(KR, qf, lane, kt + 1, tq, use_lut && kt + 1 >= lut_from_kt, lut, b31);
        float cm0 = max3f(a0[0], a0[1], a1[0]), cm1 = max3f(a0[2], a0[3], a1[1]);
        cm0 = max3f(cm0, a1[2], a1[3]);
#pragma unroll
        for (int r = 4; r < 16; r += 4) { cm0 = max3f(cm0, a0[r], a0[r + 1]); cm1 = max3f(cm1, a0[r + 2], a0[r + 3]); cm0 = max3f(cm0, a1[r], a1[r + 1]); cm1 = max3f(cm1, a1[r + 2], a1[r + 3]); }
        float cm = max3f(cm0, cm1, cm1);
        cm = fmaxf(cm, __shfl_xor(cm, 32));
        constexpr float L2E = 1.4426950408889634f;
        const float mn = fmaxf(R.mx, cm), f = __builtin_amdgcn_exp2f((R.mx - mn) * L2E), mnl = mn * L2E;
        R.mx = mn; R.l *= f;
#pragma unroll
        for (int r = 0; r < 16; ++r) { R.o0[r] *= f; R.o1[r] *= f; }
        float ls = 0.f;
#pragma unroll
        for (int r = 0; r < 16; ++r) { a0[r] = __builtin_amdgcn_exp2f(fmaf(a0[r], L2E, -mnl)); ls += a0[r]; }
        bf16x8 pa0, pa1;
        pack_p(a0, pa0, pa1);
        R.o0 = mfma32(tfrag(VT, 256, 2 * kt, 0, lane), pa0, R.o0); R.o1 = mfma32(tfrag(VT, 256, 2 * kt, 1, lane), pa0, R.o1);
        R.o0 = mfma32(tfrag(VT, 256, 2 * kt + 1, 0, lane), pa1, R.o0); R.o1 = mfma32(tfrag(VT, 256, 2 * kt + 1, 1, lane), pa1, R.o1);
        if (two) {
#pragma unroll
            for (int r = 0; r < 16; ++r) { a1[r] = __builtin_amdgcn_exp2f(fmaf(a1[r], L2E, -mnl)); ls += a1[r]; }
            pack_p(a1, pa0, pa1);
            R.o0 = mfma32(tfrag(VT, 256, 2 * kt + 2, 0, lane), pa0, R.o0); R.o1 = mfma32(tfrag(VT, 256, 2 * kt + 2, 1, lane), pa0, R.o1);
            R.o0 = mfma32(tfrag(VT, 256, 2 * kt + 3, 0, lane), pa1, R.o0); R.o1 = mfma32(tfrag(VT, 256, 2 * kt + 3, 1, lane), pa1, R.o1);
        }
        R.l += ls;
    }
    R.l += __shfl_xor(R.l, 32);
    return R;
}
constexpr int PAST_NITEMS = 32 * 120;
__device__ __forceinline__ void past_item_decode(int it, int& bh, int& n, int& o) { bh = it / 120; int pr = it % 120; n = 0; while (pr >= 15 - n) { pr -= 15 - n; ++n; } o = n + 1 + pr; }
__device__ __forceinline__ void attn_past_items(Frame& F, const LAS int* bucket) {
    LAS unsigned char* KR = F.lds + RING_OFF; LAS unsigned char* VT = F.lds + RING_OFF + 32768;
    LAS int* S = (LAS int*)(F.lds + RING_OFF + 65536);
    LAS int* C = S + 4096;
    LAS int* wsum = C + 4096;
    const int lane = F.lane, tl = lane & 31, hi = lane >> 5;
    const int* cntg = (const int*)(F.ws + WS_CNT);
    __syncthreads();
    {
        int cc[8] = {0, 0, 0, 0, 0, 0, 0, 0};
        if (8 * F.tid < PAST_NITEMS) { const int4 a = *(const int4*)(cntg + 8 * F.tid), bq = *(const int4*)(cntg + 8 * F.tid + 4); cc[0] = a.x; cc[1] = a.y; cc[2] = a.z; cc[3] = a.w; cc[4] = bq.x; cc[5] = bq.y; cc[6] = bq.z; cc[7] = bq.w; }
        int g[8], tot = 0;
#pragma unroll
        for (int k = 0; k < 8; ++k) { g[k] = (cc[k] + 31) >> 5; tot += g[k]; }
        int x = tot;
#pragma unroll
        for (int o = 1; o < 64; o <<= 1) { const int y = __shfl_up(x, o); if (lane >= o) x += y; }
        if (lane == 63) wsum[F.wave] = x;
        __syncthreads();
        int base = x - tot;
#pragma unroll
        for (int w = 0; w < 8; ++w) if (w < F.wave) base += wsum[w];
#pragma unroll
        for (int k = 0; k < 8; ++k) { const int it = 8 * F.tid + k; if (it < PAST_NITEMS) { S[it] = base; C[it] = cc[k]; } base += g[k]; }
        if (F.tid == 511) S[PAST_NITEMS] = base;
        __syncthreads();
    }
    const int T = S[PAST_NITEMS];
    const int lo = (int)(((long long)T * blockIdx.x) / F.G), hiG = (int)(((long long)T * (blockIdx.x + 1)) / F.G);
    int it = 0;
    { int a = 0, b = PAST_NITEMS; while (b - a > 1) { const int m = (a + b) >> 1; if (S[m] <= lo) a = m; else b = m; } it = a; }
#define PAST_SKIP_EMPTY(IT_) do { while ((IT_) < PAST_NITEMS && S[IT_] < hiG && (S[(IT_) + 1] == S[IT_] || S[(IT_) + 1] <= lo)) ++(IT_); } while (0)
#define PAST_RUN_LOAD(IT_) do { int bh_, n_, o_; past_item_decode((IT_), bh_, n_, o_); const size_t off_ = (size_t)((bh_ >> 3) * SEQ + n_ * 256) * AW + (bh_ & 7) * AD; load_kv64(F, SEG_AK(F) + off_, SEG_AV(F) + off_, KV); } while (0)
    Kv64Regs KV;
    PAST_SKIP_EMPTY(it);
    bool have = (lo < hiG) && it < PAST_NITEMS && S[it] < hiG;
    if (have) PAST_RUN_LOAD(it);
    while (have) {
        int bh, n, o0; past_item_decode(it, bh, n, o0);
        const int b = bh >> 3, h = bh & 7;
        const int run_end_item = it + (15 - o0) + 1;
        const int ra = S[it] > lo ? S[it] : lo;
        int rbx = S[run_end_item < PAST_NITEMS ? run_end_item : PAST_NITEMS]; const int rb = rbx < hiG ? rbx : hiG;
        int wi = it;
        int gamma = ra + F.wave;
        int p_dst = -1, p_tl = 0, p_o = 0; bf16x8 pq[4] = {};
        int r_dst = -1, r_tl = 0, r_o = 0; bf16x8 rq[4] = {};
#define PAST_FETCH(G_, DST_, TL_, O_, Q_) do { while (S[wi + 1] <= (G_)) ++wi; const int o_ = o0 + (wi - it); const int c_ = C[wi]; \
            const int qi_ = 32 * ((G_) - S[wi]) + tl; const bool v_ = qi_ < c_; const size_t e_ = (size_t)wi * 256 + (v_ ? qi_ : 0); \
            const unsigned ent_ = ((const unsigned short*)(F.ws + WS_LIST))[e_]; \
            const bf16* qp_ = (const bf16*)(F.ws + WS_QG) + e_ * 64 + 8 * hi; \
            _Pragma("unroll") for (int s_ = 0; s_ < 4; ++s_) (Q_)[s_] = *(const bf16x8*)(qp_ + 16 * s_); \
            (TL_) = ent_ & 255; (O_) = o_; (DST_) = v_ ? (((b * SEQ + o_ * 256 + (int)(ent_ & 255)) * AH + h) * 3 + (int)(ent_ >> 8)) : -1; } while (0)
        if (gamma < rb) PAST_FETCH(gamma, p_dst, p_tl, p_o, pq);
        if (gamma + 8 < rb) PAST_FETCH(gamma + 8, r_dst, r_tl, r_o, rq);
        __syncthreads();
        const LAS float* lut = LUT8(F) + h * 132;
        store_kv64(F, KV, KR, VT);
        int it_next = run_end_item; PAST_SKIP_EMPTY(it_next);
        const bool have_next = it_next < PAST_NITEMS && S[it_next] < hiG;
        if (have_next) PAST_RUN_LOAD(it_next);
        __syncthreads();
        const float b31 = lut[128];
        while (gamma < rb) {
            const int dst = p_dst, t_local = p_tl; const bool adj = (p_o == n + 1);
            bf16x8 qf[4] = {pq[0], pq[1], pq[2], pq[3]};
            p_dst = r_dst; p_tl = r_tl; p_o = r_o; pq[0] = rq[0]; pq[1] = rq[1]; pq[2] = rq[2]; pq[3] = rq[3];
            if (gamma + 16 < rb) PAST_FETCH(gamma + 16, r_dst, r_tl, r_o, rq);
            AttnOut R = wave_attend<false>(KR, VT, qf, lane, 8, 256 + t_local, adj, 4, lut, b31);
            if (dst >= 0) {
                if (hi == 0) { float* ps = (float*)(F.ws + WS_PARTS) + (size_t)dst * 2; ps[0] = R.mx; ps[1] = R.l; }
                const float rl = 1.f / R.l;
                bf16* po = (bf16*)(F.ws + WS_PARTO) + (size_t)dst * 64 + 4 * hi;
#pragma unroll
                for (int g = 0; g < 4; ++g) {
                    *(unsigned long long*)(po + 8 * g) = (unsigned long long)pk2(R.o0[4 * g] * rl, R.o0[4 * g + 1] * rl) | ((unsigned long long)pk2(R.o0[4 * g + 2] * rl, R.o0[4 * g + 3] * rl) << 32);
                    *(unsigned long long*)(po + 32 + 8 * g) = (unsigned long long)pk2(R.o1[4 * g] * rl, R.o1[4 * g + 1] * rl) | ((unsigned long long)pk2(R.o1[4 * g + 2] * rl, R.o1[4 * g + 3] * rl) << 32);
                }
            }
            gamma += 8;
        }
#undef PAST_FETCH
        it = it_next; have = have_next;
    }
#undef PAST_SKIP_EMPTY
#undef PAST_RUN_LOAD
    __syncthreads();
}
struct OwnLoads { bf16x8 qf[4]; float pm[3], pl[3]; unsigned long long pw0[3][4], pw1[3][4]; };
__device__ __forceinline__ void own_group_load(Frame& F, int b, int h, int o, int grp, OwnLoads& L) {
    const int lane = F.lane, tl = lane & 31, hi = lane >> 5;
    const int row = b * SEQ + o * 256 + 32 * grp + tl;
    { const bf16* qp = SEG_AQ(F) + (size_t)row * AW + h * AD + 8 * hi;
#pragma unroll
      for (int s = 0; s < 4; ++s) L.qf[s] = *(const bf16x8*)(qp + 16 * s); }
    const int np = o < 3 ? o : 3;
    const float* ps = (const float*)(F.ws + WS_PARTS) + (size_t)(row * AH + h) * 6;
    const bf16* po = (const bf16*)(F.ws + WS_PARTO) + (size_t)(row * AH + h) * 3 * 64 + 4 * hi;
#pragma unroll
    for (int j = 0; j < 3; ++j) {
        if (j < np) { L.pm[j] = ps[2 * j]; L.pl[j] = ps[2 * j + 1];
#pragma unroll
            for (int g = 0; g < 4; ++g) { L.pw0[j][g] = *(const unsigned long long*)(po + j * 64 + 8 * g); L.pw1[j][g] = *(const unsigned long long*)(po + j * 64 + 32 + 8 * g); } }
        else { L.pm[j] = -INFINITY; L.pl[j] = 0.f;
#pragma unroll
            for (int g = 0; g < 4; ++g) { L.pw0[j][g] = 0ull; L.pw1[j][g] = 0ull; } }
    }
}
__device__ __forceinline__ void own_group_compute(Frame& F, const LAS unsigned char* KR, const LAS unsigned char* VT, const LAS float* lut, int b, int h, int o, int grp, const OwnLoads& L) {
    const int lane = F.lane, tl = lane & 31, hi = lane >> 5;
    const int t_local = 32 * grp + tl, row = b * SEQ + o * 256 + t_local, np = o < 3 ? o : 3;
    AttnOut R = wave_attend<true>(KR, VT, L.qf, lane, grp + 1, t_local, true, 0, lut, 0.f);
    float mt = R.mx;
#pragma unroll
    for (int j = 0; j < 3; ++j) mt = fmaxf(mt, L.pm[j]);
    const float e_own = __expf(R.mx - mt); float aj[3], Ls = e_own * R.l;
#pragma unroll
    for (int j = 0; j < 3; ++j) { aj[j] = (j < np) ? __expf(L.pm[j] - mt) * L.pl[j] : 0.f; Ls += aj[j]; }
    const float rL = 1.f / Ls, a_own = e_own * rL;
#pragma unroll
    for (int j = 0; j < 3; ++j) aj[j] *= rL;
    bf16* mp = F.MIX + (size_t)row * D + h * AD + 4 * hi;
#pragma unroll
    for (int g = 0; g < 4; ++g) {
        float v0[4], v1[4];
#pragma unroll
        for (int i = 0; i < 4; ++i) { v0[i] = R.o0[4 * g + i] * a_own; v1[i] = R.o1[4 * g + i] * a_own; }
#pragma unroll
        for (int j = 0; j < 3; ++j) {
#pragma unroll
            for (int i = 0; i < 4; ++i) { v0[i] += aj[j] * bf2f((unsigned short)(L.pw0[j][g] >> (16 * i))); v1[i] += aj[j] * bf2f((unsigned short)(L.pw1[j][g] >> (16 * i))); }
        }
        *(unsigned long long*)(mp + 8 * g) = (unsigned long long)pk2(v0[0], v0[1]) | ((unsigned long long)pk2(v0[2], v0[3]) << 32);
        *(unsigned long long*)(mp + 32 + 8 * g) = (unsigned long long)pk2(v1[0], v1[1]) | ((unsigned long long)pk2(v1[2], v1[3]) << 32);
    }
}
__device__ __forceinline__ void attn_own_pair(Frame& F, const LAS int* bucket, int ua, int ub) {
    const int bha = ua >> 4, oa = ua & 15, ba = bha >> 3, ha = bha & 7, bhb = ub >> 4, ob = ub & 15, bb = bhb >> 3, hb = bhb & 7;
    LAS unsigned char* KA = F.lds + RING_OFF; LAS unsigned char* VA = KA + 32768; LAS unsigned char* KB = KA + 65536; LAS unsigned char* VB = KA + 98304;
    const LAS float* lutA = LUT8(F) + ha * 132; const LAS float* lutB = LUT8(F) + hb * 132;
    __syncthreads();
    OwnLoads LA; own_group_load(F, ba, ha, oa, F.wave, LA);
    {
        const bf16* ka = SEG_AK(F) + (size_t)(ba * SEQ + oa * 256) * AW + ha * AD; const bf16* va = SEG_AV(F) + (size_t)(ba * SEQ + oa * 256) * AW + ha * AD;
        const bf16* kb = SEG_AK(F) + (size_t)(bb * SEQ + ob * 256) * AW + hb * AD; const bf16* vb = SEG_AV(F) + (size_t)(bb * SEQ + ob * 256) * AW + hb * AD;
        v4u x[16];
#pragma unroll
        for (int i = 0; i < 4; ++i) { const int piece = F.tid + 512 * i, key = piece >> 3, ch = piece & 7; const size_t off = (size_t)key * AW + 8 * ch;
            x[4 * i] = *(const v4u*)(ka + off); x[4 * i + 1] = *(const v4u*)(va + off); x[4 * i + 2] = *(const v4u*)(kb + off); x[4 * i + 3] = *(const v4u*)(vb + off); }
        asm volatile("" : "+v"(x[0]), "+v"(x[1]), "+v"(x[2]), "+v"(x[3]), "+v"(x[4]), "+v"(x[5]), "+v"(x[6]), "+v"(x[7]));
        asm volatile("" : "+v"(x[8]), "+v"(x[9]), "+v"(x[10]), "+v"(x[11]), "+v"(x[12]), "+v"(x[13]), "+v"(x[14]), "+v"(x[15]));
#pragma unroll
        for (int i = 0; i < 4; ++i) { const int piece = F.tid + 512 * i, key = piece >> 3, ch = piece & 7;
            const int ko = ch * (256 * 16) + key * 16, vo = (ch >> 2) * (256 * 64) + key * 64 + (ch & 3) * 16;
            *(LAS v4u*)(KA + ko) = x[4 * i]; *(LAS v4u*)(VA + vo) = x[4 * i + 1]; *(LAS v4u*)(KB + ko) = x[4 * i + 2]; *(LAS v4u*)(VB + vo) = x[4 * i + 3]; }
    }
    __syncthreads();
    OwnLoads LB; own_group_load(F, bb, hb, ob, 7 - F.wave, LB);
    own_group_compute(F, KA, VA, lutA, ba, ha, oa, F.wave, LA);
    own_group_compute(F, KB, VB, lutB, bb, hb, ob, 7 - F.wave, LB);
}
constexpr size_t WS_SELS = 538 * MiB;
constexpr size_t WS_PARTOS = 539 * MiB;
constexpr size_t WS_PARTSS = 540 * MiB;
constexpr size_t WS_KSUMP = 541 * MiB;
constexpr size_t WS_SITEMS = 545 * MiB;
constexpr size_t WS_END4 = 546 * MiB;
constexpr int CW_SITEMS = 8192;
__device__ __forceinline__ void sample_select(Frame& F) {
    LAS unsigned* um = (LAS unsigned*)(F.lds + RING_OFF);
    LAS unsigned* rk = um + 16;
    const int lane = F.lane, n = lane & 31, st = 2 * F.wave + (lane >> 5);
    for (int pr = blockIdx.x; pr < DB * AH; pr += F.G) {
        const int sb = pr >> 3, h = pr & 7;
        __syncthreads();
        if (F.tid == 0) um[0] = 0u;
        if (F.tid < 32) rk[F.tid] = 0u;
        __syncthreads();
        if (F.wave < 4) {
            const int m = MP + sb * DS + st;
            v4u qw[8]; f32x4 ka[16], kb[16];
            { const v4u* qp = (const v4u*)(SEG_AQ(F) + (size_t)m * AW + h * AD);
#pragma unroll
              for (int c = 0; c < 8; ++c) qw[c] = qp[c]; }
            { const f32x4* k0 = (const f32x4*)((const float*)(F.ws + WS_KSUMP) + ((size_t)(sb * NPAGES + 2 * n)) * AW + h * AD); const f32x4* k1 = k0 + AW / 4;
#pragma unroll
              for (int c = 0; c < 16; ++c) { ka[c] = k0[c]; kb[c] = k1[c]; } }
            float s = 0.f;
#pragma unroll
            for (int c = 0; c < 8; ++c) { const unsigned ww[4] = {qw[c].x, qw[c].y, qw[c].z, qw[c].w};
                const f32x4 a0 = ka[2 * c] + kb[2 * c], a1 = ka[2 * c + 1] + kb[2 * c + 1];
                s += __builtin_bit_cast(float, ww[0] << 16) * a0.x + __builtin_bit_cast(float, ww[0] & 0xffff0000u) * a0.y + __builtin_bit_cast(float, ww[1] << 16) * a0.z + __builtin_bit_cast(float, ww[1] & 0xffff0000u) * a0.w
                   + __builtin_bit_cast(float, ww[2] << 16) * a1.x + __builtin_bit_cast(float, ww[2] & 0xffff0000u) * a1.y + __builtin_bit_cast(float, ww[3] << 16) * a1.z + __builtin_bit_cast(float, ww[3] & 0xffff0000u) * a1.w; }
            int sel[3]; unsigned mask = 0u;
#pragma unroll
            for (int j = 0; j < 3; ++j) {
                float v = s; int bn = n;
#pragma unroll
                for (int o = 1; o < 32; o <<= 1) { const float ov = __shfl_xor(v, o); const int on = __shfl_xor(bn, o); if (ov > v || (ov == v && on < bn)) { v = ov; bn = on; } }
                sel[j] = bn; mask |= 1u << bn;
                if (bn == n) s = -INFINITY;
            }
            if (n == 0) { int* so = (int*)(F.ws + WS_SELS) + (size_t)((sb * DS + st) * AH + h) * 3; so[0] = sel[0]; so[1] = sel[1]; so[2] = sel[2];
                __hip_atomic_fetch_or(um, mask, __ATOMIC_RELAXED, __HIP_MEMORY_SCOPE_WORKGROUP);
#pragma unroll
                for (int j = 0; j < 3; ++j) __hip_atomic_fetch_or(rk + sel[j], (unsigned)(j + 1) << (2 * st), __ATOMIC_RELAXED, __HIP_MEMORY_SCOPE_WORKGROUP); }
        }
        __syncthreads();
        if (F.wave == 0) {
            const unsigned mask = um[0];
            unsigned base = 0u;
            if (lane == 0) base = __hip_atomic_fetch_add((unsigned*)(F.ctl + CW_SITEMS), (unsigned)__popc(mask), __ATOMIC_RELAXED, __HIP_MEMORY_SCOPE_AGENT);
            base = __shfl(base, 0);
            if (lane < 32 && ((mask >> lane) & 1u)) ((int*)(F.ws + WS_SITEMS))[base + __popc(mask & ((1u << lane) - 1u))] = (int)((rk[lane] << 16) | (unsigned)((sb << 8) | (h << 5) | lane));
        }
    }
    __syncthreads();
}
struct KvRegs { f32x4 a[11], b[11]; };
__device__ __forceinline__ void load_kv64_paged(Frame& F, int sb, int n, int h, KvRegs& R) {
    const int pg0 = F.page_table[sb * NPAGES + 2 * n], pg1 = F.page_table[sb * NPAGES + 2 * n + 1];
    const int lt = F.tid - 128;
#pragma unroll
    for (int i = 0; i < 11; ++i) {
        const int piece = lt + 384 * i;
        if (i < 10 || piece < 4096) {
            const int idx = piece & 2047, key = idx >> 3, ch = idx & 7;
            const float* base = (piece < 2048) ? F.cache_k : F.cache_v;
            const float* src = base + ((size_t)((key < PAGE) ? pg0 : pg1) * PAGE + (key & (PAGE - 1))) * AW + h * AD + 8 * ch;
            R.a[i] = __builtin_nontemporal_load((const f32x4*)src); R.b[i] = __builtin_nontemporal_load((const f32x4*)(src + 4));
        }
    }
}
__device__ __forceinline__ void store_kv64_tiles(Frame& F, const KvRegs& R, LAS unsigned char* KR, LAS unsigned char* VT) {
    const int lt = F.tid - 128;
#pragma unroll
    for (int i = 0; i < 11; ++i) {
        const int piece = lt + 384 * i;
        if (i < 10 || piece < 4096) {
            const int idx = piece & 2047, key = idx >> 3, ch = idx & 7;
            const f32x4 x0 = R.a[i], x1 = R.b[i];
            v4u w; w.x = pk2(x0.x, x0.y); w.y = pk2(x0.z, x0.w); w.z = pk2(x1.x, x1.y); w.w = pk2(x1.z, x1.w);
            LAS unsigned char* dst = (piece < 2048) ? KR + ch * (256 * 16) + key * 16 : VT + (ch >> 2) * (256 * 64) + key * 64 + (ch & 3) * 16;
            *(LAS v4u*)dst = w;
        }
    }
}
__device__ __forceinline__ void sample_past_items(Frame& F, const LAS int* bucket) {
    LAS float* tab = (LAS float*)(F.lds + ML_TAB_OFF);
    const int lane = F.lane, tl = lane & 31, hi = lane >> 5;
    const int L = (int)__hip_atomic_load((unsigned*)(F.ctl + CW_SITEMS), __ATOMIC_RELAXED, __HIP_MEMORY_SCOPE_AGENT);
    const int* items = (const int*)(F.ws + WS_SITEMS);
    int idx = blockIdx.x, cur = 0;
#define ITEM_AT(k) items[idx + (k) * F.G]
#define HAS(k) (idx + (k) * F.G < L)
#define LOADER_STEP(RX) do { if (HAS(1)) { \
            LAS unsigned char* kb_ = F.lds + RING_OFF + (cur ^ 1) * 65536; store_kv64_tiles(F, RX, kb_, kb_ + 32768); \
            if (HAS(3)) { const int i3_ = ITEM_AT(3); load_kv64_paged(F, (i3_ >> 8) & 31, i3_ & 31, (i3_ >> 5) & 7, RX); } } \
        __syncthreads(); cur ^= 1; idx += F.G; } while (0)
    __syncthreads();
    if (F.wave >= 2) {
        KvRegs RA, RB;
        if (HAS(0)) {
            const int it = ITEM_AT(0);
            load_kv64_paged(F, (it >> 8) & 31, it & 31, (it >> 5) & 7, RA); store_kv64_tiles(F, RA, F.lds + RING_OFF, F.lds + RING_OFF + 32768);
            if (HAS(1)) { const int i1 = ITEM_AT(1); load_kv64_paged(F, (i1 >> 8) & 31, i1 & 31, (i1 >> 5) & 7, RA); }
            if (HAS(2)) { const int i2 = ITEM_AT(2); load_kv64_paged(F, (i2 >> 8) & 31, i2 & 31, (i2 >> 5) & 7, RB); }
        }
        __syncthreads();
        while (idx < L) { LOADER_STEP(RA); if (idx >= L) break; LOADER_STEP(RB); }
    } else {
        int pj = -1, pst = 0; bf16x8 pq[4] = {};
#define SAMPLE_ITEM_QUERY(IT, J, ST, QF) do { const int h_ = ((IT) >> 5) & 7, sb_ = ((IT) >> 8) & 31; const unsigned rk_ = (unsigned)(IT) >> 16; \
        const int j_ = (tl < 8) ? (int)((rk_ >> (2 * tl)) & 3u) - 1 : -1;                         \
        int first_ = 0; _Pragma("unroll") for (int s_ = 7; s_ >= 0; --s_) if ((rk_ >> (2 * s_)) & 3u) first_ = s_; \
        (J) = j_; (ST) = (j_ >= 0) ? tl : first_;                                                  \
        const bf16* qp_ = SEG_AQ(F) + (size_t)(MP + sb_ * DS + (ST)) * AW + h_ * AD + 8 * hi; \
        _Pragma("unroll") for (int s_ = 0; s_ < 4; ++s_) (QF)[s_] = *(const bf16x8*)(qp_ + 16 * s_); } while (0)
        LAS float* hand = tab + ML_WSC;
        volatile LAS int* flag = (volatile LAS int*)(tab + ML_WSC + 1160);
        if (HAS(0)) { const int it = ITEM_AT(0); SAMPLE_ITEM_QUERY(it, pj, pst, pq); }
        if (F.tid == 0) flag[0] = 0;
        __syncthreads();
        int seq = 0;
        for (; idx < L; idx += F.G) {
            const int it = ITEM_AT(0), n = it & 31, h = (it >> 5) & 7, sb = (it >> 8) & 31;
            const LAS unsigned char* KR = F.lds + RING_OFF + cur * 65536; const LAS unsigned char* VT = KR + 32768; const LAS float* lut = LUT8(F) + h * 132;
            const int j = pj, st = pst; const bool valid = j >= 0;
            bf16x8 qf[4] = {pq[0], pq[1], pq[2], pq[3]};
            if (HAS(1)) { const int i1 = ITEM_AT(1); SAMPLE_ITEM_QUERY(i1, pj, pst, pq); }
            ++seq;
            AttnOut O = wave_attend<false>(KR, VT, qf, lane, 4 + 4 * F.wave, 256 + st, n == NBLK_S - 1, 4, lut, lut[128], 4 * F.wave);
            LAS float* hp = hand + (seq & 1) * 576 + ((lane >> 5) * 8 + (tl & 7)) * 36;
            if (F.wave == 1) {
                if (tl < 8) { hp[0] = O.mx; hp[1] = O.l;
#pragma unroll
                    for (int r = 0; r < 16; ++r) { hp[2 + r] = O.o0[r]; hp[18 + r] = O.o1[r]; } }
                asm volatile("s_waitcnt lgkmcnt(0)" ::: "memory");
                if (lane == 0) flag[0] = seq;
            } else {
                while (flag[0] < seq) __builtin_amdgcn_s_sleep(1);
                asm volatile("" ::: "memory");
                if (valid) {
                    const float m1 = hp[0], l1 = hp[1], mt = fmaxf(O.mx, m1), f0 = __expf(O.mx - mt), f1 = __expf(m1 - mt), lt_ = O.l * f0 + l1 * f1;
                    const size_t dst = (size_t)((sb * DS + st) * AH + h) * 3 + j;
                    if (hi == 0) { float* ps = (float*)(F.ws + WS_PARTSS) + dst * 2; ps[0] = mt; ps[1] = lt_; }
                    const float rl = 1.f / lt_, g0 = f0 * rl, g1 = f1 * rl;
                    bf16* po = (bf16*)(F.ws + WS_PARTOS) + dst * 64 + 4 * hi;
#pragma unroll
                    for (int g = 0; g < 4; ++g) {
                        float a[4], b[4];
#pragma unroll
                        for (int i = 0; i < 4; ++i) { a[i] = O.o0[4 * g + i] * g0 + hp[2 + 4 * g + i] * g1; b[i] = O.o1[4 * g + i] * g0 + hp[18 + 4 * g + i] * g1; }
                        *(unsigned long long*)(po + 8 * g) = (unsigned long long)pk2(a[0], a[1]) | ((unsigned long long)pk2(a[2], a[3]) << 32);
                        *(unsigned long long*)(po + 32 + 8 * g) = (unsigned long long)pk2(b[0], b[1]) | ((unsigned long long)pk2(b[2], b[3]) << 32);
                    }
                }
            }
            __syncthreads();
            cur ^= 1;
        }
#undef SAMPLE_ITEM_QUERY
    }
#undef LOADER_STEP
#undef ITEM_AT
#undef HAS
    __syncthreads();
}
__device__ __forceinline__ void sample_own_merge(Frame& F, const LAS int* bucket) {
    const int gw = blockIdx.x * NWAVES + F.wave, NGW = F.G * NWAVES, d = F.lane;
    for (int idx = gw; idx < MS * AH; idx += NGW) {
        const int r = idx >> 3, h = idx & 7, sb = r >> 3, st = r & 7, m = MP + r;
        const float q = bf2f(SEG_AQ(F)[(size_t)m * AW + h * AD + d]);
        float s[8], vv[8];
#pragma unroll
        for (int p = 0; p < 8; ++p) { const size_t off = ((size_t)(MP + sb * DS + p)) * AW + h * AD + d; s[p] = q * bf2f(SEG_AK(F)[off]); vv[p] = bf2f(SEG_AV(F)[off]); }
#pragma unroll
        for (int p = 0; p < 8; ++p) { s[p] = wave_sum(s[p]); s[p] = (p <= st) ? s[p] + LUT8(F)[h * 132 + ((st - p) & 7)] : -INFINITY; }
        float mx = s[0];
#pragma unroll
        for (int p = 1; p < 8; ++p) mx = fmaxf(mx, s[p]);
        float l = 0.f, o = 0.f;
#pragma unroll
        for (int p = 0; p < 8; ++p) { const float pw = __expf(s[p] - mx); l += pw; o += pw * vv[p]; }
        const float* ps = (const float*)(F.ws + WS_PARTSS) + (size_t)idx * 6;
        float mt = mx; float pm[3], pl[3];
#pragma unroll
        for (int j = 0; j < 3; ++j) { pm[j] = ps[2 * j]; pl[j] = ps[2 * j + 1]; mt = fmaxf(mt, pm[j]); }
        const float e_own = __expf(mx - mt); float aj[3], L = e_own * l;
#pragma unroll
        for (int j = 0; j < 3; ++j) { aj[j] = __expf(pm[j] - mt) * pl[j]; L += aj[j]; }
        const float rL = 1.f / L;
        const bf16* po = (const bf16*)(F.ws + WS_PARTOS) + (size_t)idx * 3 * 64 + d;
        F.MIX[(size_t)m * D + h * AD + d] = (bf16)f2bf(rL * (o * e_own + aj[0] * bf2f(po[0]) + aj[1] * bf2f(po[64]) + aj[2] * bf2f(po[128])));
    }
}

template <int BATCH, class Epi>
__device__ __forceinline__ void skinny_gemm(Frame& F, const bf16* A, int lda, const bf16* Wt, int ldw, int ntile, int K, const Epi& E) {
    const int lane = F.lane, r = lane & 31, hi = lane >> 5, kw = K / 8;
    LAS float* red = (LAS float*)(F.lds + RING_OFF);
    for (int u = blockIdx.x; u < 8 * ntile; u += F.G) {
        const int rg = u & 7, ct = u >> 3, k0 = F.wave * kw;
        const bf16* ap = A + (size_t)(32 * rg + r) * lda + k0 + 8 * hi;
        const bf16* bp = Wt + (size_t)(32 * ct + r) * ldw + k0 + 8 * hi;
        f32x16 acc = {};
        for (int s = 0; s < kw / 16; s += BATCH) {
            bf16x8 af[BATCH], bfr[BATCH];
#pragma unroll
            for (int i = 0; i < BATCH; ++i) { af[i] = *(const bf16x8*)(ap + 16 * (s + i)); bfr[i] = *(const bf16x8*)(bp + 16 * (s + i)); }
#pragma unroll
            for (int i = 0; i < BATCH; ++i) acc = mfma32(af[i], bfr[i], acc);
        }
        __syncthreads();
#pragma unroll
        for (int i = 0; i < 16; ++i) red[(F.wave * 16 + i) * 64 + lane] = acc[i];
        __syncthreads();
#pragma unroll
        for (int q = 0; q < 2; ++q) {
            const int e = F.tid + 512 * q; float s = 0.f;
#pragma unroll
            for (int w = 0; w < 8; ++w) s += red[w * 1024 + e];
            const int reg = e >> 6, ln = e & 63;
            E(s, 32 * rg + crow(reg, ln >> 5), 32 * ct + (ln & 31));
        }
    }
    __syncthreads();
}
struct SkResid { const float* xs; float* x1; __device__ __forceinline__ void operator()(float s, int row, int col) const { x1[(size_t)(MP + row) * D + col] = xs[(size_t)row * D + col] + s; } };
struct SkAccum { float* x1; __device__ __forceinline__ void operator()(float s, int row, int col) const { float* p = x1 + (size_t)(MP + row) * D + col; *p = *p + s; } };
struct SkRelu2U { bf16* U; __device__ __forceinline__ void operator()(float s, int row, int col) const { const float a = fmaxf(s, 0.f); U[(size_t)(MP + row) * FF + col] = (bf16)f2bf(a * a); } };

__device__ __forceinline__ void skinny_up4(Frame& F) {
    const int lane = F.lane, r = lane & 31, hi = lane >> 5, kw = D / 8;
    LAS float* red = (LAS float*)(F.lds + RING_OFF);
    const bf16* A = F.XN + (size_t)MP * D;
    for (int u = blockIdx.x; u < 8 * (FF / 128); u += F.G) {
        const int rg = u & 7, c4 = u >> 3, k0 = F.wave * kw;
        const bf16* ap = A + (size_t)(32 * rg + r) * D + k0 + 8 * hi;
        bf16x8 af[8];
#pragma unroll
        for (int i = 0; i < 8; ++i) af[i] = *(const bf16x8*)(ap + 16 * i);
        f32x16 acc[4];
#pragma unroll
        for (int t = 0; t < 4; ++t) {
            const bf16* bp = F.Wup_t + (size_t)(32 * (4 * c4 + t) + r) * D + k0 + 8 * hi;
            bf16x8 bfr[8];
#pragma unroll
            for (int i = 0; i < 8; ++i) bfr[i] = *(const bf16x8*)(bp + 16 * i);
            acc[t] = (f32x16){};
#pragma unroll
            for (int i = 0; i < 8; ++i) acc[t] = mfma32(af[i], bfr[i], acc[t]);
        }
        __syncthreads();
#pragma unroll
        for (int t = 0; t < 4; ++t)
#pragma unroll
            for (int i = 0; i < 16; ++i) red[((t * 8 + F.wave) * 16 + i) * 64 + lane] = acc[t][i];
        __syncthreads();
#pragma unroll
        for (int q = 0; q < 8; ++q) {
            const int e4 = F.tid + 512 * q, t = e4 >> 10, e = e4 & 1023; float s = 0.f;
#pragma unroll
            for (int w = 0; w < 8; ++w) s += red[(t * 8 + w) * 1024 + e];
            const int reg = e >> 6, ln = e & 63; const float a = fmaxf(s, 0.f);
            F.U[(size_t)(MP + 32 * rg + crow(reg, ln >> 5)) * FF + 32 * (4 * c4 + t) + (ln & 31)] = (bf16)f2bf(a * a);
        }
    }
    __syncthreads();
}

__device__ __forceinline__ void sample_ffn_norm(Frame& F) {
    for (int u = blockIdx.x; u < 8 * (FF / 128); u += F.G) {
        const int rg = u & 7;
#pragma unroll
        for (int i = 0; i < 4; ++i) {
            const int r = 32 * rg + 4 * F.wave + i;
            f32x4 v[4]; load_row(F.X1 + (size_t)(MP + r) * D, F.lane, v);
            rms_row_to_bf16<false>(F, v, F.norm_ffn, F.XN + (size_t)(MP + r) * D, MP + r);
        }
    }
    asm volatile("s_waitcnt vmcnt(0)" ::: "memory");
    __syncthreads();
}

#ifndef MK_ONE_LAUNCH
#define MK_ONE_LAUNCH 1
#endif
constexpr int N_PHASES = 11;
struct Args { const void* in[19]; float* out; unsigned char* ws; int ph_lo, ph_hi; };
static_assert(sizeof(Args) == 19 * 8 + 8 + 8 + 8, "Args has no padding bytes");
__global__ void __launch_bounds__(NWAVES * 64, 2) hymba_fwd(Args args) {
    extern __shared__ __attribute__((aligned(16))) unsigned char lds[];
    Frame F;
    F.lds = (LAS unsigned char*)lds;
    F.MISC = (volatile LAS unsigned*)(F.lds + MISC_OFF);
    F.tid = threadIdx.x; F.lane = F.tid & 63; F.wave = __builtin_amdgcn_readfirstlane(F.tid >> 6);
    F.G = gridDim.x; { const int bx = blockIdx.x; F.vcu = (F.G % 8 == 0) ? (bx % 8) * (F.G / 8) + bx / 8 : bx; }
    unsigned char* ws = args.ws; F.ws = ws;
    F.ctl = (gu32*)(ws + WS_CTL);
    F.xp = (const float*)args.in[0]; F.xs = (const float*)args.in[1]; F.cache_k = (const float*)args.in[2]; F.cache_v = (const float*)args.in[3];
    F.state_C = (const float*)args.in[4]; F.state_n = (const float*)args.in[5]; F.state_m = (const float*)args.in[6]; F.page_table = (const int*)args.in[7];
    F.rel_bias = (const float*)args.in[8]; F.norm_mix = (const float*)args.in[9]; F.w_in = (const float*)args.in[10]; F.b_ig = (const float*)args.in[11];
    F.b_fg = (const float*)args.in[12]; F.ml_norm = (const float*)args.in[13]; F.w_out = (const float*)args.in[14]; F.norm_ffn = (const float*)args.in[15];
    F.w_up = (const float*)args.in[16]; F.w_down = (const float*)args.in[17]; F.norm_final = (const float*)args.in[18];
    F.out = args.out;
    F.Win_t = (bf16*)(ws + WS_WIN); F.Wout_t = (bf16*)(ws + WS_WOUT); F.Wup_t = (bf16*)(ws + WS_WUP); F.Wdn_t = (bf16*)(ws + WS_WDN);
    F.XN = (bf16*)(ws + WS_XN); F.SEG = (bf16*)(ws + WS_SEG); F.MIX = (bf16*)(ws + WS_MIX); F.U = (bf16*)(ws + WS_U);
    F.KSUM = (float*)(ws + WS_KSUM); F.KSUMS = (float*)(ws + WS_KSUMP); F.IG = (float*)(ws + WS_GATE); F.LF = (float*)(ws + WS_GATE + 512 * 1024);
    F.H = (float*)(ws + WS_H); F.X1 = (float*)(ws + WS_X1);
    for (int u = F.tid; u < (LDS_BYTES - LDSCTL_OFF) / 4; u += NWAVES * 64) ((LAS unsigned*)(F.lds + LDSCTL_OFF))[u] = 0u;
    __syncthreads();
    LAS int* bucket = (LAS int*)(F.lds + LDSCTL_OFF + 1024);
    if (F.tid < 128) bucket[F.tid] = t5_bucket_small(F.tid);
    __syncthreads();
    { LAS float* l8 = (LAS float*)(F.lds + LUT8_OFF);
      for (int i = F.tid; i < AH * 129; i += NWAVES * 64) { const int h_ = i / 129, d_ = i % 129; l8[h_ * 132 + d_] = F.rel_bias[(d_ < 128 ? bucket[d_] : 31) * AH + h_]; }
    }
    __syncthreads();
    const int lo = args.ph_lo, hi = args.ph_hi;
    XcdBarrier bar; bar.bar = (unsigned*)(F.ctl + CW_BAR); bar.x = 0; bar.st = nullptr;
    if (hi - lo > 1) bar = xcd_barrier_post((unsigned*)(F.ctl + CW_BAR), F.MISC + 8);
#define IN(k) (lo <= (k) && (k) < hi)
#define SEAM(k) do { if (IN(k) && IN((k) + 1)) xcd_barrier(bar); } while (0)

    if (IN(0)) { p0_prologue(F); } SEAM(0);
    if (IN(1)) {
        const int gwg = (F.G > P1_GEMM_WGS) ? P1_GEMM_WGS : F.G;
        if ((int)blockIdx.x < gwg) {
            pg8::Gemm g{F.XN, F.Win_t, M, NPG, D}; pg8::StaticOrder S; S.init(M, NPG, gwg, (int)blockIdx.x); pg8::EpiInProj E{F.SEG, SEG_ELEMS, F.out, F.KSUM};
            pg8::gemm_phase<pg8::EpiInProj, pg8::StaticOrder, true, true>(F.lds + RING_OFF, g, S, E);
        }
        if (F.G > gwg) { if ((int)blockIdx.x >= gwg) { page_sums(F, PS_SPLIT, DB * NPAGES, ((int)blockIdx.x - gwg) * NWAVES + F.wave, (F.G - gwg) * NWAVES); late_transposes(F, ((int)blockIdx.x - gwg) * NWAVES + F.wave, (F.G - gwg) * NWAVES); } }
        else { page_sums(F, PS_SPLIT, DB * NPAGES, F.vcu * NWAVES + F.wave, F.G * NWAVES); late_transposes(F, F.vcu * NWAVES + F.wave, F.G * NWAVES); }
    } SEAM(1);
    if (IN(2)) {
        for (int u = blockIdx.x; u < NSEQ * NCH; u += F.G) mlstm_stepA(F, u);
        for (int u = blockIdx.x; u < 32 * 15; u += 2 * F.G) attn_select2(F, u, (u + F.G < 32 * 15) ? u + F.G : -1);
        sample_select(F);
    } SEAM(2);
    if (IN(3)) {
        for (int u = blockIdx.x; u < NSEQ * 16; u += F.G) mlstm_stepB(F, u);
        attn_past_items(F, bucket);
        sample_past_items(F, bucket);
    } SEAM(3);
    if (IN(4)) {
        for (int u = blockIdx.x; u < NSEQ * NCH; u += F.G) mlstm_stepC(F, u);
        for (int u = blockIdx.x; u < 16 * 16; u += F.G) attn_own_pair(F, bucket, u, u + 256);
        for (int u = blockIdx.x; u < DB * MH; u += F.G) mlstm_sample_full(F, u);
        __syncthreads();
        sample_own_merge(F, bucket);
    }
    if (IN(4) && IN(6)) xcd_barrier(bar);
    if (IN(6)) {
        pg8::Gemm g{F.MIX, F.Wout_t, MP, D, D}; pg8::StaticOrder S; S.init(MP, D, F.G, (int)blockIdx.x); pg8::EpiResid E{F.xp, F.xs, F.X1, F.norm_ffn, F.XN, (float*)(F.ws + WS_SSQ)};
        pg8::gemm_phase<pg8::EpiResid, pg8::StaticOrder, true, true>(F.lds + RING_OFF, g, S, E);
        skinny_gemm<8>(F, F.MIX + (size_t)MP * D, D, F.Wout_t, D, D / 32, D, SkResid{F.xs, F.X1});
    }
    if (IN(6) && IN(8)) xcd_barrier(bar);
    if (IN(8)) {
        pg8::Gemm g{F.XN, F.Wup_t, MP, FF, D}; pg8::StaticOrder S; S.init(MP, FF, F.G, (int)blockIdx.x); pg8::EpiRelu2 E{F.U, (const float*)(F.ws + WS_SSQ)};
        pg8::gemm_phase<pg8::EpiRelu2, pg8::StaticOrder, true, true>(F.lds + RING_OFF, g, S, E);
        sample_ffn_norm(F); skinny_up4(F);
    } SEAM(8);
    if (IN(9)) {
        pg8::Gemm g{F.U, F.Wdn_t, MP, D, FF}; pg8::StaticOrder S; S.init(MP, D, F.G, (int)blockIdx.x);
        pg8::EpiAccum E{F.X1};
        pg8::gemm_phase<pg8::EpiAccum, pg8::StaticOrder, true, true>(F.lds + RING_OFF, g, S, E);
        skinny_gemm<16>(F, F.U + (size_t)MP * FF, FF, F.Wdn_t, FF, D / 32, FF, SkAccum{F.X1});
    } SEAM(9);
    if (IN(10)) { final_norm_rows(F); }
#undef IN
#undef SEAM
}

extern "C" void kernel_launch(void* const* d_in, const int* in_sizes, int n_in, void* d_out, int out_size, void* d_ws, size_t ws_size, hipStream_t stream) {
    static int grid = 0;
    if (grid == 0) {
        if (n_in != 19 || (size_t)out_size != O_END || ws_size < WS_END_SSQ) { fprintf(stderr, "kernel_launch: unexpected shapes (n_in %d out %d ws %zu)\n", n_in, out_size, ws_size); grid = -1; return; }
        int dev = 0, cus = 0, per_cu = 0;
        if (hipGetDevice(&dev) != hipSuccess || hipDeviceGetAttribute(&cus, hipDeviceAttributeMultiprocessorCount, dev) != hipSuccess) { grid = -1; return; }
        if (hipFuncSetAttribute((const void*)hymba_fwd, hipFuncAttributeMaxDynamicSharedMemorySize, LDS_BYTES) != hipSuccess) { fprintf(stderr, "kernel_launch: hipFuncSetAttribute failed\n"); grid = -1; return; }
        if (hipOccupancyMaxActiveBlocksPerMultiprocessor(&per_cu, (const void*)hymba_fwd, NWAVES * 64, LDS_BYTES) != hipSuccess || per_cu < 1)
            fprintf(stderr, "kernel_launch: note: occupancy query reports %d workgroups per CU\n", per_cu);
        (void)hipGetLastError();
        grid = cus;
    }
    if (grid < 0) return;
    if (hipMemsetAsync((char*)d_ws + WS_CTL, 0, CTL_ZERO_BYTES, stream) != hipSuccess) { fprintf(stderr, "kernel_launch: memset failed\n"); return; }
    Args a{};
    for (int i = 0; i < 19; ++i) a.in[i] = d_in[i];
    a.out = (float*)d_out; a.ws = (unsigned char*)d_ws;
#if MK_ONE_LAUNCH
    a.ph_lo = 0; a.ph_hi = N_PHASES;
    hipLaunchKernelGGL(hymba_fwd, dim3(grid), dim3(NWAVES * 64), LDS_BYTES, stream, a);
#else
    for (int p = 0; p < N_PHASES; ++p) {
        a.ph_lo = p; a.ph_hi = p + 1;
        hipLaunchKernelGGL(hymba_fwd, dim3(grid), dim3(NWAVES * 64), LDS_BYTES, stream, a);
    }
#endif
    const hipError_t le = hipPeekAtLastError();
    if (le != hipSuccess) fprintf(stderr, "kernel_launch: launch failed: %s\n", hipGetErrorName(le));
}
```
